# Optimizing an MI355X kernel written in HIP

```python
import math
import jax
import jax.numpy as jnp
from jax import lax
import numpy as np

D_MODEL = 1024
BATCH = 8
SEQ = 4096
DEPTH = 1

ATT_HEAD_DIM = 64
ATT_HEADS = 8
ATT_GROUPS = ((128, 1), (512, 4), (2048, 16))
N_ATT_GROUPS = 3
ATT_QK_WIDTH = N_ATT_GROUPS * ATT_HEADS * ATT_HEAD_DIM
ATT_OUT_WIDTH = ATT_HEADS * ATT_HEAD_DIM
ATT_BLOCK = 128
NEG_INF = -1e30

HG_HEADS = 8
HG_EXPAND = 128
HG_WIDTH = HG_HEADS * HG_EXPAND
HG_HEAD_V = HG_WIDTH // HG_HEADS
HG_CHUNK = 32
RMS_EPS = 1e-6

SPLIT_SIZES = (ATT_QK_WIDTH,) * 3 + (HG_WIDTH,) * 4 + (D_MODEL,) * 2
N_IN = 3 * ATT_QK_WIDTH + 4 * HG_WIDTH + 2 * D_MODEL

N_EXPERTS = 64
TOP_K = 8
N_EXPERT_GROUPS = 8
TOPK_GROUPS = 4
EXPERT_FF = 256
SHARED_FF = 256
ROUTED_SCALE = 2.5
MOE_BLOCK = 512

PLE_DIM = 256
LN_EPS = 1e-5
DEEPNORM_ALPHA = (2.0 * DEPTH) ** 0.25
DEEPNORM_BETA = (8.0 * DEPTH) ** -0.25

kernel_name = 'hybrid_dilated_attn_hgrn2_moe_block'


def layer_norm(x, w, b):
    xf = x.astype(jnp.float32)
    mu = xf.mean(-1, keepdims=True)
    var = jnp.mean(jnp.square(xf - mu), -1, keepdims=True)
    return ((xf - mu) * lax.rsqrt(var + LN_EPS) * w.astype(jnp.float32) + b.astype(jnp.float32)).astype(x.dtype)


def alibi_slopes():
    return jnp.asarray(np.array([2.0 ** (-8.0 * (h + 1) / ATT_HEADS) for h in range(ATT_HEADS)], np.float32))


def dilated_window_group(q, k, v, window, dilation):
    B, S, H, Dh = q.shape
    w_sub = window // dilation
    L = S // dilation
    nb = -(-L // ATT_BLOCK)
    pad = nb * ATT_BLOCK - L

    def to_blocks(t):
        t = t.astype(jnp.float32).reshape(B, L, dilation, H, Dh)
        t = jnp.pad(t, ((0, 0), (0, pad), (0, 0), (0, 0), (0, 0)))
        return t.reshape(B, nb, ATT_BLOCK, dilation, H, Dh)

    def with_previous_block(t):
        prev = jnp.pad(t[:, :-1], ((0, 0), (1, 0), (0, 0), (0, 0), (0, 0), (0, 0)))
        return jnp.concatenate([prev, t], axis=2)

    qb = to_blocks(q) * (Dh ** -0.5)
    kc = with_previous_block(to_blocks(k))
    vc = with_previous_block(to_blocks(v))

    qi = jnp.arange(ATT_BLOCK)[:, None]
    ki = jnp.arange(2 * ATT_BLOCK)[None, :]
    steps = qi + ATT_BLOCK - ki
    key_idx = jnp.arange(nb)[:, None] * ATT_BLOCK - ATT_BLOCK + jnp.arange(2 * ATT_BLOCK)[None, :]
    valid = ((steps >= 0) & (steps <= w_sub))[None] & (key_idx >= 0)[:, None, :]
    bias = -alibi_slopes()[:, None, None] * (steps * dilation).astype(jnp.float32)[None]

    s = jnp.einsum('bnqrhd,bnkrhd->bnrhqk', qb, kc) + bias[None, None, None]
    s = jnp.where(valid[None, :, None, None], s, NEG_INF)
    m = s.max(-1)
    pexp = jnp.exp(s - m[..., None])
    den = pexp.sum(-1)
    num = jnp.einsum('bnrhqk,bnkrhd->bnqrhd', pexp, vc)

    def back(t):
        t = t.reshape((B, nb * ATT_BLOCK, dilation) + t.shape[4:])[:, :L]
        return t.reshape((B, S) + t.shape[3:])

    return back(num), back(m.transpose(0, 1, 4, 2, 3)), back(den.transpose(0, 1, 4, 2, 3))


def dilated_attention(q, k, v):
    parts = [dilated_window_group(q[:, :, g], k[:, :, g], v[:, :, g], win, dil)
             for g, (win, dil) in enumerate(ATT_GROUPS)]
    m_all = jnp.stack([pt[1] for pt in parts])
    scale = jnp.exp(m_all - m_all.max(0))
    num = sum(scale[g][..., None] * parts[g][0] for g in range(N_ATT_GROUPS))
    den = sum(scale[g] * parts[g][2] for g in range(N_ATT_GROUPS))
    return num / den[..., None]


def hgrn2_recurrence(q, f_logit, i, lb):
    B, S, _ = q.shape
    n_chunks = S // HG_CHUNK
    forget = lb + (1.0 - lb) * jax.nn.sigmoid(f_logit.astype(jnp.float32))
    log_f = jnp.log(forget)
    key = 1.0 - forget

    def chunked(t):
        t = t.astype(jnp.float32).reshape(B, n_chunks, HG_CHUNK, HG_HEADS, -1)
        return t.transpose(1, 0, 3, 2, 4)

    causal = jnp.tril(jnp.ones((HG_CHUNK, HG_CHUNK), dtype=bool))

    def step(state, inp):
        qc, kc, vc, gc = inp
        b = jnp.cumsum(gc, axis=2)
        b_last = b[:, :, -1:]
        q_dec = qc * jnp.exp(b)
        k_inv = kc * jnp.exp(-b)
        k_end = kc * jnp.exp(b_last - b)
        a = jnp.where(causal, jnp.einsum('bhtk,bhsk->bhts', q_dec, k_inv), 0.0)
        o = jnp.einsum('bhts,bhsv->bhtv', a, vc) + jnp.einsum('bhtk,bhkv->bhtv', q_dec, state)
        state = jnp.exp(b_last)[:, :, 0, :, None] * state + jnp.einsum('bhsk,bhsv->bhkv', k_end, vc)
        return state, o

    state0 = jnp.zeros((B, HG_HEADS, HG_EXPAND, HG_HEAD_V), jnp.float32)
    _, o = lax.scan(step, state0, (chunked(q), chunked(key), chunked(i), chunked(log_f)))
    return o.transpose(1, 0, 3, 2, 4).reshape(B, S, HG_HEADS, HG_HEAD_V)


def rms_norm_heads(o, gain):
    B, S, H, dv = o.shape
    o = o * lax.rsqrt(jnp.mean(jnp.square(o), -1, keepdims=True) + RMS_EPS)
    return (o * gain.astype(jnp.float32).reshape(H, dv)).reshape(B, S, H * dv)


def swiglu(h, w_gate, w_up, w_down):
    return (jax.nn.silu(h @ w_gate) * (h @ w_up)) @ w_down


def route(h, w_router, bias):
    T = h.shape[0]
    s = jax.nn.sigmoid(h.astype(jnp.float32) @ w_router.astype(jnp.float32))
    sel = s + bias.astype(jnp.float32)
    grp = sel.reshape(T, N_EXPERT_GROUPS, N_EXPERTS // N_EXPERT_GROUPS)
    grp_score = lax.top_k(grp, 2)[0].sum(-1)
    _, top_grp = lax.top_k(grp_score, TOPK_GROUPS)
    grp_mask = jnp.any(top_grp[..., :, None] == jnp.arange(N_EXPERT_GROUPS), axis=-2)
    expert_mask = jnp.repeat(grp_mask, N_EXPERTS // N_EXPERT_GROUPS, axis=-1)
    _, idx = lax.top_k(jnp.where(expert_mask, sel, -jnp.inf), TOP_K)
    g = jnp.take_along_axis(s, idx, axis=-1)
    g = g / g.sum(-1, keepdims=True) * ROUTED_SCALE
    return idx, g


def routed_experts(h, idx, gate, w_gate, w_up, w_down):
    T, D = h.shape
    A = T * TOP_K
    e_flat = idx.reshape(A).astype(jnp.int32)
    tok_flat = (jnp.arange(A, dtype=jnp.int32) // TOP_K)
    g_flat = gate.reshape(A)
    order = jnp.argsort(e_flat)
    e_s, tok_s, g_s = e_flat[order], tok_flat[order], g_flat[order]
    counts = jnp.bincount(e_flat, length=N_EXPERTS).astype(jnp.int32)
    padded = ((counts + MOE_BLOCK - 1) // MOE_BLOCK) * MOE_BLOCK
    start = jnp.cumsum(counts) - counts
    pend = jnp.cumsum(padded)
    pstart = pend - padded
    dest = pstart[e_s] + (jnp.arange(A, dtype=jnp.int32) - start[e_s])
    n_blocks = -(-(A + N_EXPERTS * (MOE_BLOCK - 1)) // MOE_BLOCK)
    P = n_blocks * MOE_BLOCK
    buf_tok = jnp.full((P,), T, jnp.int32).at[dest].set(tok_s)
    buf_g = jnp.zeros((P,), h.dtype).at[dest].set(g_s.astype(h.dtype))
    block_expert = jnp.minimum(
        jnp.searchsorted(pend, jnp.arange(n_blocks, dtype=jnp.int32) * MOE_BLOCK, side='right'),
        N_EXPERTS - 1).astype(jnp.int32)
    h_pad = jnp.concatenate([h, jnp.zeros((1, D), h.dtype)], axis=0)

    def step(acc, blk):
        tok_b, g_b, e = blk
        xb = h_pad[tok_b]
        a = jax.nn.silu(xb @ w_gate[e]) * (xb @ w_up[e])
        out = (a @ w_down[e]) * g_b[:, None]
        return acc.at[tok_b].add(out.astype(acc.dtype)), None

    acc, _ = lax.scan(step, jnp.zeros((T + 1, D), h.dtype),
                      (buf_tok.reshape(n_blocks, MOE_BLOCK), buf_g.reshape(n_blocks, MOE_BLOCK), block_expert))
    return acc[:T]


def setup_inputs(seed: int = 0) -> dict:
    key = jax.random.key(seed)
    ks = jax.random.split(key, 24)
    f32 = jnp.float32
    beta = DEEPNORM_BETA

    def nrm(k, shape, fan_in, scale=1.0):
        return jax.random.normal(k, shape, f32) * (fan_in ** -0.5 * scale)

    col_scale = np.ones((N_IN,), np.float32)
    v0 = 2 * ATT_QK_WIDTH
    col_scale[v0:v0 + ATT_QK_WIDTH] = beta
    i0 = 3 * ATT_QK_WIDTH + 2 * HG_WIDTH
    col_scale[i0:i0 + HG_WIDTH] = beta

    return {
        'x': jax.random.normal(ks[0], (BATCH, SEQ, D_MODEL), f32),
        'p': jax.random.normal(ks[1], (DEPTH, BATCH, SEQ, PLE_DIM), f32),
        'w_in': nrm(ks[2], (DEPTH, D_MODEL, N_IN), D_MODEL) * jnp.asarray(col_scale),
        'hgrn_lb_logits': 0.1 * jax.random.normal(ks[3], (DEPTH + 1, HG_WIDTH), f32),
        'hgrn_norm_w': 1.0 + 0.05 * jax.random.normal(ks[4], (DEPTH, HG_WIDTH), f32),
        'w_branch_att': nrm(ks[5], (DEPTH, ATT_OUT_WIDTH, D_MODEL), ATT_OUT_WIDTH, beta),
        'w_branch_hgrn': nrm(ks[6], (DEPTH, HG_WIDTH, D_MODEL), HG_WIDTH, beta),
        'w_out': nrm(ks[7], (DEPTH, D_MODEL, D_MODEL), D_MODEL, beta),
        'ln1_w': 1.0 + 0.05 * jax.random.normal(ks[8], (DEPTH, D_MODEL), f32),
        'ln1_b': 0.02 * jax.random.normal(ks[9], (DEPTH, D_MODEL), f32),
        'router_w': nrm(ks[10], (DEPTH, D_MODEL, N_EXPERTS), D_MODEL),
        'router_bias': 0.01 * jax.random.normal(ks[11], (DEPTH, N_EXPERTS), f32),
        'expert_w_gate': nrm(ks[12], (DEPTH, N_EXPERTS, D_MODEL, EXPERT_FF), D_MODEL),
        'expert_w_up': nrm(ks[13], (DEPTH, N_EXPERTS, D_MODEL, EXPERT_FF), D_MODEL, beta),
        'expert_w_down': nrm(ks[14], (DEPTH, N_EXPERTS, EXPERT_FF, D_MODEL), EXPERT_FF, beta),
        'shared_w_gate': nrm(ks[15], (DEPTH, D_MODEL, SHARED_FF), D_MODEL),
        'shared_w_up': nrm(ks[16], (DEPTH, D_MODEL, SHARED_FF), D_MODEL, beta),
        'shared_w_down': nrm(ks[17], (DEPTH, SHARED_FF, D_MODEL), SHARED_FF, beta),
        'ple_gate_w': nrm(ks[18], (DEPTH, D_MODEL, D_MODEL), D_MODEL),
        'ple_proj_w': nrm(ks[19], (DEPTH, PLE_DIM, D_MODEL), PLE_DIM, beta),
        'ln2_w': 1.0 + 0.05 * jax.random.normal(ks[20], (DEPTH, D_MODEL), f32),
        'ln2_b': 0.02 * jax.random.normal(ks[21], (DEPTH, D_MODEL), f32),
    }


def reference(x, p, w_in, hgrn_lb_logits, hgrn_norm_w, w_branch_att, w_branch_hgrn, w_out,
              ln1_w, ln1_b, router_w, router_bias, expert_w_gate, expert_w_up, expert_w_down,
              shared_w_gate, shared_w_up, shared_w_down, ple_gate_w, ple_proj_w, ln2_w, ln2_b):
    B, S, D = x.shape
    split_points = np.cumsum(SPLIT_SIZES)[:-1].tolist()
    lower_bounds = jnp.cumsum(jax.nn.softmax(hgrn_lb_logits.astype(jnp.float32), axis=0), axis=0)

    def att_heads(t):
        return t.reshape(B, S, N_ATT_GROUPS, ATT_HEADS, ATT_HEAD_DIM)

    for l in range(DEPTH):
        u = x @ w_in[l]
        q_a, k_a, v_a, q_h, f_h, i_h, g_h, gate_a, gate_h = jnp.split(u, split_points, axis=-1)
        y_att = dilated_attention(att_heads(q_a), att_heads(k_a), att_heads(v_a))
        y_att = y_att.reshape(B, S, ATT_OUT_WIDTH).astype(x.dtype)
        o_h = hgrn2_recurrence(q_h, f_h, jax.nn.silu(i_h), lower_bounds[l])
        y_hg = (rms_norm_heads(o_h, hgrn_norm_w[l]) * jax.nn.silu(g_h.astype(jnp.float32))).astype(x.dtype)
        merged = (jax.nn.sigmoid(gate_a) * (y_att @ w_branch_att[l])
                  + jax.nn.sigmoid(gate_h) * (y_hg @ w_branch_hgrn[l]))
        x1 = layer_norm(DEEPNORM_ALPHA * x + merged @ w_out[l], ln1_w[l], ln1_b[l])

        h = x1.reshape(B * S, D)
        idx, gate = route(h, router_w[l], router_bias[l])
        y_moe = (routed_experts(h, idx, gate, expert_w_gate[l], expert_w_up[l], expert_w_down[l])
                 + swiglu(h, shared_w_gate[l], shared_w_up[l], shared_w_down[l]))
        ple = jax.nn.sigmoid(x1 @ ple_gate_w[l]) * (p[l] @ ple_proj_w[l])
        x = layer_norm(DEEPNORM_ALPHA * x1 + y_moe.reshape(B, S, D) + ple, ln2_w[l], ln2_b[l])
    return x
```

```cpp
#include <hip/hip_runtime.h>
#include <cstdio>
#include <cstdint>

#define LAS __attribute__((address_space(3)))
#define GAS __attribute__((address_space(1)))
#define DI __device__ __forceinline__
typedef unsigned short bf16;
typedef short bf16x8 __attribute__((ext_vector_type(8)));
typedef short s16x4 __attribute__((ext_vector_type(4)));
typedef short v4i16_t __attribute__((ext_vector_type(4)));
typedef float f32x2 __attribute__((ext_vector_type(2)));
typedef float f32x4 __attribute__((ext_vector_type(4)));
typedef float f32x16 __attribute__((ext_vector_type(16)));
typedef unsigned u32x2 __attribute__((ext_vector_type(2)));
typedef unsigned u32x4 __attribute__((ext_vector_type(4)));
typedef __bf16 bf16x2_t __attribute__((ext_vector_type(2)));
typedef int v8i32 __attribute__((ext_vector_type(8)));
typedef short s16x16 __attribute__((ext_vector_type(16)));

constexpr int NB = 8, SEQ = 4096, T = NB * SEQ, D = 1024;
constexpr int NIN = 10752, NATT = 4608, NHG = 4096, NGATE = 2048;
constexpr int NEXP = 64, TOPK = 8, EFF = 256;
constexpr int NBLK = 1, TB = T / NBLK;
constexpr int MAXTILES = TB * TOPK / 256 + NEXP;
constexpr int MAXROWS = MAXTILES * 256;
constexpr float LN_EPS = 1e-5f, RMS_EPS = 1e-6f;
constexpr float ALPHA = 1.18920711500272f;
constexpr float LOG2E = 1.4426950408889634f;
constexpr float QSCALE = 0.125f * LOG2E;
constexpr float W8S = 32.0f, W8I = 1.0f / 32.0f;
constexpr float HGS = 8.0f;
constexpr float YEI = 1.0f / (8.0f * 32.0f);

constexpr size_t MiB = 1u << 20;
constexpr size_t WS_CTL = 0, CTL_ZERO_BYTES = 64 * 1024;
constexpr size_t WS_TAB = 512 * 1024;
constexpr size_t WS_LISTS = 1 * MiB;
constexpr size_t WS_WIN8 = 1 * MiB, WS_WIN = 6 * MiB, WS_WA = 22 * MiB, WS_WH = 23 * MiB, WS_WO = 25 * MiB, WS_WPG = 27 * MiB, WS_WPP = 29 * MiB, WS_WSGU = 30 * MiB, WS_WSD = 31 * MiB, WS_WEGU8 = 32 * MiB, WS_X8 = 64 * MiB;
constexpr size_t WS_WRT = 29 * MiB + 512 * 1024;
constexpr size_t WS_PB = 96 * MiB, WS_HS = 112 * MiB;
constexpr size_t WS_XB = 128 * MiB;
constexpr size_t WS_R = 192 * MiB;
constexpr size_t WS_L = 448 * MiB;
constexpr size_t WS_YATT = 480 * MiB;
constexpr size_t WS_MERGED = 192 * MiB, WS_PRE1 = 256 * MiB, WS_X1B = 448 * MiB;
constexpr size_t WS_YE = 192 * MiB, WS_YE2 = 96 * MiB;
constexpr int YE_SPLIT = 262144;
constexpr size_t WS_END = 512 * MiB;
static_assert(WS_YE + (size_t)YE_SPLIT * 1024 <= WS_X1B && WS_YE2 + (size_t)(MAXROWS - YE_SPLIT) * 1024 <= 128 * MiB && (size_t)MAXROWS * 256 <= 96 * MiB, "ws map");
constexpr size_t LS_TOKE = 0, LS_TOKG = 1 * MiB, LS_POS = 2 * MiB, LS_TOKLIST = 3 * MiB, LS_GATELIST = 3 * MiB + (size_t)NBLK * MAXROWS * 4;
static_assert(LS_GATELIST + (size_t)NBLK * MAXROWS * 4 <= 7 * MiB, "lists");
constexpr size_t DO_LSE = 96 * MiB, DO_WED = 96 * MiB;
constexpr int TB_CNT = 0;
constexpr int TB_NT = 256 * 64;
constexpr int TB_TEXP = TB_NT + 4 * 64;
constexpr int TB_TCNT = TB_TEXP + 4 * MAXTILES;

constexpr int RING_BYTES = 131072, LDSCTL_OFF = RING_BYTES, MISC_OFF = LDSCTL_OFF + 320, TABL_OFF = LDSCTL_OFF + 1024, LDS_BYTES = 163840;

DI float bf2f(unsigned b) { return __uint_as_float(b << 16); }
DI unsigned f2bf(float f) { unsigned u = __float_as_uint(f); return (u + 0x7fffu + ((u >> 16) & 1u)) >> 16; }
DI unsigned pk2(float lo, float hi) { f32x2 v = {lo, hi}; bf16x2_t b = __builtin_convertvector(v, bf16x2_t); return __builtin_bit_cast(unsigned, b); }
DI unsigned pk4_fp8(float a, float b, float c, float d) { int w = 0; w = __builtin_amdgcn_cvt_pk_fp8_f32(a, b, w, false); w = __builtin_amdgcn_cvt_pk_fp8_f32(c, d, w, true); return (unsigned)w; }
DI f32x4 unpk4_fp8(unsigned w) { const f32x2 lo = __builtin_amdgcn_cvt_pk_f32_fp8((int)w, false), hi = __builtin_amdgcn_cvt_pk_f32_fp8((int)w, true); return (f32x4){lo.x, lo.y, hi.x, hi.y}; }
DI float sigmoidf_(float v) { return __builtin_amdgcn_rcpf(1.0f + __expf(-v)); }
DI float siluf_(float v) { return v * sigmoidf_(v); }
template <int M> DI float xshf(float v) {
    if constexpr (M == 32) { const auto rr = __builtin_amdgcn_permlane32_swap(__float_as_uint(v), __float_as_uint(v), false, false); return __uint_as_float(rr[0] == __float_as_uint(v) ? rr[1] : rr[0]); }
    else return __builtin_bit_cast(float, __builtin_amdgcn_ds_swizzle(__builtin_bit_cast(int, v), 0x1F | (M << 10)));
}
DI float xsum32(float v) { const auto rr = __builtin_amdgcn_permlane32_swap(__float_as_uint(v), __float_as_uint(v), false, false); return __uint_as_float(rr[0]) + __uint_as_float(rr[1]); }
DI float xmax32(float v) { const auto rr = __builtin_amdgcn_permlane32_swap(__float_as_uint(v), __float_as_uint(v), false, false); return fmaxf(__uint_as_float(rr[0]), __uint_as_float(rr[1])); }
DI float wave_sum(float v) {
    v += xshf<1>(v); v += xshf<2>(v); v += xshf<4>(v); v += xshf<8>(v); v += xshf<16>(v);
    return xsum32(v);
}
DI int lane_id_asm() { int l; asm volatile("v_mbcnt_lo_u32_b32 %0, -1, 0\n\tv_mbcnt_hi_u32_b32 %0, -1, %0" : "=v"(l)); return l & 63; }
DI int crow(int r, int hi) { return (r & 3) + 8 * (r >> 2) + 4 * hi; }
DI s16x4 vtr(const LAS unsigned char* p) { return __builtin_bit_cast(s16x4, __builtin_amdgcn_ds_read_tr16_b64_v4i16((LAS v4i16_t*)p)); }
DI bf16x8 cat8(s16x4 lo, s16x4 hi) { return (bf16x8){lo[0], lo[1], lo[2], lo[3], hi[0], hi[1], hi[2], hi[3]}; }
DI bf16x8 pack8(const f32x16& x, int s) {
    u32x4 p; p.x = pk2(x[8 * s], x[8 * s + 1]); p.y = pk2(x[8 * s + 2], x[8 * s + 3]); p.z = pk2(x[8 * s + 4], x[8 * s + 5]); p.w = pk2(x[8 * s + 6], x[8 * s + 7]);
    return __builtin_bit_cast(bf16x8, p);
}
#define MFMA32(a, b, c) __builtin_amdgcn_mfma_f32_32x32x16_bf16((a), (b), (c), 0, 0, 0)

#define XB_TMO      128
#define XB_XCNT(j)  (256  + 64 * (j))
#define XB_XSUB(j)  (1280 + 64 * (j))
#define XB_XGEN(j)  (2304 + 64 * (j))
#define XB_TOP      3328
#define XB_TOPGEN   3392
#define XCD_BAR_WORDS 3456
#define XB_SPIN_CAP (1u << 18)
DI unsigned xb_ld(unsigned* p)              { return __hip_atomic_load(p, __ATOMIC_RELAXED, __HIP_MEMORY_SCOPE_AGENT); }
DI unsigned xb_add(unsigned* p, unsigned v) { return __hip_atomic_fetch_add(p, v, __ATOMIC_RELAXED, __HIP_MEMORY_SCOPE_AGENT); }
DI unsigned xb_xcc_id() { return (unsigned)__builtin_amdgcn_s_getreg((3 << 11) | 20) & 0xFu; }
#define XB_SPIN(cond, bar) do { unsigned _sp = 0; while (cond) { __builtin_amdgcn_s_sleep(1); \
    if ((++_sp & 255u) == 0u) { if (xb_ld(&(bar)[XB_TMO])) break; if (_sp > XB_SPIN_CAP) { atomicAdd(&(bar)[XB_TMO], 1u); break; } } } } while (0)
struct XcdBarrier { unsigned* bar; unsigned x; volatile LAS unsigned* st; };
DI XcdBarrier xcd_barrier_post(unsigned* bar, volatile LAS unsigned* st, bool leader) {
    XcdBarrier b; b.bar = bar; b.x = xb_xcc_id(); b.st = st;
    if (leader) (void)xb_add(&bar[XB_XCNT(b.x)], 1u);
    return b;
}
DI void xcd_barrier_complete(unsigned* bar, unsigned x, unsigned& nloc, unsigned& nx) {
    const unsigned G = gridDim.x * gridDim.y * gridDim.z;
    unsigned sum, cnt, mine, sp = 0u;
    for (;;) {
        sum = 0u; cnt = 0u; mine = 0u;
#pragma unroll
        for (unsigned j = 0; j < 16; ++j) { const unsigned c = xb_ld(&bar[XB_XCNT(j)]); sum += c; cnt += (c > 0u) ? 1u : 0u; mine = (j == x) ? c : mine; }
        if (sum == G) break;
        __builtin_amdgcn_s_sleep(1);
        if ((++sp & 255u) == 0u) { if (xb_ld(&bar[XB_TMO])) break; if (sp > XB_SPIN_CAP) { atomicAdd(&bar[XB_TMO], 1u); break; } }
    }
    nloc = mine > 0u ? mine : 1u; nx = cnt > 0u ? cnt : 1u;
}
DI void xcd_barrier(const XcdBarrier& b, bool leader) {
    asm volatile("s_waitcnt vmcnt(0)" ::: "memory");
    __syncthreads();
    if (leader) {
        unsigned* bar = b.bar;
        __builtin_amdgcn_s_waitcnt(0);
        unsigned nloc = b.st[0], nx = b.st[1];
        if (nloc == 0u) { xcd_barrier_complete(bar, b.x, nloc, nx); b.st[0] = nloc; b.st[1] = nx; }
        const unsigned old = xb_add(&bar[XB_XSUB(b.x)], 1u);
        const unsigned gen = old / nloc;
        if (old + 1u == (gen + 1u) * nloc) {
            __builtin_amdgcn_fence(__ATOMIC_RELEASE, "agent");
            asm volatile("s_waitcnt vmcnt(0)" ::: "memory");
            const unsigned og = xb_add(&bar[XB_TOP], 1u);
            const unsigned tg = og / nx;
            if (og + 1u == (tg + 1u) * nx) xb_add(&bar[XB_TOPGEN], 1u);
            else XB_SPIN(xb_ld(&bar[XB_TOPGEN]) == tg, bar);
            __builtin_amdgcn_fence(__ATOMIC_ACQUIRE, "agent");
            xb_add(&bar[XB_XGEN(b.x)], 1u);
            asm volatile("s_waitcnt vmcnt(0)" ::: "memory");
        } else {
            XB_SPIN(xb_ld(&bar[XB_XGEN(b.x)]) == gen, bar);
            __builtin_amdgcn_fence(__ATOMIC_ACQUIRE, "agent");
            asm volatile("s_waitcnt vmcnt(0)" ::: "memory");
        }
    }
    __syncthreads();
}

namespace pg8 {
constexpr int BM = 256, BK = 64, HALF = 128, HTB = HALF * BK * 2, STAGE_BYTES = 8 * HTB, NXCD = 8, WGM = 8;
DI int lds_byte(int r, int c) { const int st = (r >> 4) * 2 + (c >> 5), rr = r & 15, cc = c & 31, ob = rr * 64 + cc * 2; return st * 1024 + (ob ^ (((ob >> 9) & 1) << 5)); }
DI void stage_rc(int b, int& R, int& C) { const int st = b / 1024, sb = b % 1024, swz = sb ^ (((sb >> 9) & 1) << 5); R = (st >> 1) * 16 + swz / 64; C = (st & 1) * 32 + (swz % 64) / 2; }
DI int perm32(int rho) { const int n = rho >> 4, i = rho & 15; return 8 * (i >> 2) + 4 * n + (i & 3); }
DI void glds16_s(const char* sbase, unsigned voff, unsigned lds_dst) { unsigned keep;
    asm volatile("s_mov_b32 %0, m0\n\ts_mov_b32 m0, %3\n\ts_nop 0\n\tglobal_load_lds_dwordx4 %1, %2\n\ts_mov_b32 m0, %0" : "=&s"(keep) : "v"(voff), "s"(sbase), "s"(lds_dst) : "memory"); }
struct Unit { int pm, pn; };
struct StaticOrder {
    int nM, nN, nwg, G, c;
    DI void init(int M, int N, int G_, int c_) { nM = M / BM; nN = N / BM; nwg = nM * nN; G = G_; c = c_; }
    DI bool next(int i, Unit& u) const {
        const long L = (long)i * G + c; if (L >= nwg) return false;
        int wgid = (int)L; { const int q = nwg / NXCD, r = nwg % NXCD, xcd = wgid % NXCD, off = wgid / NXCD; wgid = (xcd < r ? xcd * (q + 1) : r * (q + 1) + (xcd - r) * q) + off; }
        const int nig = WGM * nN, gid = wgid / nig, fm = gid * WGM, gsz = (nM - fm) < WGM ? (nM - fm) : WGM;
        u.pm = fm + ((wgid % nig) % gsz); u.pn = (wgid % nig) / gsz; return true;
    }
};
template <class P>
DI void gemm_phase(LAS unsigned char* lds, const P& S, const int wave0) {
    const int tid = wave0 * 64 + lane_id_asm();
    const int wid = __builtin_amdgcn_readfirstlane(tid >> 6), lane = tid & 63, wr = wid >> 2, wc = wid & 3, fr = lane & 15, fq = lane >> 4;
    const int K = S.K, nt = K / BK;
    int Rr[2], Cc[2];
    unsigned voffB[2], vcur[2][2];
    const size_t hstep = (size_t)HALF * K * 2;
#pragma unroll
    for (int i = 0; i < 2; ++i) { stage_rc(tid * 16 + i * 8192, Rr[i], Cc[i]); const int Rb = P::PERM ? ((Rr[i] & ~31) + perm32(Rr[i] & 31)) : Rr[i];
        voffB[i] = (unsigned)(Rb * K + Cc[i]) * 2u; }
    const size_t kstep = (size_t)(BK * 2);
    const unsigned ldsw = (unsigned)wid * 1024u;
    const unsigned ldsbase = (unsigned)(size_t)lds;
    const int aoff = lds_byte(wr * 64 + fr, fq * 8); int boff = lds_byte(wc * 32 + fr, fq * 8) + 4 * HTB;
    asm volatile("" : "+v"(boff));
#define PG8_SA(b, h) (((b) * 2 + (h)) * HTB)
#define PG8_SB(b, h) ((4 + (b) * 2 + (h)) * HTB)
#define PG8_SBR(b, h) (((b) * 2 + (h)) * HTB)
#define PG8_STAGE(bufoff, gbase, voff) do { _Pragma("unroll") for (int _i = 0; _i < 2; ++_i) \
        glds16_s((const char*)(gbase), (voff)[_i], ldsbase + (unsigned)((bufoff) + _i * 8192) + ldsw); } while (0)
#define PG8_LDA(dst, b, h) do { _Pragma("unroll") for (int m = 0; m < 4; ++m) _Pragma("unroll") for (int k = 0; k < 2; ++k) dst[m][k] = *(const LAS bf16x8*)(lds + PG8_SA(b, h) + aoff + m * 2048 + k * 1024); } while (0)
#define PG8_LDB(dst, b, h) do { _Pragma("unroll") for (int n = 0; n < 2; ++n) _Pragma("unroll") for (int k = 0; k < 2; ++k) dst[n][k] = *(const LAS bf16x8*)(lds + boff + (PG8_SBR(b, h) + n * 2048 + k * 1024)); } while (0)
#define PG8_CAT(x) __builtin_bit_cast(v8i32, __builtin_shufflevector((x)[0], (x)[1], 0, 1, 2, 3, 4, 5, 6, 7, 8, 9, 10, 11, 12, 13, 14, 15))
#define PG8_MMA(ai, bj, At, Bt) do { __builtin_amdgcn_s_setprio(1); _Pragma("unroll") for (int m = 0; m < 4; ++m) _Pragma("unroll") for (int n = 0; n < 2; ++n) { \
        if constexpr (P::FP8) acc[ai][bj][m][n] = __builtin_amdgcn_mfma_scale_f32_16x16x128_f8f6f4(PG8_CAT(Bt[n]), PG8_CAT(At[m]), acc[ai][bj][m][n], 0, 0, 0, 0x7f7f7f7f, 0, 0x7f7f7f7f); \
        else { _Pragma("unroll") for (int k = 0; k < 2; ++k) acc[ai][bj][m][n] = __builtin_amdgcn_mfma_f32_16x16x32_bf16(Bt[n][k], At[m][k], acc[ai][bj][m][n], 0, 0, 0); } } \
        __builtin_amdgcn_s_setprio(0); } while (0)
#define PG8_A1(p) (P::GATHER ? (p) : (p) + hstep)
#define PG8_V1 vcur[P::GATHER ? 1 : 0]
#define PG8_WAIT_V(n) asm volatile("s_waitcnt vmcnt(" #n ")" ::: "memory")
#define PG8_WAIT_L(n) asm volatile("s_waitcnt lgkmcnt(" #n ")" ::: "memory")
#define PG8_BAR __builtin_amdgcn_s_barrier()
#define PG8_SCHED __builtin_amdgcn_sched_barrier(0)
    Unit cur, nxt; int ui = 0;
    if (!S.next(0, cur)) return;
#define PG8_AOFFS(dst, u) do { const int _t = wave0 * 64 + lane_id_asm(); _Pragma("unroll") for (int _i = 0; _i < 2; ++_i) { int _R, _C; stage_rc(_t * 16 + _i * 8192, _R, _C); \
        _Pragma("unroll") for (int _h = 0; _h < 2; ++_h) \
        dst[_h][_i] = P::GATHER ? (unsigned)(((size_t)S.gather_row(u, _h * HALF + _R) * K + _C) * 2u) : (unsigned)((size_t)(_R * K + _C) * 2u); } } while (0)
    PG8_AOFFS(vcur, cur);
    LAS u32x4* const gslot = (LAS u32x4*)(lds + (TABL_OFF + 6144)) + tid;
    f32x4 acc[2][2][4][2];
#pragma unroll
    for (int a = 0; a < 2; ++a)
#pragma unroll
        for (int b = 0; b < 2; ++b)
#pragma unroll
            for (int m = 0; m < 4; ++m)
#pragma unroll
                for (int n = 0; n < 2; ++n) acc[a][b][m][n] = (f32x4){0.f, 0.f, 0.f, 0.f};
    bf16x8 At[4][2], B0[2][2], B1[2][2];
    const char* cA = S.a_ptr(cur); const char* cB = S.b_ptr(cur);
    PG8_STAGE(PG8_SB(0, 0), cB, voffB); PG8_STAGE(PG8_SB(0, 1), cB + hstep, voffB); PG8_STAGE(PG8_SA(0, 0), cA, vcur[0]); PG8_STAGE(PG8_SA(0, 1), PG8_A1(cA), PG8_V1);
    if (wr == 1) PG8_BAR;
    PG8_WAIT_V(2); PG8_BAR;
    PG8_STAGE(PG8_SB(1, 0), cB + kstep, voffB); PG8_STAGE(PG8_SA(1, 0), cA + kstep, vcur[0]); PG8_STAGE(PG8_SB(1, 1), cB + hstep + kstep, voffB);
    PG8_WAIT_V(6); PG8_BAR;
    for (;;) {
        const bool has_next = S.next(ui + 1, nxt);
        const char* nA = has_next ? S.a_ptr(nxt) : cA; const char* nB = has_next ? S.b_ptr(nxt) : cB;
        if (P::GATHER) { if (has_next) { unsigned vn_[2][2]; PG8_AOFFS(vn_, nxt); *gslot = (u32x4){vn_[0][0], vn_[0][1], vn_[1][0], vn_[1][1]}; } }
        for (int t = 0; t < nt; t += 2) {
            const bool last = (t == nt - 2);
            const char* a1 = cA + (size_t)(t + 1) * kstep;
            const char* a2 = last ? nA : cA + (size_t)(t + 2) * kstep; const char* b2 = last ? nB : cB + (size_t)(t + 2) * kstep;
            const char* a3 = a2 + kstep; const char* b3 = b2 + kstep;
            PG8_LDB(B0, 0, 0); PG8_LDB(B1, 0, 1); PG8_SCHED; PG8_LDA(At, 0, 0); PG8_STAGE(PG8_SA(1, 1), PG8_A1(a1), PG8_V1);
            PG8_WAIT_V(8); PG8_WAIT_L(0); PG8_BAR; PG8_MMA(0, 0, At, B0); PG8_MMA(0, 1, At, B1); PG8_BAR; PG8_SCHED;
            if (P::GATHER) { if (last && has_next) { const u32x4 vn_ = *gslot; vcur[0][0] = vn_.x; vcur[0][1] = vn_.y; vcur[1][0] = vn_.z; vcur[1][1] = vn_.w; } }
            PG8_LDA(At, 0, 1); PG8_STAGE(PG8_SB(0, 0), b2, voffB); PG8_STAGE(PG8_SB(0, 1), b2 + hstep, voffB); PG8_STAGE(PG8_SA(0, 0), a2, vcur[0]);
            PG8_WAIT_V(8); PG8_WAIT_L(0); PG8_BAR; PG8_MMA(1, 0, At, B0); PG8_MMA(1, 1, At, B1); PG8_BAR; PG8_SCHED;
            PG8_LDB(B0, 1, 0); PG8_LDB(B1, 1, 1); PG8_SCHED; PG8_LDA(At, 1, 0); PG8_STAGE(PG8_SA(0, 1), PG8_A1(a2), PG8_V1);
            PG8_WAIT_V(8); PG8_WAIT_L(0); PG8_BAR; PG8_MMA(0, 0, At, B0); PG8_MMA(0, 1, At, B1); PG8_BAR; PG8_SCHED;
            PG8_LDA(At, 1, 1); PG8_STAGE(PG8_SB(1, 0), b3, voffB); PG8_STAGE(PG8_SB(1, 1), b3 + hstep, voffB); PG8_STAGE(PG8_SA(1, 0), a3, vcur[0]);
            PG8_WAIT_V(8); PG8_WAIT_L(0); PG8_BAR; PG8_MMA(1, 0, At, B0); PG8_MMA(1, 1, At, B1); PG8_BAR; PG8_SCHED;
        }
        if (wr == 0) PG8_BAR;
        PG8_SCHED;
        { const int l2 = lane_id_asm();
          S.epi(acc, cur, wave0 >> 2, wave0 & 3, l2 & 15, l2 >> 4); }
        if (!has_next) break;
#pragma unroll
        for (int a = 0; a < 2; ++a)
#pragma unroll
            for (int b = 0; b < 2; ++b)
#pragma unroll
                for (int m = 0; m < 4; ++m)
#pragma unroll
                    for (int n = 0; n < 2; ++n) acc[a][b][m][n] = (f32x4){0.f, 0.f, 0.f, 0.f};
        cur = nxt; cA = nA; cB = nB; ++ui;
        if (wr == 1) PG8_BAR;
    }
    PG8_WAIT_V(0);
    PG8_BAR;
#undef PG8_AOFFS
#undef PG8_SA
#undef PG8_SB
#undef PG8_SBR
#undef PG8_STAGE
#undef PG8_LDA
#undef PG8_LDB
#undef PG8_MMA
#undef PG8_CAT
#undef PG8_WAIT_V
#undef PG8_A1
#undef PG8_V1
#undef PG8_WAIT_L
#undef PG8_BAR
#undef PG8_SCHED
}
}
using pg8::Unit;
typedef f32x4 AccT[2][2][4][2];

struct Args {
    const float* x; const float* p; const float* w_in; const float* lb_logits; const float* hg_norm_w; const float* w_a; const float* w_h; const float* w_o;
    const float* ln1_w; const float* ln1_b; const float* router_w; const float* router_b; const float* ew_gate; const float* ew_up; const float* ew_down;
    const float* sw_gate; const float* sw_up; const float* sw_down; const float* w_pg; const float* w_pp; const float* ln2_w; const float* ln2_b;
    float* out; unsigned char* ws;
};
struct Frame { LAS unsigned char* lds; int tid, lane, wave, G, bid; };

#define LAMBDA_INL __attribute__((always_inline))
struct TrItem { const float* W; unsigned char* WT; int ldw, ldt, k0, n0, drow0, f8; };
DI void tr_load(const TrItem& d, int lane, float (&v)[32]) {
#pragma unroll
    for (int i = 0; i < 32; ++i) v[i] = __builtin_nontemporal_load(d.W + (size_t)(d.k0 + 2 * i + (lane >> 5)) * d.ldw + d.n0 + (lane & 31));
}
DI void tr_store(const TrItem& d, const float (&v)[32], LAS float* scr, int lane) {
#pragma unroll
    for (int i = 0; i < 32; ++i) scr[(2 * i + (lane >> 5)) * 33 + (lane & 31)] = v[i];
    asm volatile("s_waitcnt lgkmcnt(0)" ::: "memory");
    const int c = lane & 7;
#pragma unroll
    for (int j = 0; j < 4; ++j) { const int n = (lane >> 3) + 8 * j; const LAS float* s = scr + (8 * c) * 33 + n;
        if (d.f8) { u32x2 o; o.x = pk4_fp8(s[0 * 33] * W8S, s[1 * 33] * W8S, s[2 * 33] * W8S, s[3 * 33] * W8S); o.y = pk4_fp8(s[4 * 33] * W8S, s[5 * 33] * W8S, s[6 * 33] * W8S, s[7 * 33] * W8S);
            *(u32x2*)(d.WT + (size_t)(d.drow0 + n) * d.ldt + d.k0 + 8 * c) = o; }
        else { u32x4 o; o.x = pk2(s[0 * 33], s[1 * 33]); o.y = pk2(s[2 * 33], s[3 * 33]); o.z = pk2(s[4 * 33], s[5 * 33]); o.w = pk2(s[6 * 33], s[7 * 33]);
            *(u32x4*)((bf16*)d.WT + (size_t)(d.drow0 + n) * d.ldt + d.k0 + 8 * c) = o; } }
    asm volatile("s_waitcnt lgkmcnt(0)" ::: "memory");
}
DI TrItem tr_plain_item(const float* W, int N, void* WT, int ldt, int f8, int r) { const int nblk = N / 32, kb = r / nblk, nb = r % nblk; return TrItem{W, (unsigned char*)WT, N, ldt, 64 * kb, 32 * nb, 32 * nb, f8}; }
DI TrItem tr_gu_item(const float* Wg, const float* Wu, void* WT, int f8, int r) { const int which = r >> 7, rr = r & 127, kb = rr >> 3, nb = rr & 7, n0 = 32 * nb;
    return TrItem{which ? Wu : Wg, (unsigned char*)WT, 256, 1024, 64 * kb, n0, (n0 >> 7) * 256 + which * 128 + (n0 & 127), f8}; }
constexpr int I_WIN = 16 * (NIN / 32), I_WA = 8 * 32, I_WH = 16 * 32, I_WPP = 4 * 32, I_SGU = 256, I_SD = 4 * 32, I_WR = 16 * 2, I_EGU = 64 * 256;
constexpr int P0_NITEMS = I_WIN + I_WA + 3 * I_WH + I_WPP + I_SGU + I_SD + I_WR + I_EGU;
DI TrItem p0_item(const Args& a, int it) {
    unsigned char* ws = a.ws; int r = it;
    if (r < I_WIN) return tr_plain_item(a.w_in, NIN, ws + WS_WIN8, 1024, 1, r); r -= I_WIN;
    if (r < I_WA) return tr_plain_item(a.w_a, 1024, ws + WS_WA, 512, 1, r); r -= I_WA;
    if (r < I_WH) return tr_plain_item(a.w_h, 1024, ws + WS_WH, 1024, 1, r); r -= I_WH;
    if (r < I_WH) return tr_plain_item(a.w_o, 1024, ws + WS_WO, 1024, 1, r); r -= I_WH;
    if (r < I_WH) return tr_plain_item(a.w_pg, 1024, ws + WS_WPG, 1024, 1, r); r -= I_WH;
    if (r < I_WPP) return tr_plain_item(a.w_pp, 1024, ws + WS_WPP, 256, 0, r); r -= I_WPP;
    if (r < I_SGU) return tr_gu_item(a.sw_gate, a.sw_up, ws + WS_WSGU, 0, r); r -= I_SGU;
    if (r < I_SD) return tr_plain_item(a.sw_down, 1024, ws + WS_WSD, 256, 0, r); r -= I_SD;
    if (r < I_WR) return tr_plain_item(a.router_w, 64, ws + WS_WRT, 1024, 0, r); r -= I_WR;
    const int e = r >> 8; return tr_gu_item(a.ew_gate + (size_t)e * 1024 * 256, a.ew_up + (size_t)e * 1024 * 256, ws + WS_WEGU8 + (size_t)e * 512 * 1024, 1, r & 255);
}
DI TrItem p8_item(const Args& a, unsigned char* wed, int it) { const int e = it >> 7; return tr_plain_item(a.ew_down + (size_t)e * 256 * 1024, 1024, wed + (size_t)e * 1024 * 256, 256, 1, it & 127); }
template <class ItemFn>
DI void tr_run(const Frame& F, int nitems, ItemFn item) {
    LAS float* scr = (LAS float*)(F.lds + F.wave * 16384);
    const int gw = F.bid * 8 + F.wave, NGW = F.G * 8;
    float va[32], vb[32]; TrItem da, db; int it = gw;
    if (it < nitems) { da = item(it); tr_load(da, F.lane, va); }
    for (; it < nitems; it += 2 * NGW) {
        const int it2 = it + NGW, it3 = it2 + NGW;
        if (it2 < nitems) { db = item(it2); tr_load(db, F.lane, vb); }
        tr_store(da, va, scr, F.lane);
        if (it3 < nitems) { da = item(it3); tr_load(da, F.lane, va); }
        if (it2 < nitems) tr_store(db, vb, scr, F.lane);
    }
}
DI void p0_prologue(const Frame& F, const Args& a) {
    tr_run(F, P0_NITEMS, [&](int it) LAMBDA_INL { return p0_item(a, it); });
    unsigned char* ws = a.ws; const int gw = F.bid * 8 + F.wave, NGW = F.G * 8;
    for (int m0 = gw * 4; m0 < T; m0 += NGW * 4) {
        f32x4 v[4][4];
#pragma unroll
        for (int q = 0; q < 4; ++q)
#pragma unroll
            for (int j = 0; j < 4; ++j) v[q][j] = __builtin_nontemporal_load((const f32x4*)(a.x + (size_t)(m0 + q) * D) + F.lane + 64 * j);
#pragma unroll
        for (int q = 0; q < 4; ++q) { unsigned* o4 = (unsigned*)(ws + WS_X8 + (size_t)(m0 + q) * D) + F.lane;
#pragma unroll
            for (int j = 0; j < 4; ++j) { const f32x4 w4 = v[q][j]; o4[64 * j] = pk4_fp8(w4.x, w4.y, w4.z, w4.w); } }
    }
}

struct DenseBase {
    static constexpr bool GATHER = false, FP8 = false;
    pg8::StaticOrder S; const char* A; const char* Bt; int K;
    DI void init(const void* A_, const void* Bt_, int M, int N, int K_, int G, int c) { A = (const char*)A_; Bt = (const char*)Bt_; K = K_; S.init(M, N, G, c); }
    DI bool next(int i, Unit& u) const { return S.next(i, u); }
    DI const char* a_ptr(const Unit& u) const { return A + (size_t)u.pm * 256 * K * 2; }
    DI const char* b_ptr(const Unit& u) const { return Bt + (size_t)u.pn * 256 * K * 2; }
    DI int gather_row(const Unit&, int) const { return 0; }
};
DI u32x4 pack_bf8(const f32x4& v0, const f32x4& v1) { u32x4 w; w.x = pk2(v0[0], v0[1]); w.y = pk2(v0[2], v0[3]); w.z = pk2(v1[0], v1[1]); w.w = pk2(v1[2], v1[3]); return w; }
DI void unpack_bf8(const u32x4& w, f32x4& v0, f32x4& v1) {
    v0 = (f32x4){bf2f(w.x & 0xffffu), bf2f(w.x >> 16), bf2f(w.y & 0xffffu), bf2f(w.y >> 16)};
    v1 = (f32x4){bf2f(w.z & 0xffffu), bf2f(w.z >> 16), bf2f(w.w & 0xffffu), bf2f(w.w >> 16)};
}
template <class Fn> DI void epi_walk(const AccT& acc, const Unit& u, int wr, int wc, int fr, int fq, Fn fn) {
#pragma unroll
    for (int ai = 0; ai < 2; ++ai)
#pragma unroll
        for (int m = 0; m < 4; ++m) { const int row = u.pm * 256 + ai * 128 + wr * 64 + m * 16 + fr;
#pragma unroll
            for (int bj = 0; bj < 2; ++bj) { const int col = u.pn * 256 + bj * 128 + wc * 32 + 8 * fq; fn(row, col, bj, acc[ai][bj][m][0], acc[ai][bj][m][1]); } }
}

template <class Op, class Ld, class Fn> DI void epi_walk_ld(const AccT& acc, const Unit& u, int wr, int wc, int fr, int fq, Ld ld, Fn fn) {
#pragma unroll
    for (int ai = 0; ai < 2; ++ai) {
        Op ops[4][2];
#pragma unroll
        for (int m = 0; m < 4; ++m)
#pragma unroll
            for (int bj = 0; bj < 2; ++bj) ops[m][bj] = ld(u.pm * 256 + ai * 128 + wr * 64 + m * 16 + fr, u.pn * 256 + bj * 128 + wc * 32 + 8 * fq);
#pragma unroll
        for (int m = 0; m < 4; ++m)
#pragma unroll
            for (int bj = 0; bj < 2; ++bj) fn(u.pm * 256 + ai * 128 + wr * 64 + m * 16 + fr, u.pn * 256 + bj * 128 + wc * 32 + 8 * fq, acc[ai][bj][m][0], acc[ai][bj][m][1], ops[m][bj]);
    }
}
constexpr int XR_RING = 3 * 16384, XR_TAIL = TABL_OFF + 6144;
constexpr int XL_UNITS = 10, XL_TOK = TABL_OFF + 6144 + 8192, XL_GATE = XL_TOK + XL_UNITS * 512;
static_assert(XL_GATE + XL_UNITS * 1024 <= LDS_BYTES && (MAXTILES + 127) / 128 <= XL_UNITS, "MoE list images");
template <class Fn> DI void epi_walk_rows(const AccT& acc, const Unit& u, int wr, int wc, int fr, int fq, LAS unsigned char* lds, bf16* O, int ldo, Fn fn) {
    const int tid = (wr * 4 + wc) * 64 + fq * 16 + fr, wrow = wr * 16 + fr, rl = tid >> 5;
    const int woff = wrow * 512 + (((wc * 4 + fq) ^ (wrow & 7)) << 4);
    const int roff = rl * 512 + ((tid & 31) << 4);
    bf16* gp = O + (size_t)(u.pm * 256 + rl) * ldo + u.pn * 256 + (((tid & 31) ^ (rl & 7)) << 3);
#pragma unroll
    for (int ai = 0; ai < 2; ++ai)
#pragma unroll
        for (int m = 0; m < 4; ++m) { LAS unsigned char* xb = lds + ((m & 1) ? XR_TAIL : XR_RING);
#pragma unroll
            for (int bj = 0; bj < 2; ++bj) *(LAS u32x4*)(xb + woff + bj * 256) = fn(u.pm * 256 + ai * 128 + wr * 64 + m * 16 + fr, u.pn * 256 + bj * 128 + wc * 32 + 8 * fq, bj, acc[ai][bj][m][0], acc[ai][bj][m][1]);
            asm volatile("s_waitcnt lgkmcnt(0)" ::: "memory"); __builtin_amdgcn_s_barrier(); asm volatile("" ::: "memory");
#pragma unroll
            for (int j = 0; j < 2; ++j) { const u32x4 v = *(const LAS u32x4*)(xb + roff + j * 8192); *(u32x4*)(gp + (size_t)(ai * 128 + m * 16 + j * 64) * ldo) = v; } }
}
struct ProbQKV : DenseBase { static constexpr bool PERM = true, FP8 = true; bf16* O; LAS unsigned char* xl;
    DI void epi(const AccT& acc, const Unit& u, int wr, int wc, int fr, int fq) const {
        const float sc = (u.pn < 6 ? QSCALE : 1.0f) * W8I; bf16* o = O;
        epi_walk_rows(acc, u, wr, wc, fr, fq, xl, o, NATT, [=](int, int, int, f32x4 v0, f32x4 v1) LAMBDA_INL { return pack_bf8(v0 * sc, v1 * sc); });
    } };
struct ProbHG : DenseBase { static constexpr bool PERM = true, FP8 = true; bf16* R2; bf16* gates; const float* lbl;
    DI void epi(const AccT& acc, const Unit& u, int wr, int wc, int fr, int fq) const {
        const int seg = u.pn >> 2; bf16* r2 = R2; bf16* gt = gates;
        if (seg == 0) { epi_walk(acc, u, wr, wc, fr, fq, [=](int row, int col, int, f32x4 v0, f32x4 v1) LAMBDA_INL { *((u32x4*)(r2 + (size_t)row * NHG + col)) = pack_bf8(v0 * W8I, v1 * W8I); }); }
        else if (seg == 1) {
            const float* lbp = lbl + (u.pn - 4) * 256 + wc * 32 + 8 * fq;
            float la[2][8];
#pragma unroll
            for (int bj = 0; bj < 2; ++bj) { const f32x4 a0 = *(const f32x4*)(lbp + bj * 128), a1 = *(const f32x4*)(lbp + bj * 128 + 4), b0 = *(const f32x4*)(lbp + 1024 + bj * 128), b1 = *(const f32x4*)(lbp + 1024 + bj * 128 + 4);
#pragma unroll
                for (int j = 0; j < 4; ++j) { la[bj][j] = __builtin_amdgcn_rcpf(1.0f + __expf(b0[j] - a0[j])); la[bj][4 + j] = __builtin_amdgcn_rcpf(1.0f + __expf(b1[j] - a1[j])); } }
            epi_walk(acc, u, wr, wc, fr, fq, [&](int row, int col, int bj, f32x4 v0, f32x4 v1) LAMBDA_INL {
#pragma unroll
                for (int j = 0; j < 4; ++j) { const float l0 = bj ? la[1][j] : la[0][j], l1 = bj ? la[1][4 + j] : la[0][4 + j];
                    v0[j] = __logf(l0 + (1.0f - l0) * sigmoidf_(v0[j] * W8I)); v1[j] = __logf(l1 + (1.0f - l1) * sigmoidf_(v1[j] * W8I)); }
                *((u32x4*)(r2 + (size_t)row * NHG + col)) = pack_bf8(v0, v1); });
        } else if (seg < 4) {
            epi_walk(acc, u, wr, wc, fr, fq, [=](int row, int col, int, f32x4 v0, f32x4 v1) LAMBDA_INL {
#pragma unroll
                for (int j = 0; j < 4; ++j) { v0[j] = siluf_(v0[j] * W8I); v1[j] = siluf_(v1[j] * W8I); }
                *((u32x4*)(r2 + (size_t)row * NHG + col)) = pack_bf8(v0, v1); });
        } else {
            epi_walk(acc, u, wr, wc, fr, fq, [=](int row, int col, int, f32x4 v0, f32x4 v1) LAMBDA_INL {
#pragma unroll
                for (int j = 0; j < 4; ++j) { v0[j] = sigmoidf_(v0[j] * W8I); v1[j] = sigmoidf_(v1[j] * W8I); }
                *((u32x4*)(gt + (size_t)row * NGATE + (col - 4096))) = pack_bf8(v0, v1); });
        }
    } };
struct ProbBrA : DenseBase { static constexpr bool PERM = true, FP8 = true; const bf16* gates; bf16* O;
    DI void epi(const AccT& acc, const Unit& u, int wr, int wc, int fr, int fq) const {
        const bf16* gt = gates; bf16* o = O;
        epi_walk_ld<u32x4>(acc, u, wr, wc, fr, fq, [=](int row, int col) LAMBDA_INL { return *(const u32x4*)(gt + (size_t)row * NGATE + col); },
            [=](int row, int col, f32x4 v0, f32x4 v1, u32x4 gw) LAMBDA_INL { f32x4 g0, g1; unpack_bf8(gw, g0, g1); *(u32x4*)(o + (size_t)row * D + col) = pack_bf8(v0 * g0 * W8I, v1 * g1 * W8I); });
    } };
constexpr float MGS = 8.0f;
struct ProbBrH : DenseBase { static constexpr bool PERM = true, FP8 = true; const bf16* gates; const bf16* M1; unsigned char* O;
    DI void epi(const AccT& acc, const Unit& u, int wr, int wc, int fr, int fq) const {
        const bf16* gt = gates; const bf16* m1 = M1; unsigned char* o = O;
        struct Op2 { u32x4 g, p; };
        epi_walk_ld<Op2>(acc, u, wr, wc, fr, fq, [=](int row, int col) LAMBDA_INL { return Op2{*(const u32x4*)(gt + (size_t)row * NGATE + 1024 + col), *(const u32x4*)(m1 + (size_t)row * D + col)}; },
            [=](int row, int col, f32x4 v0, f32x4 v1, Op2 w) LAMBDA_INL {
                f32x4 g0, g1, p0, p1; unpack_bf8(w.g, g0, g1); unpack_bf8(w.p, p0, p1);
                v0 = (v0 * g0 * W8I + p0) * MGS; v1 = (v1 * g1 * W8I + p1) * MGS;
                *(u32x2*)(o + (size_t)row * D + col) = (u32x2){pk4_fp8(v0[0], v0[1], v0[2], v0[3]), pk4_fp8(v1[0], v1[1], v1[2], v1[3])}; });
    } };
struct ProbWo : DenseBase { static constexpr bool PERM = true, FP8 = true; const float* x; bf16* O;
    DI void epi(const AccT& acc, const Unit& u, int wr, int wc, int fr, int fq) const {
        const float* xp = x; bf16* o = O;
        struct OpX { f32x4 a, b; };
        epi_walk_ld<OpX>(acc, u, wr, wc, fr, fq, [=](int row, int col) LAMBDA_INL { return OpX{*(const f32x4*)(xp + (size_t)row * D + col), *(const f32x4*)(xp + (size_t)row * D + col + 4)}; },
            [=](int row, int col, f32x4 v0, f32x4 v1, OpX w) LAMBDA_INL { *(u32x4*)(o + (size_t)row * D + col) = pack_bf8(w.a * ALPHA + v0 * (W8I / MGS), w.b * ALPHA + v1 * (W8I / MGS)); });
    } };
struct ProbPP : DenseBase { static constexpr bool PERM = true; bf16* O;
    DI void epi(const AccT& acc, const Unit& u, int wr, int wc, int fr, int fq) const { bf16* o = O;
        epi_walk(acc, u, wr, wc, fr, fq, [=](int row, int col, int, f32x4 v0, f32x4 v1) LAMBDA_INL { *(u32x4*)(o + (size_t)row * D + col) = pack_bf8(v0, v1); }); } };
struct ProbPG : DenseBase { static constexpr bool PERM = true, FP8 = true; bf16* O;
    DI void epi(const AccT& acc, const Unit& u, int wr, int wc, int fr, int fq) const { bf16* o = O;
        epi_walk_ld<u32x4>(acc, u, wr, wc, fr, fq, [=](int row, int col) LAMBDA_INL { return *(const u32x4*)(o + (size_t)row * D + col); },
            [=](int row, int col, f32x4 v0, f32x4 v1, u32x4 pw) LAMBDA_INL { f32x4 p0, p1; unpack_bf8(pw, p0, p1);
#pragma unroll
                for (int j = 0; j < 4; ++j) { v0[j] = sigmoidf_(v0[j] * W8I) * p0[j]; v1[j] = sigmoidf_(v1[j] * W8I) * p1[j]; }
                *(u32x4*)(o + (size_t)row * D + col) = pack_bf8(v0, v1); });
    } };
template <bool SCALED>
DI void epi_swiglu(const AccT& acc, bf16* O, int ldo, int row0, int hcol0, int wr, int wc, int fr, int fq) {
    const float cs = SCALED ? W8I : 1.0f;
#pragma unroll
    for (int ai = 0; ai < 2; ++ai)
#pragma unroll
        for (int m = 0; m < 4; ++m) { const int row = row0 + ai * 128 + wr * 64 + m * 16 + fr; f32x4 h0, h1;
#pragma unroll
            for (int j = 0; j < 4; ++j) { h0[j] = siluf_(acc[ai][0][m][0][j] * cs) * (acc[ai][1][m][0][j] * cs); h1[j] = siluf_(acc[ai][0][m][1][j] * cs) * (acc[ai][1][m][1][j] * cs); }
            *(u32x4*)(O + (size_t)row * ldo + hcol0 + wc * 32 + 8 * fq) = pack_bf8(h0, h1); }
}
DI void epi_swiglu_moe(const AccT& acc, unsigned char* O, const LAS float* gate, int row0, int hcol0, int wr, int wc, int fr, int fq) {
#pragma unroll
    for (int ai = 0; ai < 2; ++ai)
#pragma unroll
        for (int m = 0; m < 4; ++m) { const int lr = ai * 128 + wr * 64 + m * 16 + fr, row = row0 + lr; const float gs = gate[lr] * (HGS * W8I); f32x4 h0, h1;
#pragma unroll
            for (int j = 0; j < 4; ++j) { h0[j] = siluf_(acc[ai][0][m][0][j] * W8I) * (acc[ai][1][m][0][j] * gs); h1[j] = siluf_(acc[ai][0][m][1][j] * W8I) * (acc[ai][1][m][1][j] * gs); }
            *(u32x2*)(O + (size_t)row * 256 + hcol0 + wc * 32 + 8 * fq) = (u32x2){pk4_fp8(h0[0], h0[1], h0[2], h0[3]), pk4_fp8(h1[0], h1[1], h1[2], h1[3])}; }
}
struct ProbSGU : DenseBase { static constexpr bool PERM = true; bf16* O;
    DI void epi(const AccT& acc, const Unit& u, int wr, int wc, int fr, int fq) const { epi_swiglu<false>(acc, O, 256, u.pm * 256, u.pn * 128, wr, wc, fr, fq); } };
struct ProbSD : DenseBase { static constexpr bool PERM = true; bf16* O; int rank, nlight;
    DI bool next(int i, Unit& u) const { if (rank < 0) return false; const int L = rank + i * nlight; if (L >= 512) return false; u.pm = L >> 2; u.pn = L & 3; return true; }
    DI void epi(const AccT& acc, const Unit& u, int wr, int wc, int fr, int fq) const {
        bf16* o = O;
        epi_walk_ld<u32x4>(acc, u, wr, wc, fr, fq, [=](int row, int col) LAMBDA_INL { return *(const u32x4*)(o + (size_t)row * D + col); },
            [=](int row, int col, f32x4 v0, f32x4 v1, u32x4 pw) LAMBDA_INL { f32x4 p0, p1; unpack_bf8(pw, p0, p1); *(u32x4*)(o + (size_t)row * D + col) = pack_bf8(v0 + p0, v1 + p1); });
    } };
struct ProbMoeUp { static constexpr bool PERM = true, GATHER = true, FP8 = true;
    const char* A; const char* Bt; int K; int ntiles, G, c; const LAS int* texp; const LAS unsigned short* ltok; const LAS float* lgate; unsigned char* H;
    DI bool next(int i, Unit& u) const { const int x = c & 7, sl = c >> 3; u.pm = i * 128 + (sl >> 1) * 8 + x; u.pn = sl & 1; return u.pm < ntiles; }
    DI const char* a_ptr(const Unit&) const { return A; }
    DI const char* b_ptr(const Unit& u) const { return Bt + ((size_t)__builtin_amdgcn_readfirstlane(texp[u.pm]) * 512 + (size_t)u.pn * 256) * 1024; }
    DI int gather_row(const Unit& u, int r) const { return (int)ltok[(u.pm >> 7) * 256 + r]; }
    DI void epi(const AccT& acc, const Unit& u, int wr, int wc, int fr, int fq) const { epi_swiglu_moe(acc, H, lgate + (u.pm >> 7) * 256, u.pm * 256, u.pn * 128, wr, wc, fr, fq); } };
constexpr int XPITCH = 272, XBUF = 32 * XPITCH;
struct ProbMoeDown { static constexpr bool PERM = true, GATHER = false, FP8 = true;
    const char* A; const char* Bt; int K; int ntiles, G, c; const LAS int* texp; unsigned char* Y; unsigned char* Y2;
    DI bool next(int i, Unit& u) const { const int x = c & 7, sl = c >> 3; u.pm = i * 64 + (sl >> 2) * 8 + x; u.pn = sl & 3; return u.pm < ntiles; }
    DI const char* a_ptr(const Unit& u) const { return A + (size_t)u.pm * 256 * 256; }
    DI const char* b_ptr(const Unit& u) const { return Bt + ((size_t)__builtin_amdgcn_readfirstlane(texp[u.pm]) * 1024 + (size_t)u.pn * 256) * 256; }
    DI int gather_row(const Unit&, int) const { return 0; }
    LAS unsigned char* xl;
    DI void epi(const AccT& acc, const Unit& u, int wr, int wc, int fr, int fq) const {
        unsigned char* y = (u.pm * 256 < YE_SPLIT ? Y : Y2 - (size_t)YE_SPLIT * D) + (size_t)u.pm * 256 * D + u.pn * 256;
        const int tid = (wr * 4 + wc) * 64 + fq * 16 + fr, rrow = tid >> 4;
        const int woff = (wr * 16 + fr) * 256 + (((wc * 2 + (fq >> 1)) ^ fr) << 4) + 8 * (fq & 1);
        const int roff = rrow * 256 + ((tid & 15) << 4);
        unsigned char* gp = y + (size_t)(64 * ((tid >> 8) & 1) + (rrow & 15)) * D + (((tid & 15) ^ (rrow & 15)) << 4);
#pragma unroll
        for (int r = 0; r < 4; ++r) { LAS unsigned char* xb = xl + ((r & 1) ? XR_TAIL : XR_RING); const int ai = r >> 1;
#pragma unroll
            for (int mm = 0; mm < 2; ++mm)
#pragma unroll
                for (int bj = 0; bj < 2; ++bj) { const int m = 2 * (r & 1) + mm; const f32x4 v0 = acc[ai][bj][m][0], v1 = acc[ai][bj][m][1];
                    *(LAS u32x2*)(xb + (woff ^ (bj * 128)) + mm * 8192) = (u32x2){pk4_fp8(v0[0], v0[1], v0[2], v0[3]), pk4_fp8(v1[0], v1[1], v1[2], v1[3])}; }
            asm volatile("s_waitcnt lgkmcnt(0)" ::: "memory"); __builtin_amdgcn_s_barrier(); asm volatile("" ::: "memory");
#pragma unroll
            for (int j = 0; j < 2; ++j) { const u32x4 v = *(const LAS u32x4*)(xb + roff + j * 8192);
                *(u32x4*)(gp + (size_t)(128 * ai + 16 * (2 * (r & 1) + j)) * D) = v; } }
    } };

constexpr int VPITCH = 144;
constexpr int ATT_K = 0, ATT_V = 384 * VPITCH;
struct AttnU { int b, hd, g, r, rho, n0; };
DI AttnU attn_decode(int ui) {
    AttnU u; const int w16 = ui & 15; u.g = (ui >> 4) % 3; const int bh = (ui >> 4) / 3; u.hd = bh & 7; u.b = bh >> 3;
    u.r = u.g == 0 ? 1 : (u.g == 1 ? 4 : 16);
    u.rho = u.g == 0 ? 0 : (u.g == 1 ? (w16 & 3) : w16); const int pair = u.g == 0 ? w16 : (u.g == 1 ? (w16 >> 2) : 0);
    u.n0 = 256 * pair; return u;
}
DI void attn_load_kv(const bf16* qkv, const AttnU& u, int tid, u32x4 (&kreg)[6], u32x4 (&vreg)[6]) {
    const size_t tokb = (size_t)u.b * SEQ; const int colq = u.g * 512 + u.hd * 64;
#pragma unroll
    for (int i = 0; i < 6; ++i) { const int c = tid + 512 * i, row = c >> 3, ch = c & 7; int nk = u.n0 - 128 + row; nk = nk < 0 ? 0 : nk;
        const bf16* p = qkv + (tokb + (size_t)nk * u.r + u.rho) * NATT + colq + ch * 8;
        kreg[i] = *(const u32x4*)(p + 1536); vreg[i] = *(const u32x4*)(p + 3072); }
}
DI void attn_load_q(const bf16* qkv, const AttnU& u, int w, int l31, int hh, bf16x8 (&Qf)[4]) {
    const size_t tq = (size_t)u.b * SEQ + (size_t)(u.n0 + 32 * w + l31) * u.r + u.rho; const int colq = u.g * 512 + u.hd * 64;
#pragma unroll
    for (int s = 0; s < 4; ++s) Qf[s] = *(const bf16x8*)(qkv + tq * NATT + colq + 16 * s + 8 * hh);
}
DI void attn_phase(const Frame& F, const bf16* qkv, bf16* opart, float* lse) {
    LAS unsigned char* Kl = F.lds + ATT_K; LAS unsigned char* Vl = F.lds + ATT_V;
    const int lane = F.lane, l31 = lane & 31, hh = lane >> 5, w = F.wave;
    const int q4 = (lane & 15) >> 2, p4 = lane & 3, blk = (lane >> 4) & 1;
    constexpr int NU = NB * 8 * 3 * 16;
    if (F.bid >= NU) return;
    u32x4 kreg[6], vreg[6]; bf16x8 Qn[4];
    { const AttnU u0 = attn_decode(F.bid); attn_load_kv(qkv, u0, F.tid, kreg, vreg); attn_load_q(qkv, u0, w, l31, hh, Qn); }
    for (int ui = F.bid; ui < NU; ui += F.G) {
        const AttnU u = attn_decode(ui);
        const int r = u.r, n0 = u.n0, hd = u.hd;
        __syncthreads();
#pragma unroll
        for (int i = 0; i < 6; ++i) { const int c = F.tid + 512 * i, row = c >> 3, ch = c & 7;
            *(LAS u32x4*)(Kl + row * VPITCH + ch * 16) = kreg[i]; *(LAS u32x4*)(Vl + row * VPITCH + ch * 16) = vreg[i]; }
        bf16x8 Qf[4];
#pragma unroll
        for (int s = 0; s < 4; ++s) Qf[s] = Qn[s];
        __syncthreads();
        { const int un = ui + F.G < NU ? ui + F.G : ui; const AttnU u2 = attn_decode(un); attn_load_kv(qkv, u2, F.tid, kreg, vreg); attn_load_q(qkv, u2, w, l31, hh, Qn); }
        __builtin_amdgcn_sched_barrier(0);
        const int qq = 32 * w + l31; const size_t tq = (size_t)u.b * SEQ + (size_t)(n0 + qq) * r + u.rho;
        f32x16 sc[5];
        bf16x8 kf[2][4];
        { const LAS unsigned char* kr = Kl + (32 * w + l31) * VPITCH + 16 * hh;
#pragma unroll
          for (int s = 0; s < 4; ++s) kf[0][s] = *(const LAS bf16x8*)(kr + 32 * s); }
#pragma unroll
        for (int J = 0; J < 5; ++J) {
            if (J < 4) { const LAS unsigned char* kr = Kl + (32 * (w + J + 1) + l31) * VPITCH + 16 * hh;
#pragma unroll
                for (int s = 0; s < 4; ++s) kf[(J + 1) & 1][s] = *(const LAS bf16x8*)(kr + 32 * s); }
            f32x16 a;
#pragma unroll
            for (int i = 0; i < 16; ++i) a[i] = 0.f;
#pragma unroll
            for (int s = 0; s < 4; ++s) a = MFMA32(kf[J & 1][s], Qf[s], a);
            sc[J] = a;
            __builtin_amdgcn_sched_barrier(0);
        }
        const float slope2 = exp2f(-(float)(hd + 1)) * (float)r * LOG2E;
        int l31v = l31; asm volatile("" : "+v"(l31v));
        const int cb = 4 * hh;
        float nb[5]; bool tok[5];
#pragma unroll
        for (int J = 0; J < 5; ++J) { tok[J] = (n0 > 0) || (w + J >= 4); nb[J] = -slope2 * (float)(l31v + 128 - 32 * J - cb); }
        float mx = -3.0e38f;
#pragma unroll
        for (int J = 0; J < 5; ++J) {
            if (tok[J]) {
#pragma unroll
                for (int i = 0; i < 16; ++i) {
                    const int ci = (i & 3) + 8 * (i >> 2);
                    const float s2 = fmaf(slope2, (float)ci, sc[J][i] + nb[J]);
                    if (J == 0) mx = (ci + cb >= l31v) ? fmaxf(mx, s2) : mx;
                    else if (J == 4) mx = (ci + cb <= l31v) ? fmaxf(mx, s2) : mx;
                    else mx = fmaxf(mx, s2);
                }
            }
        }
        mx = xmax32(mx);
        float den = 0.f;
#pragma unroll
        for (int J = 0; J < 5; ++J) {
            if (tok[J]) {
                const float c2 = nb[J] - mx;
#pragma unroll
                for (int i = 0; i < 16; ++i) {
                    const int ci = (i & 3) + 8 * (i >> 2);
                    float pv = exp2f(fmaf(slope2, (float)ci, sc[J][i] + c2));
                    if (J == 0) pv = (ci + cb >= l31v) ? pv : 0.f;
                    if (J == 4) pv = (ci + cb <= l31v) ? pv : 0.f;
                    sc[J][i] = pv; den += pv;
                }
            } else {
#pragma unroll
                for (int i = 0; i < 16; ++i) sc[J][i] = 0.f;
            }
        }
        den = xsum32(den);
        f32x16 o[2];
#pragma unroll
        for (int c = 0; c < 2; ++c)
#pragma unroll
            for (int i = 0; i < 16; ++i) o[c][i] = 0.f;
#pragma unroll
        for (int J = 0; J < 5; ++J) {
#pragma unroll
            for (int s = 0; s < 2; ++s) {
                const bf16x8 pf = pack8(sc[J], s);
#pragma unroll
                for (int c = 0; c < 2; ++c) {
                    const LAS unsigned char* vb = Vl + (32 * (w + J) + 16 * s + 4 * hh + q4) * VPITCH + (32 * c + 16 * blk + 4 * p4) * 2;
                    const bf16x8 vf = cat8(vtr(vb), vtr(vb + 8 * VPITCH));
                    o[c] = MFMA32(vf, pf, o[c]);
                }
            }
            __builtin_amdgcn_sched_barrier(0);
        }
        const float inv = 1.0f / den;
        bf16* op = opart + ((size_t)u.g * T + tq) * 512 + hd * 64;
#pragma unroll
        for (int c = 0; c < 2; ++c)
#pragma unroll
            for (int i4 = 0; i4 < 4; ++i4) {
                const int d0 = 32 * c + 8 * i4 + 4 * hh;
                *(u32x2*)(op + d0) = (u32x2){pk2(o[c][4 * i4] * inv, o[c][4 * i4 + 1] * inv), pk2(o[c][4 * i4 + 2] * inv, o[c][4 * i4 + 3] * inv)};
            }
        if (hh == 0) lse[((size_t)u.g * T + tq) * 8 + hd] = mx + log2f(den);
    }
}
DI void attn_mix_phase(const Frame& F, const bf16* opart, const float* lse, unsigned char* yatt) {
    const int gw = F.bid * 8 + F.wave, NGW = F.G * 8;
    for (int it = gw; it < T / 2; it += 2 * NGW) {
        const int c16 = F.lane & 31, hd = c16 >> 2;
        int tk[2]; float l[2][3]; u32x4 sv[2][3][2];
#pragma unroll
        for (int q = 0; q < 2; ++q) { tk[q] = 2 * (it + q * NGW) + (F.lane >> 5);
#pragma unroll
            for (int g = 0; g < 3; ++g) { l[q][g] = lse[((size_t)g * T + tk[q]) * 8 + hd]; const u32x4* src = (const u32x4*)(opart + ((size_t)g * T + tk[q]) * 512 + c16 * 16); sv[q][g][0] = src[0]; sv[q][g][1] = src[1]; } }
#pragma unroll
        for (int q = 0; q < 2; ++q) {
            const float m = fmaxf(fmaxf(l[q][0], l[q][1]), l[q][2]);
            float wsum = 0.f, wg[3];
#pragma unroll
            for (int g = 0; g < 3; ++g) { wg[g] = exp2f(l[q][g] - m); wsum += wg[g]; }
            const float inv = 1.0f / wsum;
            f32x4 a0 = {0, 0, 0, 0}, a1 = a0, a2 = a0, a3 = a0;
#pragma unroll
            for (int g = 0; g < 3; ++g) { f32x4 v0, v1, v2, v3; unpack_bf8(sv[q][g][0], v0, v1); unpack_bf8(sv[q][g][1], v2, v3);
                const float ww = wg[g] * inv; a0 += v0 * ww; a1 += v1 * ww; a2 += v2 * ww; a3 += v3 * ww; }
            *(u32x4*)(yatt + (size_t)tk[q] * 512 + c16 * 16) = (u32x4){pk4_fp8(a0[0], a0[1], a0[2], a0[3]), pk4_fp8(a1[0], a1[1], a1[2], a1[3]), pk4_fp8(a2[0], a2[1], a2[2], a2[3]), pk4_fp8(a3[0], a3[1], a3[2], a3[3])};
        }
    }
}

constexpr int HP = 272;
constexpr int HG_QD = 0, HG_KI = 32 * HP, HG_KE = 2 * 32 * HP, HG_VV = 3 * 32 * HP, HG_DD = 4 * 32 * HP, HG_SSQ = HG_DD + 512, HG_TOT = HG_SSQ + 512, HG_HALF = HG_TOT + 2048;
struct HgRaw { unsigned lfp[8], qp[8]; u32x4 v0, v1; };
DI void hgrn_load(const bf16* R2, size_t tok0, int hd, int cp, int sg, int tidh, HgRaw& w) {
    const bf16* src = R2 + (tok0 + 8 * sg) * NHG + hd * 128 + 2 * cp;
#pragma unroll
    for (int tt = 0; tt < 8; ++tt) { w.lfp[tt] = *(const unsigned*)(src + (size_t)tt * NHG + 1024); w.qp[tt] = *(const unsigned*)(src + (size_t)tt * NHG); }
    const int row = tidh >> 3, ch = tidh & 7; const bf16* vs = R2 + (tok0 + row) * NHG + 2048 + hd * 128;
    w.v0 = *(const u32x4*)(vs + ch * 8); w.v1 = *(const u32x4*)(vs + (ch + 8) * 8);
}
template <bool OUT>
DI void hgrn_phase(const Frame& F, const bf16* R2, float* Lst, float* Dtot, const float* gain, unsigned char* yhg) {
    const int hf = F.wave >> 2, wv = F.wave & 3, tidh = F.tid & 255, lane = F.lane, l31 = lane & 31, hh = lane >> 5;
    const int q4 = (lane & 15) >> 2, p4 = lane & 3, blk = (lane >> 4) & 1;
    LAS unsigned char* base = F.lds + hf * HG_HALF;
    const int cp = tidh & 63, sg = tidh >> 6;
    for (int it0 = F.bid * 2; it0 < 512; it0 += F.G * 2) {
        const int item = it0 + hf, j = item & 7, bhd = item >> 3, hd = bhd & 7, b = bhd >> 3;
        const bool active = OUT || (j < 7);
        f32x16 S[4];
#pragma unroll
        for (int kb = 0; kb < 4; ++kb)
#pragma unroll
            for (int i = 0; i < 16; ++i) S[kb][i] = 0.f;
        if (OUT) {
            for (int i0 = 0; i0 < j; ++i0) {
                const float* Lp = Lst + (size_t)(bhd * 8 + i0) * 16384; const float* Dp = Dtot + (bhd * 8 + i0) * 128;
#pragma unroll
                for (int kb = 0; kb < 4; ++kb)
#pragma unroll
                    for (int i4 = 0; i4 < 4; ++i4) { const f32x4 dd = *(const f32x4*)(Dp + 32 * kb + 8 * i4 + 4 * hh);
#pragma unroll
                        for (int e = 0; e < 4; ++e) S[kb][4 * i4 + e] = S[kb][4 * i4 + e] * dd[e] + Lp[(32 * kb + 8 * i4 + 4 * hh + e) * 128 + 32 * wv + l31]; }
            }
        }
        float dsum0 = 0.f, dsum1 = 0.f;
        const size_t tokI = (size_t)b * SEQ + j * 512;
        HgRaw raw; hgrn_load(R2, tokI, hd, cp, sg, tidh, raw);
        for (int c = 0; c < 16; ++c) {
            const size_t tok0 = tokI + c * 32;
            float lf0[8], lf1[8], cs0[8], cs1[8];
            { float r0 = 0.f, r1 = 0.f;
#pragma unroll
              for (int tt = 0; tt < 8; ++tt) { lf0[tt] = bf2f(raw.lfp[tt] & 0xffffu); lf1[tt] = bf2f(raw.lfp[tt] >> 16); r0 += lf0[tt]; r1 += lf1[tt]; cs0[tt] = r0; cs1[tt] = r1; } }
            LAS float* tot = (LAS float*)(base + HG_TOT);
            *(LAS f32x2*)(tot + sg * 128 + 2 * cp) = (f32x2){cs0[7], cs1[7]};
            __syncthreads();
            float off0 = 0.f, off1 = 0.f, bl0 = 0.f, bl1 = 0.f;
#pragma unroll
            for (int g2 = 0; g2 < 4; ++g2) { const f32x2 tv = *(const LAS f32x2*)(tot + g2 * 128 + 2 * cp); bl0 += tv.x; bl1 += tv.y; if (g2 < sg) { off0 += tv.x; off1 += tv.y; } }
#pragma unroll
            for (int tt = 0; tt < 8; ++tt) {
                const float bt0 = off0 + cs0[tt], bt1 = off1 + cs1[tt], e0 = __expf(bt0), e1 = __expf(bt1);
                const float key0 = 1.0f - __expf(lf0[tt]), key1 = 1.0f - __expf(lf1[tt]);
                const int t = 8 * sg + tt;
                *(LAS unsigned*)(base + HG_QD + t * HP + cp * 4) = pk2(bf2f(raw.qp[tt] & 0xffffu) * e0, bf2f(raw.qp[tt] >> 16) * e1);
                *(LAS unsigned*)(base + HG_KI + t * HP + cp * 4) = pk2(key0 * __expf(-bt0), key1 * __expf(-bt1));
                *(LAS unsigned*)(base + HG_KE + t * HP + cp * 4) = pk2(key0 * __expf(bl0 - bt0), key1 * __expf(bl1 - bt1));
            }
            { const int row = tidh >> 3, ch = tidh & 7;
              *(LAS u32x4*)(base + HG_VV + row * HP + ch * 16) = raw.v0; *(LAS u32x4*)(base + HG_VV + row * HP + (ch + 8) * 16) = raw.v1; }
            if (sg == 0) { *(LAS f32x2*)(base + HG_DD + cp * 8) = (f32x2){__expf(bl0), __expf(bl1)}; dsum0 += bl0; dsum1 += bl1; }
            __syncthreads();
            if (c < 15) hgrn_load(R2, tok0 + 32, hd, cp, sg, tidh, raw);
            u32x2 sgv[4];
            if (OUT) {
#pragma unroll
                for (int i4 = 0; i4 < 4; ++i4) sgv[i4] = *(const u32x2*)(R2 + (tok0 + l31) * NHG + 3072 + hd * 128 + 32 * wv + 8 * i4 + 4 * hh);
            }
            __builtin_amdgcn_sched_barrier(0);
            f32x16 o;
            if (OUT) {
                f32x16 X;
#pragma unroll
                for (int i = 0; i < 16; ++i) X[i] = 0.f;
#pragma unroll
                for (int s2 = 0; s2 < 8; ++s2) {
                    const bf16x8 af = *(const LAS bf16x8*)(base + HG_KI + l31 * HP + (16 * s2 + 8 * hh) * 2);
                    const bf16x8 bfr = *(const LAS bf16x8*)(base + HG_QD + l31 * HP + (16 * s2 + 8 * hh) * 2);
                    X = MFMA32(af, bfr, X);
                }
                int l31v = l31; asm volatile("" : "+v"(l31v));
#pragma unroll
                for (int i = 0; i < 16; ++i) X[i] = (crow(i, hh) <= l31v) ? X[i] : 0.f;
#pragma unroll
                for (int i = 0; i < 16; ++i) o[i] = 0.f;
#pragma unroll
                for (int s2 = 0; s2 < 2; ++s2) {
                    const LAS unsigned char* vb = base + HG_VV + (16 * s2 + 4 * hh + q4) * HP + (32 * wv + 16 * blk + 4 * p4) * 2;
                    const bf16x8 vf = cat8(vtr(vb), vtr(vb + 8 * HP));
                    o = MFMA32(vf, pack8(X, s2), o);
                }
#pragma unroll
                for (int kb = 0; kb < 4; ++kb)
#pragma unroll
                    for (int s2 = 0; s2 < 2; ++s2) {
                        const LAS unsigned char* qb = base + HG_QD + l31 * HP + (32 * kb + 16 * s2 + 4 * hh) * 2;
                        const bf16x8 qf = cat8(*(const LAS s16x4*)qb, *(const LAS s16x4*)(qb + 16));
                        o = MFMA32(pack8(S[kb], s2), qf, o);
                    }
            }
            if (active) {
#pragma unroll
                for (int kb = 0; kb < 4; ++kb) {
#pragma unroll
                    for (int i4 = 0; i4 < 4; ++i4) { const f32x4 dv = *(const LAS f32x4*)(base + HG_DD + (32 * kb + 8 * i4 + 4 * hh) * 4);
#pragma unroll
                        for (int e = 0; e < 4; ++e) S[kb][4 * i4 + e] *= dv[e]; }
#pragma unroll
                    for (int s2 = 0; s2 < 2; ++s2) {
                        const LAS unsigned char* kb_ = base + HG_KE + (16 * s2 + 8 * hh + q4) * HP + (32 * kb + 16 * blk + 4 * p4) * 2;
                        const LAS unsigned char* vb = base + HG_VV + (16 * s2 + 8 * hh + q4) * HP + (32 * wv + 16 * blk + 4 * p4) * 2;
                        const bf16x8 kf = cat8(vtr(kb_), vtr(kb_ + 4 * HP));
                        const bf16x8 vf = cat8(vtr(vb), vtr(vb + 4 * HP));
                        S[kb] = MFMA32(kf, vf, S[kb]);
                    }
                }
            }
            if (OUT) {
                float ss = 0.f;
#pragma unroll
                for (int i = 0; i < 16; ++i) ss += o[i] * o[i];
                ss = xsum32(ss);
                LAS float* ssq = (LAS float*)(base + HG_SSQ);
                if (hh == 0) ssq[wv * 32 + l31] = ss;
                __syncthreads();
                const float tot2 = ssq[l31] + ssq[32 + l31] + ssq[64 + l31] + ssq[96 + l31];
                const float rinv = rsqrtf(tot2 * (1.0f / 128.0f) + RMS_EPS);
                const size_t tk = tok0 + l31;
#pragma unroll
                for (int i4 = 0; i4 < 4; ++i4) {
                    const int dv0 = 32 * wv + 8 * i4 + 4 * hh;
                    const f32x4 gn = *(const f32x4*)(gain + hd * 128 + dv0);
                    const u32x2 sgg = sgv[i4];
                    const float y0 = o[4 * i4] * rinv * gn[0] * bf2f(sgg.x & 0xffffu), y1 = o[4 * i4 + 1] * rinv * gn[1] * bf2f(sgg.x >> 16);
                    const float y2 = o[4 * i4 + 2] * rinv * gn[2] * bf2f(sgg.y & 0xffffu), y3 = o[4 * i4 + 3] * rinv * gn[3] * bf2f(sgg.y >> 16);
                    *(unsigned*)(yhg + tk * D + hd * 128 + dv0) = pk4_fp8(y0, y1, y2, y3);
                }
            }
        }
        if (!OUT && active) {
            float* Lp = Lst + (size_t)item * 16384;
#pragma unroll
            for (int kb = 0; kb < 4; ++kb)
#pragma unroll
                for (int i = 0; i < 16; ++i) Lp[(32 * kb + crow(i, hh)) * 128 + 32 * wv + l31] = S[kb][i];
            if (sg == 0) *(f32x2*)(Dtot + item * 128 + 2 * cp) = (f32x2){__expf(dsum0), __expf(dsum1)};
        }
        __syncthreads();
    }
}

constexpr int H1_KE = 0, H1_VV = 64 * HP, H1_DD = 2 * 64 * HP, H1_TOT = H1_DD + 512, H1_HALF = H1_TOT + 2048;
struct Hg1Raw { unsigned lfp[16]; u32x4 v[4]; };
DI void hgrn1_load(const bf16* R2, size_t tok0, int hd, int cp, int sg, int tidh, Hg1Raw& w) {
    const bf16* src = R2 + (tok0 + 16 * sg) * NHG + hd * 128 + 1024 + 2 * cp;
#pragma unroll
    for (int tt = 0; tt < 16; ++tt) w.lfp[tt] = *(const unsigned*)(src + (size_t)tt * NHG);
#pragma unroll
    for (int i = 0; i < 4; ++i) { const int id = tidh + 256 * i, row = id >> 4, ch = id & 15; w.v[i] = *(const u32x4*)(R2 + (tok0 + row) * NHG + 2048 + hd * 128 + ch * 8); }
}
DI void hgrn_l1_phase(const Frame& F, const bf16* R2, float* Lst, float* Dtot) {
    const int hf = F.wave >> 2, wv = F.wave & 3, tidh = F.tid & 255, lane = F.lane, l31 = lane & 31, hh = lane >> 5;
    const int q4 = (lane & 15) >> 2, p4 = lane & 3, blk = (lane >> 4) & 1;
    LAS unsigned char* base = F.lds + hf * H1_HALF;
    const int cp = tidh & 63, sg = tidh >> 6;
    for (int it0 = F.bid * 2; it0 < 512; it0 += F.G * 2) {
        const int item = it0 + hf, j = item & 7, bhd = item >> 3, hd = bhd & 7, b = bhd >> 3;
        const bool active = j < 7;
        f32x16 S[4];
#pragma unroll
        for (int kb = 0; kb < 4; ++kb)
#pragma unroll
            for (int i = 0; i < 16; ++i) S[kb][i] = 0.f;
        float dsum0 = 0.f, dsum1 = 0.f;
        const size_t tokI = (size_t)b * SEQ + j * 512;
        Hg1Raw raw; hgrn1_load(R2, tokI, hd, cp, sg, tidh, raw);
        for (int c = 0; c < 8; ++c) {
            float lf0[16], lf1[16], cs0[16], cs1[16];
            { float r0 = 0.f, r1 = 0.f;
#pragma unroll
              for (int tt = 0; tt < 16; ++tt) { lf0[tt] = bf2f(raw.lfp[tt] & 0xffffu); lf1[tt] = bf2f(raw.lfp[tt] >> 16); r0 += lf0[tt]; r1 += lf1[tt]; cs0[tt] = r0; cs1[tt] = r1; } }
            LAS float* tot = (LAS float*)(base + H1_TOT);
            *(LAS f32x2*)(tot + sg * 128 + 2 * cp) = (f32x2){cs0[15], cs1[15]};
            __syncthreads();
            float off0 = 0.f, off1 = 0.f, bl0 = 0.f, bl1 = 0.f;
#pragma unroll
            for (int g2 = 0; g2 < 4; ++g2) { const f32x2 tv = *(const LAS f32x2*)(tot + g2 * 128 + 2 * cp); bl0 += tv.x; bl1 += tv.y; if (g2 < sg) { off0 += tv.x; off1 += tv.y; } }
#pragma unroll
            for (int tt = 0; tt < 16; ++tt) {
                const float key0 = 1.0f - __expf(lf0[tt]), key1 = 1.0f - __expf(lf1[tt]);
                *(LAS unsigned*)(base + H1_KE + (16 * sg + tt) * HP + cp * 4) = pk2(key0 * __expf(bl0 - off0 - cs0[tt]), key1 * __expf(bl1 - off1 - cs1[tt]));
            }
#pragma unroll
            for (int i = 0; i < 4; ++i) { const int id = tidh + 256 * i, row = id >> 4, ch = id & 15; *(LAS u32x4*)(base + H1_VV + row * HP + ch * 16) = raw.v[i]; }
            if (sg == 0) { *(LAS f32x2*)(base + H1_DD + cp * 8) = (f32x2){__expf(bl0), __expf(bl1)}; dsum0 += bl0; dsum1 += bl1; }
            __syncthreads();
            if (c < 7) hgrn1_load(R2, tokI + 64 * (c + 1), hd, cp, sg, tidh, raw);
            __builtin_amdgcn_sched_barrier(0);
            if (active) {
#pragma unroll
                for (int kb = 0; kb < 4; ++kb) {
#pragma unroll
                    for (int i4 = 0; i4 < 4; ++i4) { const f32x4 dv = *(const LAS f32x4*)(base + H1_DD + (32 * kb + 8 * i4 + 4 * hh) * 4);
#pragma unroll
                        for (int e = 0; e < 4; ++e) S[kb][4 * i4 + e] *= dv[e]; }
#pragma unroll
                    for (int s2 = 0; s2 < 4; ++s2) {
                        const LAS unsigned char* kb_ = base + H1_KE + (16 * s2 + 8 * hh + q4) * HP + (32 * kb + 16 * blk + 4 * p4) * 2;
                        const LAS unsigned char* vb = base + H1_VV + (16 * s2 + 8 * hh + q4) * HP + (32 * wv + 16 * blk + 4 * p4) * 2;
                        S[kb] = MFMA32(cat8(vtr(kb_), vtr(kb_ + 4 * HP)), cat8(vtr(vb), vtr(vb + 4 * HP)), S[kb]);
                    }
                }
            }
        }
        if (active) {
            float* Lp = Lst + (size_t)item * 16384;
#pragma unroll
            for (int kb = 0; kb < 4; ++kb)
#pragma unroll
                for (int i = 0; i < 16; ++i) Lp[(32 * kb + crow(i, hh)) * 128 + 32 * wv + l31] = S[kb][i];
            if (sg == 0) *(f32x2*)(Dtot + item * 128 + 2 * cp) = (f32x2){__expf(dsum0), __expf(dsum1)};
        }
        __syncthreads();
    }
}

DI void ln_router_phase(const Frame& F, const Args& a, const bf16* pre1, bf16* x1b, unsigned char* x18, const bf16* wrt, int* tok_e, float* tok_g, unsigned* cnt_tbl) {
    constexpr int XP = 2048 + 16;
    LAS unsigned char* XS = F.lds; LAS float* LG = (LAS float*)(F.lds + 32 * XP);
    LAS unsigned* hist = (LAS unsigned*)(F.lds + TABL_OFF);
    const int lane = F.lane, w = F.wave, mt = w >> 2, nt = w & 3, l15 = lane & 15, lq = lane >> 4;
    if (F.tid < 64) hist[F.tid] = 0u;
    bf16x8 Bf[32];
    { const bf16* wp = wrt + (size_t)(16 * nt + l15) * 1024 + 8 * lq;
#pragma unroll
      for (int s2 = 0; s2 < 32; ++s2) Bf[s2] = *(const bf16x8*)(wp + 32 * s2); }
    const float rbias = a.router_b[lane];
    u32x2 pfr[4][4];
#pragma unroll
    for (int r = 0; r < 4; ++r)
#pragma unroll
        for (int j = 0; j < 4; ++j) pfr[r][j] = *((const u32x2*)(pre1 + (size_t)(F.bid * 128 + w * 4 + r) * D) + lane + 64 * j);
    for (int bt = 0; bt < 4; ++bt) {
        const int rowb = F.bid * 128 + bt * 32;
        __syncthreads();
#pragma unroll
        for (int r = 0; r < 4; ++r) {
            const int lr = w * 4 + r;
            f32x4 v[4]; float sm = 0.f;
#pragma unroll
            for (int j = 0; j < 4; ++j) { const u32x2 pv = pfr[r][j]; v[j] = (f32x4){bf2f(pv.x & 0xffffu), bf2f(pv.x >> 16), bf2f(pv.y & 0xffffu), bf2f(pv.y >> 16)}; sm += (v[j].x + v[j].y) + (v[j].z + v[j].w); }
            const float mean = wave_sum(sm) * (1.f / D); float s2 = 0.f;
#pragma unroll
            for (int j = 0; j < 4; ++j) { v[j] = v[j] - mean; s2 += (v[j].x * v[j].x + v[j].y * v[j].y) + (v[j].z * v[j].z + v[j].w * v[j].w); }
            const float rstd = rsqrtf(wave_sum(s2) * (1.f / D) + LN_EPS);
            u32x2* o8 = (u32x2*)(x1b + (size_t)(rowb + lr) * D) + lane; unsigned* o4 = (unsigned*)(x18 + (size_t)(rowb + lr) * D) + lane;
#pragma unroll
            for (int j = 0; j < 4; ++j) {
                const f32x4 w4 = *((const f32x4*)a.ln1_w + lane + 64 * j), b4 = *((const f32x4*)a.ln1_b + lane + 64 * j);
                const f32x4 y = v[j] * rstd * w4 + b4;
                const u32x2 yb = (u32x2){pk2(y.x, y.y), pk2(y.z, y.w)};
                o8[64 * j] = yb; o4[64 * j] = pk4_fp8(y.x, y.y, y.z, y.w);
                *(LAS u32x2*)(XS + lr * XP + (lane + 64 * j) * 8) = yb;
            }
        }
        __syncthreads();
        if (bt < 3) {
#pragma unroll
            for (int r = 0; r < 4; ++r)
#pragma unroll
                for (int j = 0; j < 4; ++j) pfr[r][j] = *((const u32x2*)(pre1 + (size_t)(rowb + 32 + w * 4 + r) * D) + lane + 64 * j);
        }
        f32x4 acc = {0.f, 0.f, 0.f, 0.f};
        { const LAS unsigned char* ap = XS + (16 * mt + l15) * XP + 16 * lq;
#pragma unroll
          for (int s2 = 0; s2 < 32; ++s2) acc = __builtin_amdgcn_mfma_f32_16x16x32_bf16(*(const LAS bf16x8*)(ap + 64 * s2), Bf[s2], acc, 0, 0, 0); }
#pragma unroll
        for (int i = 0; i < 4; ++i) LG[(16 * mt + 4 * lq + i) * 64 + 16 * nt + l15] = acc[i];
        __syncthreads();
#pragma unroll
        for (int r = 0; r < 4; ++r) {
            const int lr = w * 4 + r; const float lgt = LG[lr * 64 + lane];
            const float sgm = 1.0f / (1.0f + expf(-lgt)), sel = sgm + rbias;
            float m1 = sel;
            m1 = fmaxf(m1, xshf<1>(m1)); m1 = fmaxf(m1, xshf<2>(m1)); m1 = fmaxf(m1, xshf<4>(m1));
            const unsigned long long eqm = __ballot(sel == m1);
            const unsigned grpbits = (unsigned)((eqm >> (lane & 56)) & 0xffull);
            const int first = __builtin_ctz(grpbits) + (lane & 56);
            float m2 = (lane == first) ? -3.0e38f : sel;
            m2 = fmaxf(m2, xshf<1>(m2)); m2 = fmaxf(m2, xshf<2>(m2)); m2 = fmaxf(m2, xshf<4>(m2));
            const float gs = m1 + m2;
            int grank = 0;
#pragma unroll
            for (int g2 = 0; g2 < 8; ++g2) { const float og = __builtin_bit_cast(float, __builtin_amdgcn_readlane(__builtin_bit_cast(int, gs), 8 * g2));
                grank += (og > gs || (og == gs && g2 < (lane >> 3))) ? 1 : 0; }
            const bool gsel = grank < 4;
            const float ms = gsel ? sel : -INFINITY;
            int rank = 0;
#pragma unroll 8
            for (int e2 = 0; e2 < 64; ++e2) { const float oe = __builtin_bit_cast(float, __builtin_amdgcn_readlane(__builtin_bit_cast(int, ms), e2));
                rank += (oe > ms || (oe == ms && e2 < lane)) ? 1 : 0; }
            const bool chosen = gsel && rank < 8;
            const float ssum = wave_sum(chosen ? sgm : 0.f);
            if (chosen) {
                const size_t o = (size_t)(rowb + lr) * 8 + rank;
                tok_e[o] = lane; tok_g[o] = sgm / ssum * 2.5f;
                __hip_atomic_fetch_add(hist + lane, 1u, __ATOMIC_RELAXED, __HIP_MEMORY_SCOPE_WORKGROUP);
            }
        }
    }
    __syncthreads();
    if (F.tid < 64) cnt_tbl[F.bid * 64 + F.tid] = hist[F.tid];
}
DI void p8_convert(const Frame& F, const Args& a, unsigned char* wed, bf16* pb) {
    tr_run(F, 64 * 128, [&](int it) LAMBDA_INL { return p8_item(a, wed, it); });
    const int gw = F.bid * 8 + F.wave, NGW = F.G * 8;
    for (int m0 = gw * 8; m0 < T; m0 += NGW * 8) { f32x4 v[8];
#pragma unroll
        for (int q = 0; q < 8; ++q) v[q] = *((const f32x4*)(a.p + (size_t)(m0 + q) * 256) + F.lane);
#pragma unroll
        for (int q = 0; q < 8; ++q) *((u32x2*)(pb + (size_t)(m0 + q) * 256) + F.lane) = (u32x2){pk2(v[q].x, v[q].y), pk2(v[q].z, v[q].w)}; }
}
DI void scatter_phase(const Frame& F, const unsigned* cnt_tbl, const int* tok_e, const float* tok_g, int* pos_of, int* tok_list, float* gate_list, unsigned* tabw) {
    LAS unsigned* part = (LAS unsigned*)(F.lds);
    LAS unsigned* cur = (LAS unsigned*)(F.lds + 8192);
    LAS unsigned* segs = (LAS unsigned*)(F.lds + 8192 + 256);
    constexpr int WPB = 256 / NBLK, WPP = WPB / 8;
    const int w = F.bid, blk = w / WPB, wl = w % WPB, e = F.tid & 63, part_i = F.tid >> 6;
    __syncthreads();
    { unsigned tot = 0, below = 0;
      for (int q = 0; q < WPP; ++q) { const int w2 = part_i * WPP + q; const unsigned c = cnt_tbl[(blk * WPB + w2) * 64 + e]; tot += c; below += (w2 < wl) ? c : 0u; }
      part[part_i * 64 + e] = tot; part[512 + part_i * 64 + e] = below; }
    __syncthreads();
    if (F.tid < 64) { unsigned tot = 0, below = 0;
        for (int q = 0; q < 8; ++q) { tot += part[q * 64 + e]; below += part[512 + q * 64 + e]; }
        segs[64 + e] = tot; segs[128 + e] = (tot + 255u) >> 8; cur[e] = below; }
    __syncthreads();
    if (F.tid == 0) { unsigned run = 0; for (int q = 0; q < 64; ++q) { segs[q] = run * 256u; run += segs[128 + q]; } segs[192] = run; }
    __syncthreads();
    if (F.tid < 64) cur[e] += segs[e];
    __syncthreads();
    int* tl = tok_list + (size_t)blk * MAXROWS; float* gl = gate_list + (size_t)blk * MAXROWS;
    for (int i = F.tid; i < 128 * 8; i += 512) {
        const int tk = w * 128 + (i >> 3); const int ex = tok_e[(size_t)tk * 8 + (i & 7)];
        const unsigned pos = __hip_atomic_fetch_add(cur + ex, 1u, __ATOMIC_RELAXED, __HIP_MEMORY_SCOPE_WORKGROUP);
        tl[pos] = tk; gl[pos] = tok_g[(size_t)tk * 8 + (i & 7)]; pos_of[(size_t)tk * 8 + (i & 7)] = (int)pos;
    }
    if (wl < 64) { const unsigned st = segs[wl] + segs[64 + wl], en = segs[wl] + segs[128 + wl] * 256u;
      for (unsigned pz = st + F.tid; pz < en; pz += 512) { tl[pz] = blk * TB; gl[pz] = 0.f; } }
    if (wl == 0) {
        if (F.tid == 0) tabw[TB_NT + blk * 64] = segs[192];
        if (F.tid < 64) { const unsigned t0 = segs[e] >> 8, nt_ = segs[128 + e]; for (unsigned q = 0; q < nt_; ++q) tabw[TB_TEXP + blk * MAXTILES + t0 + q] = (unsigned)e; }
    }
}
struct CombHdr { int pos[8]; u32x2 xv[4], dv[4]; };
DI void comb_load_hdr(CombHdr& h, size_t tk, const bf16* x1b, const bf16* dense, const int* pos_of, int lane) {
#pragma unroll
    for (int k = 0; k < 8; ++k) h.pos[k] = pos_of[tk * 8 + k];
#pragma unroll
    for (int j = 0; j < 4; ++j) { h.xv[j] = *((const u32x2*)(x1b + tk * D) + lane + 64 * j); h.dv[j] = *((const u32x2*)(dense + tk * D) + lane + 64 * j); }
}
DI void combine_phase(const Frame& F, const Args& a, int blk, const bf16* x1b, const bf16* dense, const unsigned char* ye, const unsigned char* ye2, const int* pos_of) {
    const int gw = F.bid * 8 + F.wave, NGW = F.G * 8, lane = F.lane;
    CombHdr h[2];
    if (gw < TB) { comb_load_hdr(h[0], (size_t)blk * TB + gw, x1b, dense, pos_of, lane); comb_load_hdr(h[1], (size_t)blk * TB + gw + NGW, x1b, dense, pos_of, lane); }
    for (int it = gw; it < TB; it += 2 * NGW) {
        unsigned yv[2][8][4];
#pragma unroll
        for (int q = 0; q < 2; ++q)
#pragma unroll
            for (int k = 0; k < 8; ++k) { const int p = h[q].pos[k]; const unsigned char* yr = p < YE_SPLIT ? ye + (size_t)p * D : ye2 + (size_t)(p - YE_SPLIT) * D;
#pragma unroll
                for (int j = 0; j < 4; ++j) yv[q][k][j] = *((const unsigned*)yr + lane + 64 * j); }
        f32x4 v[2][4];
#pragma unroll
        for (int q = 0; q < 2; ++q)
#pragma unroll
            for (int j = 0; j < 4; ++j) { const u32x2 xv = h[q].xv[j], dv = h[q].dv[j];
                v[q][j] = (f32x4){bf2f(xv.x & 0xffffu), bf2f(xv.x >> 16), bf2f(xv.y & 0xffffu), bf2f(xv.y >> 16)} * ALPHA
                        + (f32x4){bf2f(dv.x & 0xffffu), bf2f(dv.x >> 16), bf2f(dv.y & 0xffffu), bf2f(dv.y >> 16)}; }
        const int itn = it + 2 * NGW;
        if (itn < TB) { comb_load_hdr(h[0], (size_t)blk * TB + itn, x1b, dense, pos_of, lane); comb_load_hdr(h[1], (size_t)blk * TB + itn + NGW, x1b, dense, pos_of, lane); }
#pragma unroll
        for (int q = 0; q < 2; ++q) {
            const size_t tk = (size_t)blk * TB + it + q * NGW;
#pragma unroll
            for (int k = 0; k < 8; ++k)
#pragma unroll
                for (int j = 0; j < 4; ++j) v[q][j] += unpk4_fp8(yv[q][k][j]) * YEI;
            float sm = 0.f;
#pragma unroll
            for (int j = 0; j < 4; ++j) sm += (v[q][j].x + v[q][j].y) + (v[q][j].z + v[q][j].w);
            const float mean = wave_sum(sm) * (1.f / D); float s2 = 0.f;
#pragma unroll
            for (int j = 0; j < 4; ++j) { v[q][j] = v[q][j] - mean; s2 += (v[q][j].x * v[q][j].x + v[q][j].y * v[q][j].y) + (v[q][j].z * v[q][j].z + v[q][j].w * v[q][j].w); }
            const float rstd = rsqrtf(wave_sum(s2) * (1.f / D) + LN_EPS);
#pragma unroll
            for (int j = 0; j < 4; ++j) {
                const f32x4 w4 = *((const f32x4*)a.ln2_w + lane + 64 * j), b4 = *((const f32x4*)a.ln2_b + lane + 64 * j);
                *((f32x4*)(a.out + tk * D) + lane + 64 * j) = v[q][j] * rstd * w4 + b4;
            }
        }
    }
}

#ifndef PHASE_MASK
#define PHASE_MASK 0xffffffffu
#endif
#define PH(k) ((PHASE_MASK >> (k)) & 1u)
#ifndef REPEAT_MASK
#define REPEAT_MASK 0u
#endif
#define RP(k) (1 + (int)((REPEAT_MASK >> (k)) & 1u))
typedef const __attribute__((address_space(4))) Args* KArgsPtr;
DI KArgsPtr kargs_ptr() { KArgsPtr p = (KArgsPtr)__builtin_amdgcn_kernarg_segment_ptr(); asm volatile("" : "+s"(p)); return p; }
__global__ void __launch_bounds__(512, 2) fwd_kernel(Args a_by_value) {
    extern __shared__ __attribute__((aligned(16))) unsigned char lds_raw[];
    (void)a_by_value;
#if defined(__HIP_DEVICE_COMPILE__)
    const int wave0 = __builtin_amdgcn_readfirstlane((int)threadIdx.x >> 6) & 7;
#define LEADER() (wave0 == 0 && lane_id_asm() == 0)
#define FRAME() Frame F; { const int l_ = lane_id_asm(); F.tid = wave0 * 64 + l_; F.lane = l_; F.wave = wave0; F.G = gridDim.x; F.bid = blockIdx.x; F.lds = (LAS unsigned char*)lds_raw; } \
                const Args a = *kargs_ptr(); unsigned char* const ws = a.ws; unsigned char* const dob = (unsigned char*)a.out; unsigned* const tabw = (unsigned*)(ws + WS_TAB); (void)dob; (void)tabw;
#define STAMP() do {} while (0)
#define GRIDBAR() do { GRIDBAR_(); STAMP(); } while (0)
#define GRIDBAR_() do { XcdBarrier bar_; bar_.bar = (unsigned*)(kargs_ptr()->ws + WS_CTL) + 4096; bar_.x = xb_xcc_id(); bar_.st = (volatile LAS unsigned*)((LAS unsigned char*)lds_raw + MISC_OFF) + 8; xcd_barrier(bar_, LEADER()); } while (0)
    {
        for (int u = threadIdx.x; u < (LDS_BYTES - LDSCTL_OFF) / 4; u += 512) ((LAS unsigned*)((LAS unsigned char*)lds_raw + LDSCTL_OFF))[u] = 0u;
        __syncthreads();
        (void)xcd_barrier_post((unsigned*)(kargs_ptr()->ws + WS_CTL) + 4096, (volatile LAS unsigned*)((LAS unsigned char*)lds_raw + MISC_OFF) + 8, LEADER());
        STAMP();
    }
    _Pragma("unroll 1") for (int rep_ = 0; rep_ < RP(0); ++rep_) if (PH(0)) { FRAME(); p0_prologue(F, a); }
    GRIDBAR();
    _Pragma("unroll 1") for (int rep_ = 0; rep_ < RP(1); ++rep_) if (PH(1)) { FRAME(); ProbQKV P; P.init(ws + WS_X8, ws + WS_WIN8, T, NATT, 512, F.G, F.bid); P.O = (bf16*)(ws + WS_R); P.xl = F.lds; pg8::gemm_phase(F.lds, P, wave0); }
    GRIDBAR();
    _Pragma("unroll 1") for (int rep_ = 0; rep_ < RP(2); ++rep_) if (PH(2)) { FRAME(); attn_phase(F, (const bf16*)(ws + WS_R), (bf16*)dob, (float*)(dob + DO_LSE)); }
    GRIDBAR();
    _Pragma("unroll 1") for (int rep_ = 0; rep_ < RP(3); ++rep_) if (PH(3)) { FRAME(); attn_mix_phase(F, (const bf16*)dob, (const float*)(dob + DO_LSE), ws + WS_YATT); }
    GRIDBAR();
    _Pragma("unroll 1") for (int rep_ = 0; rep_ < RP(4); ++rep_) if (PH(4)) { FRAME(); ProbHG P; P.init(ws + WS_X8, ws + WS_WIN8 + (size_t)NATT * 1024, T, NHG + NGATE, 512, F.G, F.bid); P.R2 = (bf16*)(ws + WS_R); P.gates = (bf16*)dob; P.lbl = a.lb_logits; pg8::gemm_phase(F.lds, P, wave0); }
    GRIDBAR();
    _Pragma("unroll 1") for (int rep_ = 0; rep_ < RP(5); ++rep_) if (PH(5)) { FRAME(); hgrn_l1_phase(F, (const bf16*)(ws + WS_R), (float*)(ws + WS_L), (float*)(ws + WS_TAB + 128 * 1024)); }
    GRIDBAR();
    _Pragma("unroll 1") for (int rep_ = 0; rep_ < RP(7); ++rep_) if (PH(7)) { FRAME(); hgrn_phase<true>(F, (const bf16*)(ws + WS_R), (float*)(ws + WS_L), (float*)(ws + WS_TAB + 128 * 1024), a.hg_norm_w, ws + WS_XB); }
    GRIDBAR();
    _Pragma("unroll 1") for (int rep_ = 0; rep_ < RP(8); ++rep_) if (PH(8)) { FRAME(); ProbBrA P; P.init(ws + WS_YATT, ws + WS_WA, T, 1024, 256, F.G, F.bid); P.gates = (const bf16*)dob; P.O = (bf16*)(ws + WS_MERGED); pg8::gemm_phase(F.lds, P, wave0); }
    __syncthreads();
    _Pragma("unroll 1") for (int rep_ = 0; rep_ < RP(9); ++rep_) if (PH(9)) { FRAME(); ProbBrH P; P.init(ws + WS_XB, ws + WS_WH, T, 1024, 512, F.G, F.bid); P.gates = (const bf16*)dob; P.M1 = (const bf16*)(ws + WS_MERGED); P.O = ws + 320 * MiB; pg8::gemm_phase(F.lds, P, wave0); }
    GRIDBAR();
    _Pragma("unroll 1") for (int rep_ = 0; rep_ < RP(10); ++rep_) if (PH(10)) { FRAME(); ProbWo P; P.init(ws + 320 * MiB, ws + WS_WO, T, 1024, 512, F.G, F.bid); P.x = a.x; P.O = (bf16*)(ws + WS_PRE1); pg8::gemm_phase(F.lds, P, wave0); }
    GRIDBAR();
    _Pragma("unroll 1") for (int rep_ = 0; rep_ < RP(11); ++rep_) if (PH(11)) { FRAME(); ln_router_phase(F, a, (const bf16*)(ws + WS_PRE1), (bf16*)(ws + WS_X1B), ws + WS_X8, (const bf16*)(ws + WS_WRT), (int*)(ws + WS_LISTS + LS_TOKE), (float*)(ws + WS_LISTS + LS_TOKG), tabw + TB_CNT); }
    __syncthreads();
    _Pragma("unroll 1") for (int rep_ = 0; rep_ < RP(12); ++rep_) if (PH(12)) { FRAME(); p8_convert(F, a, dob + DO_WED, (bf16*)(ws + WS_PB)); }
    GRIDBAR();
    _Pragma("unroll 1") for (int rep_ = 0; rep_ < RP(13); ++rep_) if (PH(13)) { FRAME(); scatter_phase(F, tabw + TB_CNT, (const int*)(ws + WS_LISTS + LS_TOKE), (const float*)(ws + WS_LISTS + LS_TOKG), (int*)(ws + WS_LISTS + LS_POS),
                  (int*)(ws + WS_LISTS + LS_TOKLIST), (float*)(ws + WS_LISTS + LS_GATELIST), tabw); }
    __syncthreads();
    _Pragma("unroll 1") for (int rep_ = 0; rep_ < RP(14); ++rep_) if (PH(14)) { FRAME(); ProbPP P; P.init(ws + WS_PB, ws + WS_WPP, T, 1024, 256, F.G, F.bid); P.O = (bf16*)(ws + WS_XB); pg8::gemm_phase(F.lds, P, wave0); }
    __syncthreads();
    _Pragma("unroll 1") for (int rep_ = 0; rep_ < RP(15); ++rep_) if (PH(15)) { FRAME(); ProbPG P; P.init(ws + WS_X8, ws + WS_WPG, T, 1024, 512, F.G, F.bid); P.O = (bf16*)(ws + WS_XB); pg8::gemm_phase(F.lds, P, wave0); }
    __syncthreads();
    _Pragma("unroll 1") for (int rep_ = 0; rep_ < RP(16); ++rep_) if (PH(16)) { FRAME(); ProbSGU P; P.init(ws + WS_X1B, ws + WS_WSGU, T, 512, 1024, F.G, F.bid); P.O = (bf16*)(ws + WS_HS); pg8::gemm_phase(F.lds, P, wave0); }
    GRIDBAR();
#pragma unroll 1
    for (int blk = 0; blk < NBLK; ++blk) {
        {
            FRAME(); LAS int* texp = (LAS int*)(F.lds + TABL_OFF);
            const int ntl = (int)tabw[TB_NT + blk * 64];
            __syncthreads();
            for (int i = F.tid; i < ntl; i += 512) texp[i] = (int)tabw[TB_TEXP + blk * MAXTILES + i];
            __syncthreads();
            LAS unsigned short* ltok = (LAS unsigned short*)(F.lds + XL_TOK); LAS float* lgate = (LAS float*)(F.lds + XL_GATE);
            { const int* tl_ = (const int*)(ws + WS_LISTS + LS_TOKLIST) + (size_t)blk * MAXROWS; const float* gl_ = (const float*)(ws + WS_LISTS + LS_GATELIST) + (size_t)blk * MAXROWS;
              const int pm0_ = ((F.bid >> 3) >> 1) * 8 + (F.bid & 7);
#pragma unroll 1
              for (int i = 0; i < XL_UNITS; ++i) { const int pm_ = i * 128 + pm0_; if (pm_ >= ntl) break;
                  if (F.tid < 256) ltok[i * 256 + F.tid] = (unsigned short)tl_[pm_ * 256 + F.tid]; else lgate[i * 256 + F.tid - 256] = gl_[pm_ * 256 + F.tid - 256]; } }
            __syncthreads();
            _Pragma("unroll 1") for (int rep_ = 0; rep_ < RP(18); ++rep_) if (PH(18)) { ProbMoeUp P; P.A = (const char*)(ws + WS_X8); P.Bt = (const char*)(ws + WS_WEGU8); P.K = 512; P.ntiles = ntl; P.G = F.G; P.c = F.bid; P.texp = texp;
              P.ltok = ltok; P.lgate = lgate; P.H = dob; pg8::gemm_phase(F.lds, P, wave0); }
            __syncthreads();
            _Pragma("unroll 1") for (int rep_ = 0; rep_ < RP(17); ++rep_) if (PH(17)) { ProbSD P; P.init(ws + WS_HS, ws + WS_WSD, T, 1024, 256, F.G, F.bid); P.O = (bf16*)(ws + WS_XB);
              const int x_ = F.bid & 7, sl_ = F.bid >> 3, q_ = (sl_ >> 1) * 8 + x_, full_ = ntl - 8 * 128;
              const int fl_ = full_ < 0 ? 0 : (full_ > 128 ? 128 : full_);
              P.nlight = 2 * (128 - fl_); P.rank = (q_ >= fl_ && P.nlight > 0) ? 2 * (q_ - fl_) + (sl_ & 1) : -1;
              if (P.nlight == 0) { P.nlight = 256; P.rank = F.bid; }
              pg8::gemm_phase(F.lds, P, wave0); }
        }
        GRIDBAR();
        {
            FRAME(); LAS int* texp = (LAS int*)(F.lds + TABL_OFF);
            const int ntl = (int)tabw[TB_NT + blk * 64];
            _Pragma("unroll 1") for (int rep_ = 0; rep_ < RP(19); ++rep_) if (PH(19)) { ProbMoeDown P; P.A = (const char*)dob; P.Bt = (const char*)(dob + DO_WED); P.K = 128; P.ntiles = ntl; P.G = F.G; P.c = F.bid; P.texp = texp;
              P.Y = ws + WS_YE; P.Y2 = ws + WS_YE2; P.xl = F.lds; pg8::gemm_phase(F.lds, P, wave0); }
        }
        GRIDBAR();
        _Pragma("unroll 1") for (int rep_ = 0; rep_ < RP(20); ++rep_) if (PH(20)) { FRAME(); combine_phase(F, a, blk, (const bf16*)(ws + WS_X1B), (const bf16*)(ws + WS_XB), ws + WS_YE, ws + WS_YE2, (const int*)(ws + WS_LISTS + LS_POS)); }
    }
#endif
}

extern "C" void kernel_launch(void* const* d_in, const int* in_sizes, int n_in, void* d_out, int out_size, void* d_ws, size_t ws_size, hipStream_t stream) {
    static int grid = 0;
    if (grid == 0) {
        if (n_in != 22 || in_sizes[0] != T * D || out_size != T * D || ws_size < WS_END) { fprintf(stderr, "kernel_launch: unexpected shapes (n_in %d, in0 %d, out %d, ws %zu)\n", n_in, n_in > 0 ? in_sizes[0] : -1, out_size, ws_size); grid = -1; return; }
        int dev = 0, cus = 0, per_cu = 0;
        if (hipGetDevice(&dev) != hipSuccess || hipDeviceGetAttribute(&cus, hipDeviceAttributeMultiprocessorCount, dev) != hipSuccess) { grid = -1; return; }
        if (hipFuncSetAttribute((const void*)fwd_kernel, hipFuncAttributeMaxDynamicSharedMemorySize, LDS_BYTES) != hipSuccess) { fprintf(stderr, "kernel_launch: hipFuncSetAttribute failed\n"); grid = -1; return; }
        if (hipOccupancyMaxActiveBlocksPerMultiprocessor(&per_cu, (const void*)fwd_kernel, 512, LDS_BYTES) != hipSuccess || per_cu < 1) fprintf(stderr, "kernel_launch: occupancy query says %d\n", per_cu);
        (void)hipGetLastError();
        grid = cus;
        if (grid != 256) { fprintf(stderr, "kernel_launch: built for 256 CUs, device has %d\n", cus); grid = -1; return; }
    }
    if (grid < 0) return;
    if (hipMemsetAsync((char*)d_ws + WS_CTL, 0, CTL_ZERO_BYTES, stream) != hipSuccess) return;
    Args a{};
    const float** pp = (const float**)&a;
    for (int i = 0; i < 22; ++i) pp[i] = (const float*)d_in[i];
    a.out = (float*)d_out; a.ws = (unsigned char*)d_ws;
    hipLaunchKernelGGL(fwd_kernel, dim3(grid), dim3(512), LDS_BYTES, stream, a);
}
```

```cpp
#include <hip/hip_runtime.h>
#include <cstdio>
#include <cstdint>

#define LAS __attribute__((address_space(3)))
#define GAS __attribute__((address_space(1)))
#define DI __device__ __forceinline__
typedef unsigned short bf16;
typedef short bf16x8 __attribute__((ext_vector_type(8)));
typedef short s16x4 __attribute__((ext_vector_type(4)));
typedef short v4i16_t __attribute__((ext_vector_type(4)));
typedef float f32x2 __attribute__((ext_vector_type(2)));
typedef float f32x4 __attribute__((ext_vector_type(4)));
typedef float f32x16 __attribute__((ext_vector_type(16)));
typedef unsigned u32x2 __attribute__((ext_vector_type(2)));
typedef unsigned u32x4 __attribute__((ext_vector_type(4)));
typedef __bf16 bf16x2_t __attribute__((ext_vector_type(2)));
typedef int v8i32 __attribute__((ext_vector_type(8)));
typedef short s16x16 __attribute__((ext_vector_type(16)));

constexpr int NB = 8, SEQ = 4096, T = NB * SEQ, D = 1024;
constexpr int NIN = 10752, NATT = 4608, NHG = 4096, NGATE = 2048;
constexpr int NEXP = 64, TOPK = 8, EFF = 256;
constexpr int NBLK = 1, TB = T / NBLK;
constexpr int MAXTILES = TB * TOPK / 256 + NEXP;
constexpr int MAXROWS = MAXTILES * 256;
constexpr float LN_EPS = 1e-5f, RMS_EPS = 1e-6f;
constexpr float ALPHA = 1.18920711500272f;
constexpr float LOG2E = 1.4426950408889634f;
constexpr float QSCALE = 0.125f * LOG2E;
constexpr float W8S = 32.0f, W8I = 1.0f / 32.0f;
constexpr float HGS = 8.0f;
constexpr float YEI = 1.0f / (8.0f * 32.0f);

constexpr size_t MiB = 1u << 20;
constexpr size_t WS_CTL = 0, CTL_ZERO_BYTES = 64 * 1024;
constexpr size_t WS_TAB = 512 * 1024;
constexpr size_t WS_LISTS = 1 * MiB;
constexpr size_t WS_WIN8 = 1 * MiB, WS_WIN = 6 * MiB, WS_WA = 22 * MiB, WS_WH = 23 * MiB, WS_WO = 25 * MiB, WS_WPG = 27 * MiB, WS_WPP = 29 * MiB, WS_WSGU = 30 * MiB, WS_WSD = 31 * MiB, WS_WEGU8 = 32 * MiB, WS_X8 = 64 * MiB;
constexpr size_t WS_WRT = 29 * MiB + 512 * 1024;
constexpr size_t WS_PB = 96 * MiB, WS_HS = 112 * MiB;
constexpr size_t WS_XB = 128 * MiB;
constexpr size_t WS_R = 192 * MiB;
constexpr size_t WS_L = 448 * MiB;
constexpr size_t WS_YATT = 480 * MiB;
constexpr size_t WS_MERGED = 192 * MiB, WS_PRE1 = 256 * MiB, WS_X1B = 448 * MiB;
constexpr size_t WS_YE = 192 * MiB, WS_YE2 = 96 * MiB;
constexpr int YE_SPLIT = 262144;
constexpr size_t WS_END = 512 * MiB;
static_assert(WS_YE + (size_t)YE_SPLIT * 1024 <= WS_X1B && WS_YE2 + (size_t)(MAXROWS - YE_SPLIT) * 1024 <= 128 * MiB && (size_t)MAXROWS * 256 <= 96 * MiB, "ws map");
constexpr size_t LS_TOKE = 0, LS_TOKG = 1 * MiB, LS_POS = 2 * MiB, LS_TOKLIST = 3 * MiB, LS_GATELIST = 3 * MiB + (size_t)NBLK * MAXROWS * 4;
static_assert(LS_GATELIST + (size_t)NBLK * MAXROWS * 4 <= 7 * MiB, "lists");
constexpr size_t DO_LSE = 96 * MiB, DO_WED = 96 * MiB;
constexpr int TB_CNT = 0;
constexpr int TB_NT = 256 * 64;
constexpr int TB_TEXP = TB_NT + 4 * 64;
constexpr int TB_TCNT = TB_TEXP + 4 * MAXTILES;

constexpr int RING_BYTES = 131072, LDSCTL_OFF = RING_BYTES, MISC_OFF = LDSCTL_OFF + 320, TABL_OFF = LDSCTL_OFF + 1024, LDS_BYTES = 163840;

DI float bf2f(unsigned b) { return __uint_as_float(b << 16); }
DI unsigned f2bf(float f) { unsigned u = __float_as_uint(f); return (u + 0x7fffu + ((u >> 16) & 1u)) >> 16; }
DI unsigned pk2(float lo, float hi) { f32x2 v = {lo, hi}; bf16x2_t b = __builtin_convertvector(v, bf16x2_t); return __builtin_bit_cast(unsigned, b); }
DI unsigned pk4_fp8(float a, float b, float c, float d) { int w = 0; w = __builtin_amdgcn_cvt_pk_fp8_f32(a, b, w, false); w = __builtin_amdgcn_cvt_pk_fp8_f32(c, d, w, true); return (unsigned)w; }
DI f32x4 unpk4_fp8(unsigned w) { const f32x2 lo = __builtin_amdgcn_cvt_pk_f32_fp8((int)w, false), hi = __builtin_amdgcn_cvt_pk_f32_fp8((int)w, true); return (f32x4){lo.x, lo.y, hi.x, hi.y}; }
DI float sigmoidf_(float v) { return __builtin_amdgcn_rcpf(1.0f + __expf(-v)); }
DI float siluf_(float v) { return v * sigmoidf_(v); }
template <int M> DI float xshf(float v) {
    if constexpr (M == 32) { const auto rr = __builtin_amdgcn_permlane32_swap(__float_as_uint(v), __float_as_uint(v), false, false); return __uint_as_float(rr[0] == __float_as_uint(v) ? rr[1] : rr[0]); }
    else return __builtin_bit_cast(float, __builtin_amdgcn_ds_swizzle(__builtin_bit_cast(int, v), 0x1F | (M << 10)));
}
DI float xsum32(float v) { const auto rr = __builtin_amdgcn_permlane32_swap(__float_as_uint(v), __float_as_uint(v), false, false); return __uint_as_float(rr[0]) + __uint_as_float(rr[1]); }
DI float xmax32(float v) { const auto rr = __builtin_amdgcn_permlane32_swap(__float_as_uint(v), __float_as_uint(v), false, false); return fmaxf(__uint_as_float(rr[0]), __uint_as_float(rr[1])); }
DI float wave_sum(float v) {
    v += xshf<1>(v); v += xshf<2>(v); v += xshf<4>(v); v += xshf<8>(v); v += xshf<16>(v);
    return xsum32(v);
}
DI int lane_id_asm() { int l; asm volatile("v_mbcnt_lo_u32_b32 %0, -1, 0\n\tv_mbcnt_hi_u32_b32 %0, -1, %0" : "=v"(l)); return l & 63; }
DI int crow(int r, int hi) { return (r & 3) + 8 * (r >> 2) + 4 * hi; }
DI s16x4 vtr(const LAS unsigned char* p) { return __builtin_bit_cast(s16x4, __builtin_amdgcn_ds_read_tr16_b64_v4i16((LAS v4i16_t*)p)); }
DI bf16x8 cat8(s16x4 lo, s16x4 hi) { return (bf16x8){lo[0], lo[1], lo[2], lo[3], hi[0], hi[1], hi[2], hi[3]}; }
DI bf16x8 pack8(const f32x16& x, int s) {
    u32x4 p; p.x = pk2(x[8 * s], x[8 * s + 1]); p.y = pk2(x[8 * s + 2], x[8 * s + 3]); p.z = pk2(x[8 * s + 4], x[8 * s + 5]); p.w = pk2(x[8 * s + 6], x[8 * s + 7]);
    return __builtin_bit_cast(bf16x8, p);
}
#define MFMA32(a, b, c) __builtin_amdgcn_mfma_f32_32x32x16_bf16((a), (b), (c), 0, 0, 0)

#define XB_TMO      128
#define XB_XCNT(j)  (256  + 64 * (j))
#define XB_XSUB(j)  (1280 + 64 * (j))
#define XB_XGEN(j)  (2304 + 64 * (j))
#define XB_TOP      3328
#define XB_TOPGEN   3392
#define XCD_BAR_WORDS 3456
#define XB_SPIN_CAP (1u << 18)
DI unsigned xb_ld(unsigned* p)              { return __hip_atomic_load(p, __ATOMIC_RELAXED, __HIP_MEMORY_SCOPE_AGENT); }
DI unsigned xb_add(unsigned* p, unsigned v) { return __hip_atomic_fetch_add(p, v, __ATOMIC_RELAXED, __HIP_MEMORY_SCOPE_AGENT); }
DI unsigned xb_xcc_id() { return (unsigned)__builtin_amdgcn_s_getreg((3 << 11) | 20) & 0xFu; }
#define XB_SPIN(cond, bar) do { unsigned _sp = 0; while (cond) { __builtin_amdgcn_s_sleep(1); \
    if ((++_sp & 255u) == 0u) { if (xb_ld(&(bar)[XB_TMO])) break; if (_sp > XB_SPIN_CAP) { atomicAdd(&(bar)[XB_TMO], 1u); break; } } } } while (0)
struct XcdBarrier { unsigned* bar; unsigned x; volatile LAS unsigned* st; };
DI XcdBarrier xcd_barrier_post(unsigned* bar, volatile LAS unsigned* st, bool leader) {
    XcdBarrier b; b.bar = bar; b.x = xb_xcc_id(); b.st = st;
    if (leader) (void)xb_add(&bar[XB_XCNT(b.x)], 1u);
    return b;
}
DI void xcd_barrier_complete(unsigned* bar, unsigned x, unsigned& nloc, unsigned& nx) {
    const unsigned G = gridDim.x * gridDim.y * gridDim.z;
    unsigned sum, cnt, mine, sp = 0u;
    for (;;) {
        sum = 0u; cnt = 0u; mine = 0u;
#pragma unroll
        for (unsigned j = 0; j < 16; ++j) { const unsigned c = xb_ld(&bar[XB_XCNT(j)]); sum += c; cnt += (c > 0u) ? 1u : 0u; mine = (j == x) ? c : mine; }
        if (sum == G) break;
        __builtin_amdgcn_s_sleep(1);
        if ((++sp & 255u) == 0u) { if (xb_ld(&bar[XB_TMO])) break; if (sp > XB_SPIN_CAP) { atomicAdd(&bar[XB_TMO], 1u); break; } }
    }
    nloc = mine > 0u ? mine : 1u; nx = cnt > 0u ? cnt : 1u;
}
DI void xcd_barrier(const XcdBarrier& b, bool leader) {
    asm volatile("s_waitcnt vmcnt(0)" ::: "memory");
    __syncthreads();
    if (leader) {
        unsigned* bar = b.bar;
        __builtin_amdgcn_s_waitcnt(0);
        unsigned nloc = b.st[0], nx = b.st[1];
        if (nloc == 0u) { xcd_barrier_complete(bar, b.x, nloc, nx); b.st[0] = nloc; b.st[1] = nx; }
        const unsigned old = xb_add(&bar[XB_XSUB(b.x)], 1u);
        const unsigned gen = old / nloc;
        if (old + 1u == (gen + 1u) * nloc) {
            __builtin_amdgcn_fence(__ATOMIC_RELEASE, "agent");
            asm volatile("s_waitcnt vmcnt(0)" ::: "memory");
            const unsigned og = xb_add(&bar[XB_TOP], 1u);
            const unsigned tg = og / nx;
            if (og + 1u == (tg + 1u) * nx) xb_add(&bar[XB_TOPGEN], 1u);
            else XB_SPIN(xb_ld(&bar[XB_TOPGEN]) == tg, bar);
            __builtin_amdgcn_fence(__ATOMIC_ACQUIRE, "agent");
            xb_add(&bar[XB_XGEN(b.x)], 1u);
            asm volatile("s_waitcnt vmcnt(0)" ::: "memory");
        } else {
            XB_SPIN(xb_ld(&bar[XB_XGEN(b.x)]) == gen, bar);
            __builtin_amdgcn_fence(__ATOMIC_ACQUIRE, "agent");
            asm volatile("s_waitcnt vmcnt(0)" ::: "memory");
        }
    }
    __syncthreads();
}

namespace pg8 {
constexpr int BM = 256, BK = 64, HALF = 128, HTB = HALF * BK * 2, STAGE_BYTES = 8 * HTB, NXCD = 8, WGM = 8;
DI int lds_byte(int r, int c) { const int st = (r >> 4) * 2 + (c >> 5), rr = r & 15, cc = c & 31, ob = rr * 64 + cc * 2; return st * 1024 + (ob ^ (((ob >> 9) & 1) << 5)); }
DI void stage_rc(int b, int& R, int& C) { const int st = b / 1024, sb = b % 1024, swz = sb ^ (((sb >> 9) & 1) << 5); R = (st >> 1) * 16 + swz / 64; C = (st & 1) * 32 + (swz % 64) / 2; }
DI int perm32(int rho) { const int n = rho >> 4, i = rho & 15; return 8 * (i >> 2) + 4 * n + (i & 3); }
DI void glds16_s(const char* sbase, unsigned voff, unsigned lds_dst) { unsigned keep;
    asm volatile("s_mov_b32 %0, m0\n\ts_mov_b32 m0, %3\n\ts_nop 0\n\tglobal_load_lds_dwordx4 %1, %2\n\ts_mov_b32 m0, %0" : "=&s"(keep) : "v"(voff), "s"(sbase), "s"(lds_dst) : "memory"); }
struct Unit { int pm, pn; };
struct StaticOrder {
    int nM, nN, nwg, G, c;
    DI void init(int M, int N, int G_, int c_) { nM = M / BM; nN = N / BM; nwg = nM * nN; G = G_; c = c_; }
    DI bool next(int i, Unit& u) const {
        const long L = (long)i * G + c; if (L >= nwg) return false;
        int wgid = (int)L; { const int q = nwg / NXCD, r = nwg % NXCD, xcd = wgid % NXCD, off = wgid / NXCD; wgid = (xcd < r ? xcd * (q + 1) : r * (q + 1) + (xcd - r) * q) + off; }
        const int nig = WGM * nN, gid = wgid / nig, fm = gid * WGM, gsz = (nM - fm) < WGM ? (nM - fm) : WGM;
        u.pm = fm + ((wgid % nig) % gsz); u.pn = (wgid % nig) / gsz; return true;
    }
};
template <class P>
DI void gemm_phase(LAS unsigned char* lds, const P& S, const int wave0) {
    const int tid = wave0 * 64 + lane_id_asm();
    const int wid = __builtin_amdgcn_readfirstlane(tid >> 6), lane = tid & 63, wr = wid >> 2, wc = wid & 3, fr = lane & 15, fq = lane >> 4;
    const int K = S.K, nt = K / BK;
    int Rr[2], Cc[2];
    unsigned voffB[2], vcur[2][2];
    const size_t hstep = (size_t)HALF * K * 2;
#pragma unroll
    for (int i = 0; i < 2; ++i) { stage_rc(tid * 16 + i * 8192, Rr[i], Cc[i]); const int Rb = P::PERM ? ((Rr[i] & ~31) + perm32(Rr[i] & 31)) : Rr[i];
        voffB[i] = (unsigned)(Rb * K + Cc[i]) * 2u; }
    const size_t kstep = (size_t)(BK * 2);
    const unsigned ldsw = (unsigned)wid * 1024u;
    const unsigned ldsbase = (unsigned)(size_t)lds;
    const int aoff = lds_byte(wr * 64 + fr, fq * 8); int boff = lds_byte(wc * 32 + fr, fq * 8) + 4 * HTB;
    asm volatile("" : "+v"(boff));
#define PG8_SA(b, h) (((b) * 2 + (h)) * HTB)
#define PG8_SB(b, h) ((4 + (b) * 2 + (h)) * HTB)
#define PG8_SBR(b, h) (((b) * 2 + (h)) * HTB)
#define PG8_STAGE(bufoff, gbase, voff) do { _Pragma("unroll") for (int _i = 0; _i < 2; ++_i) \
        glds16_s((const char*)(gbase), (voff)[_i], ldsbase + (unsigned)((bufoff) + _i * 8192) + ldsw); } while (0)
#define PG8_LDA(dst, b, h) do { _Pragma("unroll") for (int m = 0; m < 4; ++m) _Pragma("unroll") for (int k = 0; k < 2; ++k) dst[m][k] = *(const LAS bf16x8*)(lds + PG8_SA(b, h) + aoff + m * 2048 + k * 1024); } while (0)
#define PG8_LDB(dst, b, h) do { _Pragma("unroll") for (int n = 0; n < 2; ++n) _Pragma("unroll") for (int k = 0; k < 2; ++k) dst[n][k] = *(const LAS bf16x8*)(lds + boff + (PG8_SBR(b, h) + n * 2048 + k * 1024)); } while (0)
#define PG8_CAT(x) __builtin_bit_cast(v8i32, __builtin_shufflevector((x)[0], (x)[1], 0, 1, 2, 3, 4, 5, 6, 7, 8, 9, 10, 11, 12, 13, 14, 15))
#define PG8_MMA(ai, bj, At, Bt) do { __builtin_amdgcn_s_setprio(1); _Pragma("unroll") for (int m = 0; m < 4; ++m) _Pragma("unroll") for (int n = 0; n < 2; ++n) { \
        if constexpr (P::FP8) acc[ai][bj][m][n] = __builtin_amdgcn_mfma_scale_f32_16x16x128_f8f6f4(PG8_CAT(Bt[n]), PG8_CAT(At[m]), acc[ai][bj][m][n], 0, 0, 0, 0x7f7f7f7f, 0, 0x7f7f7f7f); \
        else { _Pragma("unroll") for (int k = 0; k < 2; ++k) acc[ai][bj][m][n] = __builtin_amdgcn_mfma_f32_16x16x32_bf16(Bt[n][k], At[m][k], acc[ai][bj][m][n], 0, 0, 0); } } \
        __builtin_amdgcn_s_setprio(0); } while (0)
#define PG8_A1(p) (P::GATHER ? (p) : (p) + hstep)
#define PG8_V1 vcur[P::GATHER ? 1 : 0]
#define PG8_WAIT_V(n) asm volatile("s_waitcnt vmcnt(" #n ")" ::: "memory")
#define PG8_WAIT_L(n) asm volatile("s_waitcnt lgkmcnt(" #n ")" ::: "memory")
#define PG8_BAR __builtin_amdgcn_s_barrier()
#define PG8_SCHED __builtin_amdgcn_sched_barrier(0)
    Unit cur, nxt; int ui = 0;
    if (!S.next(0, cur)) return;
#define PG8_AOFFS(dst, u) do { const int _t = wave0 * 64 + lane_id_asm(); _Pragma("unroll") for (int _i = 0; _i < 2; ++_i) { int _R, _C; stage_rc(_t * 16 + _i * 8192, _R, _C); \
        _Pragma("unroll") for (int _h = 0; _h < 2; ++_h) \
        dst[_h][_i] = P::GATHER ? (unsigned)(((size_t)S.gather_row(u, _h * HALF + _R) * K + _C) * 2u) : (unsigned)((size_t)(_R * K + _C) * 2u); } } while (0)
    PG8_AOFFS(vcur, cur);
    LAS u32x4* const gslot = (LAS u32x4*)(lds + (TABL_OFF + 6144)) + tid;
    f32x4 acc[2][2][4][2];
#pragma unroll
    for (int a = 0; a < 2; ++a)
#pragma unroll
        for (int b = 0; b < 2; ++b)
#pragma unroll
            for (int m = 0; m < 4; ++m)
#pragma unroll
                for (int n = 0; n < 2; ++n) acc[a][b][m][n] = (f32x4){0.f, 0.f, 0.f, 0.f};
    bf16x8 At[4][2], B0[2][2], B1[2][2];
    const char* cA = S.a_ptr(cur); const char* cB = S.b_ptr(cur);
    PG8_STAGE(PG8_SB(0, 0), cB, voffB); PG8_STAGE(PG8_SB(0, 1), cB + hstep, voffB); PG8_STAGE(PG8_SA(0, 0), cA, vcur[0]); PG8_STAGE(PG8_SA(0, 1), PG8_A1(cA), PG8_V1);
    if (wr == 1) PG8_BAR;
    PG8_WAIT_V(2); PG8_BAR;
    PG8_STAGE(PG8_SB(1, 0), cB + kstep, voffB); PG8_STAGE(PG8_SA(1, 0), cA + kstep, vcur[0]); PG8_STAGE(PG8_SB(1, 1), cB + hstep + kstep, voffB);
    PG8_WAIT_V(6); PG8_BAR;
    for (;;) {
        const bool has_next = S.next(ui + 1, nxt);
        const char* nA = has_next ? S.a_ptr(nxt) : cA; const char* nB = has_next ? S.b_ptr(nxt) : cB;
        if (P::GATHER) { if (has_next) { unsigned vn_[2][2]; PG8_AOFFS(vn_, nxt); *gslot = (u32x4){vn_[0][0], vn_[0][1], vn_[1][0], vn_[1][1]}; } }
        for (int t = 0; t < nt; t += 2) {
            const bool last = (t == nt - 2);
            const char* a1 = cA + (size_t)(t + 1) * kstep;
            const char* a2 = last ? nA : cA + (size_t)(t + 2) * kstep; const char* b2 = last ? nB : cB + (size_t)(t + 2) * kstep;
            const char* a3 = a2 + kstep; const char* b3 = b2 + kstep;
            PG8_LDB(B0, 0, 0); PG8_LDB(B1, 0, 1); PG8_SCHED; PG8_LDA(At, 0, 0); PG8_STAGE(PG8_SA(1, 1), PG8_A1(a1), PG8_V1);
            PG8_WAIT_V(8); PG8_WAIT_L(0); PG8_BAR; PG8_MMA(0, 0, At, B0); PG8_MMA(0, 1, At, B1); PG8_BAR; PG8_SCHED;
            if (P::GATHER) { if (last && has_next) { const u32x4 vn_ = *gslot; vcur[0][0] = vn_.x; vcur[0][1] = vn_.y; vcur[1][0] = vn_.z; vcur[1][1] = vn_.w; } }
            PG8_LDA(At, 0, 1); PG8_STAGE(PG8_SB(0, 0), b2, voffB); PG8_STAGE(PG8_SB(0, 1), b2 + hstep, voffB); PG8_STAGE(PG8_SA(0, 0), a2, vcur[0]);
            PG8_WAIT_V(8); PG8_WAIT_L(0); PG8_BAR; PG8_MMA(1, 0, At, B0); PG8_MMA(1, 1, At, B1); PG8_BAR; PG8_SCHED;
            PG8_LDB(B0, 1, 0); PG8_LDB(B1, 1, 1); PG8_SCHED; PG8_LDA(At, 1, 0); PG8_STAGE(PG8_SA(0, 1), PG8_A1(a2), PG8_V1);
            PG8_WAIT_V(8); PG8_WAIT_L(0); PG8_BAR; PG8_MMA(0, 0, At, B0); PG8_MMA(0, 1, At, B1); PG8_BAR; PG8_SCHED;
            PG8_LDA(At, 1, 1); PG8_STAGE(PG8_SB(1, 0), b3, voffB); PG8_STAGE(PG8_SB(1, 1), b3 + hstep, voffB); PG8_STAGE(PG8_SA(1, 0), a3, vcur[0]);
            PG8_WAIT_V(8); PG8_WAIT_L(0); PG8_BAR; PG8_MMA(1, 0, At, B0); PG8_MMA(1, 1, At, B1); PG8_BAR; PG8_SCHED;
        }
        if (wr == 0) PG8_BAR;
        PG8_SCHED;
        { const int l2 = lane_id_asm();
          S.epi(acc, cur, wave0 >> 2, wave0 & 3, l2 & 15, l2 >> 4); }
        if (!has_next) break;
#pragma unroll
        for (int a = 0; a < 2; ++a)
#pragma unroll
            for (int b = 0; b < 2; ++b)
#pragma unroll
                for (int m = 0; m < 4; ++m)
#pragma unroll
                    for (int n = 0; n < 2; ++n) acc[a][b][m][n] = (f32x4){0.f, 0.f, 0.f, 0.f};
        cur = nxt; cA = nA; cB = nB; ++ui;
        if (wr == 1) PG8_BAR;
    }
    PG8_WAIT_V(0);
    PG8_BAR;
#undef PG8_AOFFS
#undef PG8_SA
#undef PG8_SB
#undef PG8_SBR
#undef PG8_STAGE
#undef PG8_LDA
#undef PG8_LDB
#undef PG8_MMA
#undef PG8_CAT
#undef PG8_WAIT_V
#undef PG8_A1
#undef PG8_V1
#undef PG8_WAIT_L
#undef PG8_BAR
#undef PG8_SCHED
}
}
using pg8::Unit;
typedef f32x4 AccT[2][2][4][2];

struct Args {
    const float* x; const float* p; const float* w_in; const float* lb_logits; const float* hg_norm_w; const float* w_a; const float* w_h; const float* w_o;
    const float* ln1_w; const float* ln1_b; const float* router_w; const float* router_b; const float* ew_gate; const float* ew_up; const float* ew_down;
    const float* sw_gate; const float* sw_up; const float* sw_down; const float* w_pg; const float* w_pp; const float* ln2_w; const float* ln2_b;
    float* out; unsigned char* ws;
};
struct Frame { LAS unsigned char* lds; int tid, lane, wave, G, bid; };

#define LAMBDA_INL __attribute__((always_inline))
struct TrItem { const float* W; unsigned char* WT; int ldw, ldt, k0, n0, drow0, f8; };
DI void tr_load(const TrItem& d, int lane, float (&v)[32]) {
#pragma unroll
    for (int i = 0; i < 32; ++i) v[i] = __builtin_nontemporal_load(d.W + (size_t)(d.k0 + 2 * i + (lane >> 5)) * d.ldw + d.n0 + (lane & 31));
}
DI void tr_store(const TrItem& d, const float (&v)[32], LAS float* scr, int lane) {
#pragma unroll
    for (int i = 0; i < 32; ++i) scr[(2 * i + (lane >> 5)) * 33 + (lane & 31)] = v[i];
    asm volatile("s_waitcnt lgkmcnt(0)" ::: "memory");
    const int c = lane & 7;
#pragma unroll
    for (int j = 0; j < 4; ++j) { const int n = (lane >> 3) + 8 * j; const LAS float* s = scr + (8 * c) * 33 + n;
        if (d.f8) { u32x2 o; o.x = pk4_fp8(s[0 * 33] * W8S, s[1 * 33] * W8S, s[2 * 33] * W8S, s[3 * 33] * W8S); o.y = pk4_fp8(s[4 * 33] * W8S, s[5 * 33] * W8S, s[6 * 33] * W8S, s[7 * 33] * W8S);
            *(u32x2*)(d.WT + (size_t)(d.drow0 + n) * d.ldt + d.k0 + 8 * c) = o; }
        else { u32x4 o; o.x = pk2(s[0 * 33], s[1 * 33]); o.y = pk2(s[2 * 33], s[3 * 33]); o.z = pk2(s[4 * 33], s[5 * 33]); o.w = pk2(s[6 * 33], s[7 * 33]);
            *(u32x4*)((bf16*)d.WT + (size_t)(d.drow0 + n) * d.ldt + d.k0 + 8 * c) = o; } }
    asm volatile("s_waitcnt lgkmcnt(0)" ::: "memory");
}
DI TrItem tr_plain_item(const float* W, int N, void* WT, int ldt, int f8, int r) { const int nblk = N / 32, kb = r / nblk, nb = r % nblk; return TrItem{W, (unsigned char*)WT, N, ldt, 64 * kb, 32 * nb, 32 * nb, f8}; }
DI TrItem tr_gu_item(const float* Wg, const float* Wu, void* WT, int f8, int r) { const int which = r >> 7, rr = r & 127, kb = rr >> 3, nb = rr & 7, n0 = 32 * nb;
    return TrItem{which ? Wu : Wg, (unsigned char*)WT, 256, 1024, 64 * kb, n0, (n0 >> 7) * 256 + which * 128 + (n0 & 127), f8}; }
constexpr int I_WIN = 16 * (NIN / 32), I_WA = 8 * 32, I_WH = 16 * 32, I_WPP = 4 * 32, I_SGU = 256, I_SD = 4 * 32, I_WR = 16 * 2, I_EGU = 64 * 256;
constexpr int P0_NITEMS = I_WIN + I_WA + 3 * I_WH + I_WPP + I_SGU + I_SD + I_WR + I_EGU;
DI TrItem p0_item(const Args& a, int it) {
    unsigned char* ws = a.ws; int r = it;
    if (r < I_WIN) return tr_plain_item(a.w_in, NIN, ws + WS_WIN8, 1024, 1, r); r -= I_WIN;
    if (r < I_WA) return tr_plain_item(a.w_a, 1024, ws + WS_WA, 512, 1, r); r -= I_WA;
    if (r < I_WH) return tr_plain_item(a.w_h, 1024, ws + WS_WH, 1024, 1, r); r -= I_WH;
    if (r < I_WH) return tr_plain_item(a.w_o, 1024, ws + WS_WO, 1024, 1, r); r -= I_WH;
    if (r < I_WH) return tr_plain_item(a.w_pg, 1024, ws + WS_WPG, 1024, 1, r); r -= I_WH;
    if (r < I_WPP) return tr_plain_item(a.w_pp, 1024, ws + WS_WPP, 256, 0, r); r -= I_WPP;
    if (r < I_SGU) return tr_gu_item(a.sw_gate, a.sw_up, ws + WS_WSGU, 0, r); r -= I_SGU;
    if (r < I_SD) return tr_plain_item(a.sw_down, 1024, ws + WS_WSD, 256, 0, r); r -= I_SD;
    if (r < I_WR) return tr_plain_item(a.router_w, 64, ws + WS_WRT, 1024, 0, r); r -= I_WR;
    const int e = r >> 8; return tr_gu_item(a.ew_gate + (size_t)e * 1024 * 256, a.ew_up + (size_t)e * 1024 * 256, ws + WS_WEGU8 + (size_t)e * 512 * 1024, 1, r & 255);
}
DI TrItem p8_item(const Args& a, unsigned char* wed, int it) { const int e = it >> 7; return tr_plain_item(a.ew_down + (size_t)e * 256 * 1024, 1024, wed + (size_t)e * 1024 * 256, 256, 1, it & 127); }
template <class ItemFn>
DI void tr_run(const Frame& F, int nitems, ItemFn item) {
    LAS float* scr = (LAS float*)(F.lds + F.wave * 16384);
    const int gw = F.bid * 8 + F.wave, NGW = F.G * 8;
    float va[32], vb[32]; TrItem da, db; int it = gw;
    if (it < nitems) { da = item(it); tr_load(da, F.lane, va); }
    for (; it < nitems; it += 2 * NGW) {
        const int it2 = it + NGW, it3 = it2 + NGW;
        if (it2 < nitems) { db = item(it2); tr_load(db, F.lane, vb); }
        tr_store(da, va, scr, F.lane);
        if (it3 < nitems) { da = item(it3); tr_load(da, F.lane, va); }
        if (it2 < nitems) tr_store(db, vb, scr, F.lane);
    }
}
DI void p0_prologue(const Frame& F, const Args& a) {
    tr_run(F, P0_NITEMS, [&](int it) LAMBDA_INL { return p0_item(a, it); });
    unsigned char* ws = a.ws; const int gw = F.bid * 8 + F.wave, NGW = F.G * 8;
    for (int m0 = gw * 4; m0 < T; m0 += NGW * 4) {
        f32x4 v[4][4];
#pragma unroll
        for (int q = 0; q < 4; ++q)
#pragma unroll
            for (int j = 0; j < 4; ++j) v[q][j] = __builtin_nontemporal_load((const f32x4*)(a.x + (size_t)(m0 + q) * D) + F.lane + 64 * j);
#pragma unroll
        for (int q = 0; q < 4; ++q) { unsigned* o4 = (unsigned*)(ws + WS_X8 + (size_t)(m0 + q) * D) + F.lane;
#pragma unroll
            for (int j = 0; j < 4; ++j) { const f32x4 w4 = v[q][j]; o4[64 * j] = pk4_fp8(w4.x, w4.y, w4.z, w4.w); } }
    }
}

struct DenseBase {
    static constexpr bool GATHER = false, FP8 = false;
    pg8::StaticOrder S; const char* A; const char* Bt; int K;
    DI void init(const void* A_, const void* Bt_, int M, int N, int K_, int G, int c) { A = (const char*)A_; Bt = (const char*)Bt_; K = K_; S.init(M, N, G, c); }
    DI bool next(int i, Unit& u) const { return S.next(i, u); }
    DI const char* a_ptr(const Unit& u) const { return A + (size_t)u.pm * 256 * K * 2; }
    DI const char* b_ptr(const Unit& u) const { return Bt + (size_t)u.pn * 256 * K * 2; }
    DI int gather_row(const Unit&, int) const { return 0; }
};
DI u32x4 pack_bf8(const f32x4& v0, const f32x4& v1) { u32x4 w; w.x = pk2(v0[0], v0[1]); w.y = pk2(v0[2], v0[3]); w.z = pk2(v1[0], v1[1]); w.w = pk2(v1[2], v1[3]); return w; }
DI void unpack_bf8(const u32x4& w, f32x4& v0, f32x4& v1) {
    v0 = (f32x4){bf2f(w.x & 0xffffu), bf2f(w.x >> 16), bf2f(w.y & 0xffffu), bf2f(w.y >> 16)};
    v1 = (f32x4){bf2f(w.z & 0xffffu), bf2f(w.z >> 16), bf2f(w.w & 0xffffu), bf2f(w.w >> 16)};
}
template <class Fn> DI void epi_walk(const AccT& acc, const Unit& u, int wr, int wc, int fr, int fq, Fn fn) {
#pragma unroll
    for (int ai = 0; ai < 2; ++ai)
#pragma unroll
        for (int m = 0; m < 4; ++m) { const int row = u.pm * 256 + ai * 128 + wr * 64 + m * 16 + fr;
#pragma unroll
            for (int bj = 0; bj < 2; ++bj) { const int col = u.pn * 256 + bj * 128 + wc * 32 + 8 * fq; fn(row, col, bj, acc[ai][bj][m][0], acc[ai][bj][m][1]); } }
}

template <class Op, class Ld, class Fn> DI void epi_walk_ld(const AccT& acc, const Unit& u, int wr, int wc, int fr, int fq, Ld ld, Fn fn) {
#pragma unroll
    for (int ai = 0; ai < 2; ++ai) {
        Op ops[4][2];
#pragma unroll
        for (int m = 0; m < 4; ++m)
#pragma unroll
            for (int bj = 0; bj < 2; ++bj) ops[m][bj] = ld(u.pm * 256 + ai * 128 + wr * 64 + m * 16 + fr, u.pn * 256 + bj * 128 + wc * 32 + 8 * fq);
#pragma unroll
        for (int m = 0; m < 4; ++m)
#pragma unroll
            for (int bj = 0; bj < 2; ++bj) fn(u.pm * 256 + ai * 128 + wr * 64 + m * 16 + fr, u.pn * 256 + bj * 128 + wc * 32 + 8 * fq, acc[ai][bj][m][0], acc[ai][bj][m][1], ops[m][bj]);
    }
}
constexpr int XR_RING = 3 * 16384, XR_TAIL = TABL_OFF + 6144;
constexpr int XL_UNITS = 10, XL_TOK = TABL_OFF + 6144 + 8192, XL_GATE = XL_TOK + XL_UNITS * 512;
static_assert(XL_GATE + XL_UNITS * 1024 <= LDS_BYTES && (MAXTILES + 127) / 128 <= XL_UNITS, "MoE list images");
template <class Fn> DI void epi_walk_rows(const AccT& acc, const Unit& u, int wr, int wc, int fr, int fq, LAS unsigned char* lds, bf16* O, int ldo, Fn fn) {
    const int tid = (wr * 4 + wc) * 64 + fq * 16 + fr, wrow = wr * 16 + fr, rl = tid >> 5;
    const int woff = wrow * 512 + (((wc * 4 + fq) ^ (wrow & 7)) << 4);
    const int roff = rl * 512 + ((tid & 31) << 4);
    bf16* gp = O + (size_t)(u.pm * 256 + rl) * ldo + u.pn * 256 + (((tid & 31) ^ (rl & 7)) << 3);
#pragma unroll
    for (int ai = 0; ai < 2; ++ai)
#pragma unroll
        for (int m = 0; m < 4; ++m) { LAS unsigned char* xb = lds + ((m & 1) ? XR_TAIL : XR_RING);
#pragma unroll
            for (int bj = 0; bj < 2; ++bj) *(LAS u32x4*)(xb + woff + bj * 256) = fn(u.pm * 256 + ai * 128 + wr * 64 + m * 16 + fr, u.pn * 256 + bj * 128 + wc * 32 + 8 * fq, bj, acc[ai][bj][m][0], acc[ai][bj][m][1]);
            asm volatile("s_waitcnt lgkmcnt(0)" ::: "memory"); __builtin_amdgcn_s_barrier(); asm volatile("" ::: "memory");
#pragma unroll
            for (int j = 0; j < 2; ++j) { const u32x4 v = *(const LAS u32x4*)(xb + roff + j * 8192); *(u32x4*)(gp + (size_t)(ai * 128 + m * 16 + j * 64) * ldo) = v; } }
}
struct ProbQKV : DenseBase { static constexpr bool PERM = true, FP8 = true; bf16* O; LAS unsigned char* xl;
    DI void epi(const AccT& acc, const Unit& u, int wr, int wc, int fr, int fq) const {
        const float sc = (u.pn < 6 ? QSCALE : 1.0f) * W8I; bf16* o = O;
        epi_walk_rows(acc, u, wr, wc, fr, fq, xl, o, NATT, [=](int, int, int, f32x4 v0, f32x4 v1) LAMBDA_INL { return pack_bf8(v0 * sc, v1 * sc); });
    } };
struct ProbHG : DenseBase { static constexpr bool PERM = true, FP8 = true; bf16* R2; bf16* gates; const float* lbl;
    DI void epi(const AccT& acc, const Unit& u, int wr, int wc, int fr, int fq) const {
        const int seg = u.pn >> 2; bf16* r2 = R2; bf16* gt = gates;
        if (seg == 0) { epi_walk(acc, u, wr, wc, fr, fq, [=](int row, int col, int, f32x4 v0, f32x4 v1) LAMBDA_INL { *((u32x4*)(r2 + (size_t)row * NHG + col)) = pack_bf8(v0 * W8I, v1 * W8I); }); }
        else if (seg == 1) {
            const float* lbp = lbl + (u.pn - 4) * 256 + wc * 32 + 8 * fq;
            float la[2][8];
#pragma unroll
            for (int bj = 0; bj < 2; ++bj) { const f32x4 a0 = *(const f32x4*)(lbp + bj * 128), a1 = *(const f32x4*)(lbp + bj * 128 + 4), b0 = *(const f32x4*)(lbp + 1024 + bj * 128), b1 = *(const f32x4*)(lbp + 1024 + bj * 128 + 4);
#pragma unroll
                for (int j = 0; j < 4; ++j) { la[bj][j] = __builtin_amdgcn_rcpf(1.0f + __expf(b0[j] - a0[j])); la[bj][4 + j] = __builtin_amdgcn_rcpf(1.0f + __expf(b1[j] - a1[j])); } }
            epi_walk(acc, u, wr, wc, fr, fq, [&](int row, int col, int bj, f32x4 v0, f32x4 v1) LAMBDA_INL {
#pragma unroll
                for (int j = 0; j < 4; ++j) { const float l0 = bj ? la[1][j] : la[0][j], l1 = bj ? la[1][4 + j] : la[0][4 + j];
                    v0[j] = __logf(l0 + (1.0f - l0) * sigmoidf_(v0[j] * W8I)); v1[j] = __logf(l1 + (1.0f - l1) * sigmoidf_(v1[j] * W8I)); }
                *((u32x4*)(r2 + (size_t)row * NHG + col)) = pack_bf8(v0, v1); });
        } else if (seg < 4) {
            epi_walk(acc, u, wr, wc, fr, fq, [=](int row, int col, int, f32x4 v0, f32x4 v1) LAMBDA_INL {
#pragma unroll
                for (int j = 0; j < 4; ++j) { v0[j] = siluf_(v0[j] * W8I); v1[j] = siluf_(v1[j] * W8I); }
                *((u32x4*)(r2 + (size_t)row * NHG + col)) = pack_bf8(v0, v1); });
        } else {
            epi_walk(acc, u, wr, wc, fr, fq, [=](int row, int col, int, f32x4 v0, f32x4 v1) LAMBDA_INL {
#pragma unroll
                for (int j = 0; j < 4; ++j) { v0[j] = sigmoidf_(v0[j] * W8I); v1[j] = sigmoidf_(v1[j] * W8I); }
                *((u32x4*)(gt + (size_t)row * NGATE + (col - 4096))) = pack_bf8(v0, v1); });
        }
    } };
struct ProbBrA : DenseBase { static constexpr bool PERM = true, FP8 = true; const bf16* gates; bf16* O;
    DI void epi(const AccT& acc, const Unit& u, int wr, int wc, int fr, int fq) const {
        const bf16* gt = gates; bf16* o = O;
        epi_walk_ld<u32x4>(acc, u, wr, wc, fr, fq, [=](int row, int col) LAMBDA_INL { return *(const u32x4*)(gt + (size_t)row * NGATE + col); },
            [=](int row, int col, f32x4 v0, f32x4 v1, u32x4 gw) LAMBDA_INL { f32x4 g0, g1; unpack_bf8(gw, g0, g1); *(u32x4*)(o + (size_t)row * D + col) = pack_bf8(v0 * g0 * W8I, v1 * g1 * W8I); });
    } };
constexpr float MGS = 8.0f;
struct ProbBrH : DenseBase { static constexpr bool PERM = true, FP8 = true; const bf16* gates; const bf16* M1; unsigned char* O;
    DI void epi(const AccT& acc, const Unit& u, int wr, int wc, int fr, int fq) const {
        const bf16* gt = gates; const bf16* m1 = M1; unsigned char* o = O;
        struct Op2 { u32x4 g, p; };
        epi_walk_ld<Op2>(acc, u, wr, wc, fr, fq, [=](int row, int col) LAMBDA_INL { return Op2{*(const u32x4*)(gt + (size_t)row * NGATE + 1024 + col), *(const u32x4*)(m1 + (size_t)row * D + col)}; },
            [=](int row, int col, f32x4 v0, f32x4 v1, Op2 w) LAMBDA_INL {
                f32x4 g0, g1, p0, p1; unpack_bf8(w.g, g0, g1); unpack_bf8(w.p, p0, p1);
                v0 = (v0 * g0 * W8I + p0) * MGS; v1 = (v1 * g1 * W8I + p1) * MGS;
                *(u32x2*)(o + (size_t)row * D + col) = (u32x2){pk4_fp8(v0[0], v0[1], v0[2], v0[3]), pk4_fp8(v1[0], v1[1], v1[2], v1[3])}; });
    } };
struct ProbWo : DenseBase { static constexpr bool PERM = true, FP8 = true; const float* x; bf16* O;
    DI void epi(const AccT& acc, const Unit& u, int wr, int wc, int fr, int fq) const {
        const float* xp = x; bf16* o = O;
        struct OpX { f32x4 a, b; };
        epi_walk_ld<OpX>(acc, u, wr, wc, fr, fq, [=](int row, int col) LAMBDA_INL { return OpX{*(const f32x4*)(xp + (size_t)row * D + col), *(const f32x4*)(xp + (size_t)row * D + col + 4)}; },
            [=](int row, int col, f32x4 v0, f32x4 v1, OpX w) LAMBDA_INL { *(u32x4*)(o + (size_t)row * D + col) = pack_bf8(w.a * ALPHA + v0 * (W8I / MGS), w.b * ALPHA + v1 * (W8I / MGS)); });
    } };
struct ProbPP : DenseBase { static constexpr bool PERM = true; bf16* O;
    DI void epi(const AccT& acc, const Unit& u, int wr, int wc, int fr, int fq) const { bf16* o = O;
        epi_walk(acc, u, wr, wc, fr, fq, [=](int row, int col, int, f32x4 v0, f32x4 v1) LAMBDA_INL { *(u32x4*)(o + (size_t)row * D + col) = pack_bf8(v0, v1); }); } };
struct ProbPG : DenseBase { static constexpr bool PERM = true, FP8 = true; bf16* O;
    DI void epi(const AccT& acc, const Unit& u, int wr, int wc, int fr, int fq) const { bf16* o = O;
        epi_walk_ld<u32x4>(acc, u, wr, wc, fr, fq, [=](int row, int col) LAMBDA_INL { return *(const u32x4*)(o + (size_t)row * D + col); },
            [=](int row, int col, f32x4 v0, f32x4 v1, u32x4 pw) LAMBDA_INL { f32x4 p0, p1; unpack_bf8(pw, p0, p1);
#pragma unroll
                for (int j = 0; j < 4; ++j) { v0[j] = sigmoidf_(v0[j] * W8I) * p0[j]; v1[j] = sigmoidf_(v1[j] * W8I) * p1[j]; }
                *(u32x4*)(o + (size_t)row * D + col) = pack_bf8(v0, v1); });
    } };
template <bool SCALED>
DI void epi_swiglu(const AccT& acc, bf16* O, int ldo, int row0, int hcol0, int wr, int wc, int fr, int fq) {
    const float cs = SCALED ? W8I : 1.0f;
#pragma unroll
    for (int ai = 0; ai < 2; ++ai)
#pragma unroll
        for (int m = 0; m < 4; ++m) { const int row = row0 + ai * 128 + wr * 64 + m * 16 + fr; f32x4 h0, h1;
#pragma unroll
            for (int j = 0; j < 4; ++j) { h0[j] = siluf_(acc[ai][0][m][0][j] * cs) * (acc[ai][1][m][0][j] * cs); h1[j] = siluf_(acc[ai][0][m][1][j] * cs) * (acc[ai][1][m][1][j] * cs); }
            *(u32x4*)(O + (size_t)row * ldo + hcol0 + wc * 32 + 8 * fq) = pack_bf8(h0, h1); }
}
DI void epi_swiglu_moe(const AccT& acc, unsigned char* O, const LAS float* gate, int row0, int hcol0, int wr, int wc, int fr, int fq) {
#pragma unroll
    for (int ai = 0; ai < 2; ++ai)
#pragma unroll
        for (int m = 0; m < 4; ++m) { const int lr = ai * 128 + wr * 64 + m * 16 + fr, row = row0 + lr; const float gs = gate[lr] * (HGS * W8I); f32x4 h0, h1;
#pragma unroll
            for (int j = 0; j < 4; ++j) { h0[j] = siluf_(acc[ai][0][m][0][j] * W8I) * (acc[ai][1][m][0][j] * gs); h1[j] = siluf_(acc[ai][0][m][1][j] * W8I) * (acc[ai][1][m][1][j] * gs); }
            *(u32x2*)(O + (size_t)row * 256 + hcol0 + wc * 32 + 8 * fq) = (u32x2){pk4_fp8(h0[0], h0[1], h0[2], h0[3]), pk4_fp8(h1[0], h1[1], h1[2], h1[3])}; }
}
struct ProbSGU : DenseBase { static constexpr bool PERM = true; bf16* O;
    DI void epi(const AccT& acc, const Unit& u, int wr, int wc, int fr, int fq) const { epi_swiglu<false>(acc, O, 256, u.pm * 256, u.pn * 128, wr, wc, fr, fq); } };
struct ProbSD : DenseBase { static constexpr bool PERM = true; bf16* O; int rank, nlight;
    DI bool next(int i, Unit& u) const { if (rank < 0) return false; const int L = rank + i * nlight; if (L >= 512) return false; u.pm = L >> 2; u.pn = L & 3; return true; }
    DI void epi(const AccT& acc, const Unit& u, int wr, int wc, int fr, int fq) const {
        bf16* o = O;
        epi_walk_ld<u32x4>(acc, u, wr, wc, fr, fq, [=](int row, int col) LAMBDA_INL { return *(const u32x4*)(o + (size_t)row * D + col); },
            [=](int row, int col, f32x4 v0, f32x4 v1, u32x4 pw) LAMBDA_INL { f32x4 p0, p1; unpack_bf8(pw, p0, p1); *(u32x4*)(o + (size_t)row * D + col) = pack_bf8(v0 + p0, v1 + p1); });
    } };
struct ProbMoeUp { static constexpr bool PERM = true, GATHER = true, FP8 = true;
    const char* A; const char* Bt; int K; int ntiles, G, c; const LAS int* texp; const LAS unsigned short* ltok; const LAS float* lgate; unsigned char* H;
    DI bool next(int i, Unit& u) const { const int x = c & 7, sl = c >> 3; u.pm = i * 128 + (sl >> 1) * 8 + x; u.pn = sl & 1; return u.pm < ntiles; }
    DI const char* a_ptr(const Unit&) const { return A; }
    DI const char* b_ptr(const Unit& u) const { return Bt + ((size_t)__builtin_amdgcn_readfirstlane(texp[u.pm]) * 512 + (size_t)u.pn * 256) * 1024; }
    DI int gather_row(const Unit& u, int r) const { return (int)ltok[(u.pm >> 7) * 256 + r]; }
    DI void epi(const AccT& acc, const Unit& u, int wr, int wc, int fr, int fq) const { epi_swiglu_moe(acc, H, lgate + (u.pm >> 7) * 256, u.pm * 256, u.pn * 128, wr, wc, fr, fq); } };
constexpr int XPITCH = 272, XBUF = 32 * XPITCH;
struct ProbMoeDown { static constexpr bool PERM = true, GATHER = false, FP8 = true;
    const char* A; const char* Bt; int K; int ntiles, G, c; const LAS int* texp; unsigned char* Y; unsigned char* Y2;
    DI bool next(int i, Unit& u) const { const int x = c & 7, sl = c >> 3; u.pm = i * 64 + (sl >> 2) * 8 + x; u.pn = sl & 3; return u.pm < ntiles; }
    DI const char* a_ptr(const Unit& u) const { return A + (size_t)u.pm * 256 * 256; }
    DI const char* b_ptr(const Unit& u) const { return Bt + ((size_t)__builtin_amdgcn_readfirstlane(texp[u.pm]) * 1024 + (size_t)u.pn * 256) * 256; }
    DI int gather_row(const Unit&, int) const { return 0; }
    LAS unsigned char* xb;
    DI void epi(const AccT& acc, const Unit& u, int wr, int wc, int fr, int fq) const {
        unsigned char* y = (u.pm * 256 < YE_SPLIT ? Y : Y2 - (size_t)YE_SPLIT * D) + (size_t)u.pm * 256 * D + u.pn * 256;
        const int tid = (wr * 4 + wc) * 64 + fq * 16 + fr, rl = tid >> 4;
        LAS unsigned char* wp = xb + (wr * 16 + fr) * XPITCH + wc * 32 + 8 * fq;
        const LAS unsigned char* rp = xb + rl * XPITCH + (tid & 15) * 16;
        unsigned char* gp = y + (size_t)(64 * (rl >> 4) + (rl & 15)) * D + (tid & 15) * 16;
#pragma unroll
        for (int ai = 0; ai < 2; ++ai)
#pragma unroll
            for (int m = 0; m < 4; ++m) { const int bo = (m & 1) * XBUF;
#pragma unroll
                for (int bj = 0; bj < 2; ++bj) { const f32x4 v0 = acc[ai][bj][m][0], v1 = acc[ai][bj][m][1];
                    *(LAS u32x2*)(wp + bo + bj * 128) = (u32x2){pk4_fp8(v0[0], v0[1], v0[2], v0[3]), pk4_fp8(v1[0], v1[1], v1[2], v1[3])}; }
                asm volatile("s_waitcnt lgkmcnt(0)" ::: "memory"); __builtin_amdgcn_s_barrier(); asm volatile("" ::: "memory");
                const u32x4 v = *(const LAS u32x4*)(rp + bo);
                *(u32x4*)(gp + (size_t)(128 * ai + 16 * m) * D) = v; }
    } };

constexpr int VPITCH = 144;
constexpr int ATT_K = 0, ATT_V = 384 * VPITCH, ATT_O = 2 * 384 * VPITCH, ATT_O2 = TABL_OFF + 6144;
struct AttnU { int b, hd, g, r, rho, n0; };
DI AttnU attn_decode(int ui) {
    AttnU u; const int w16 = ui & 15; u.g = (ui >> 4) % 3; const int bh = (ui >> 4) / 3; u.hd = bh & 7; u.b = bh >> 3;
    u.r = u.g == 0 ? 1 : (u.g == 1 ? 4 : 16);
    u.rho = u.g == 0 ? 0 : (u.g == 1 ? (w16 & 3) : w16); const int pair = u.g == 0 ? w16 : (u.g == 1 ? (w16 >> 2) : 0);
    u.n0 = 256 * pair; return u;
}
DI void attn_load_kv(const bf16* qkv, const AttnU& u, int tid, u32x4 (&kreg)[6], u32x4 (&vreg)[6]) {
    const size_t tokb = (size_t)u.b * SEQ; const int colq = u.g * 512 + u.hd * 64;
#pragma unroll
    for (int i = 0; i < 6; ++i) { const int c = tid + 512 * i, row = c >> 3, ch = c & 7; int nk = u.n0 - 128 + row; nk = nk < 0 ? 0 : nk;
        const bf16* p = qkv + (tokb + (size_t)nk * u.r + u.rho) * NATT + colq + ch * 8;
        kreg[i] = *(const u32x4*)(p + 1536); vreg[i] = *(const u32x4*)(p + 3072); }
}
DI void attn_load_q(const bf16* qkv, const AttnU& u, int w, int l31, int hh, bf16x8 (&Qf)[4]) {
    const size_t tq = (size_t)u.b * SEQ + (size_t)(u.n0 + 32 * w + l31) * u.r + u.rho; const int colq = u.g * 512 + u.hd * 64;
#pragma unroll
    for (int s = 0; s < 4; ++s) Qf[s] = *(const bf16x8*)(qkv + tq * NATT + colq + 16 * s + 8 * hh);
}
DI void attn_phase(const Frame& F, const bf16* qkv, bf16* opart, float* lse) {
    LAS unsigned char* Kl = F.lds + ATT_K; LAS unsigned char* Vl = F.lds + ATT_V;
    const int lane = F.lane, l31 = lane & 31, hh = lane >> 5, w = F.wave;
    const int q4 = (lane & 15) >> 2, p4 = lane & 3, blk = (lane >> 4) & 1;
    constexpr int NU = NB * 8 * 3 * 16;
    if (F.bid >= NU) return;
    u32x4 kreg[6], vreg[6]; bf16x8 Qn[4];
    { const AttnU u0 = attn_decode(F.bid); attn_load_kv(qkv, u0, F.tid, kreg, vreg); attn_load_q(qkv, u0, w, l31, hh, Qn); }
    for (int ui = F.bid; ui < NU; ui += F.G) {
        const AttnU u = attn_decode(ui);
        const int r = u.r, n0 = u.n0, hd = u.hd;
        __syncthreads();
#pragma unroll
        for (int i = 0; i < 6; ++i) { const int c = F.tid + 512 * i, row = c >> 3, ch = c & 7;
            *(LAS u32x4*)(Kl + row * VPITCH + ch * 16) = kreg[i]; *(LAS u32x4*)(Vl + row * VPITCH + ch * 16) = vreg[i]; }
        bf16x8 Qf[4];
#pragma unroll
        for (int s = 0; s < 4; ++s) Qf[s] = Qn[s];
        __syncthreads();
        { const int un = ui + F.G < NU ? ui + F.G : ui; const AttnU u2 = attn_decode(un); attn_load_kv(qkv, u2, F.tid, kreg, vreg); attn_load_q(qkv, u2, w, l31, hh, Qn); }
        __builtin_amdgcn_sched_barrier(0);
        const int qq = 32 * w + l31; const size_t tq = (size_t)u.b * SEQ + (size_t)(n0 + qq) * r + u.rho;
        f32x16 sc[5];
        bf16x8 kf[2][4];
        { const LAS unsigned char* kr = Kl + (32 * w + l31) * VPITCH + 16 * hh;
#pragma unroll
          for (int s = 0; s < 4; ++s) kf[0][s] = *(const LAS bf16x8*)(kr + 32 * s); }
#pragma unroll
        for (int J = 0; J < 5; ++J) {
            if (J < 4) { const LAS unsigned char* kr = Kl + (32 * (w + J + 1) + l31) * VPITCH + 16 * hh;
#pragma unroll
                for (int s = 0; s < 4; ++s) kf[(J + 1) & 1][s] = *(const LAS bf16x8*)(kr + 32 * s); }
            f32x16 a;
#pragma unroll
            for (int i = 0; i < 16; ++i) a[i] = 0.f;
#pragma unroll
            for (int s = 0; s < 4; ++s) a = MFMA32(kf[J & 1][s], Qf[s], a);
            sc[J] = a;
            __builtin_amdgcn_sched_barrier(0);
        }
        const float slope2 = exp2f(-(float)(hd + 1)) * (float)r * LOG2E;
        int l31v = l31; asm volatile("" : "+v"(l31v));
        const int cb = 4 * hh;
        float nb[5]; bool tok[5];
#pragma unroll
        for (int J = 0; J < 5; ++J) { tok[J] = (n0 > 0) || (w + J >= 4); nb[J] = -slope2 * (float)(l31v + 128 - 32 * J - cb); }
        float mx = -3.0e38f;
#pragma unroll
        for (int J = 0; J < 5; ++J) {
            if (tok[J]) {
#pragma unroll
                for (int i = 0; i < 16; ++i) {
                    const int ci = (i & 3) + 8 * (i >> 2);
                    const float s2 = fmaf(slope2, (float)ci, sc[J][i] + nb[J]);
                    if (J == 0) mx = (ci + cb >= l31v) ? fmaxf(mx, s2) : mx;
                    else if (J == 4) mx = (ci + cb <= l31v) ? fmaxf(mx, s2) : mx;
                    else mx = fmaxf(mx, s2);
                }
            }
        }
        mx = xmax32(mx);
        float den = 0.f;
#pragma unroll
        for (int J = 0; J < 5; ++J) {
            if (tok[J]) {
                const float c2 = nb[J] - mx;
#pragma unroll
                for (int i = 0; i < 16; ++i) {
                    const int ci = (i & 3) + 8 * (i >> 2);
                    float pv = exp2f(fmaf(slope2, (float)ci, sc[J][i] + c2));
                    if (J == 0) pv = (ci + cb >= l31v) ? pv : 0.f;
                    if (J == 4) pv = (ci + cb <= l31v) ? pv : 0.f;
                    sc[J][i] = pv; den += pv;
                }
            } else {
#pragma unroll
                for (int i = 0; i < 16; ++i) sc[J][i] = 0.f;
            }
        }
        den = xsum32(den);
        f32x16 o[2];
#pragma unroll
        for (int c = 0; c < 2; ++c)
#pragma unroll
            for (int i = 0; i < 16; ++i) o[c][i] = 0.f;
#pragma unroll
        for (int J = 0; J < 5; ++J) {
#pragma unroll
            for (int s = 0; s < 2; ++s) {
                const bf16x8 pf = pack8(sc[J], s);
#pragma unroll
                for (int c = 0; c < 2; ++c) {
                    const LAS unsigned char* vb = Vl + (32 * (w + J) + 16 * s + 4 * hh + q4) * VPITCH + (32 * c + 16 * blk + 4 * p4) * 2;
                    const bf16x8 vf = cat8(vtr(vb), vtr(vb + 8 * VPITCH));
                    o[c] = MFMA32(vf, pf, o[c]);
                }
            }
            __builtin_amdgcn_sched_barrier(0);
        }
        const float inv = 1.0f / den;
        LAS unsigned char* ob = F.lds + (w < 4 ? ATT_O + w * (32 * VPITCH) : ATT_O2 + (w - 4) * (32 * VPITCH));
#pragma unroll
        for (int c = 0; c < 2; ++c)
#pragma unroll
            for (int i4 = 0; i4 < 4; ++i4) {
                const int d0 = 32 * c + 8 * i4 + 4 * hh;
                *(LAS u32x2*)(ob + l31 * VPITCH + d0 * 2) = (u32x2){pk2(o[c][4 * i4] * inv, o[c][4 * i4 + 1] * inv), pk2(o[c][4 * i4 + 2] * inv, o[c][4 * i4 + 3] * inv)};
            }
        asm volatile("s_waitcnt lgkmcnt(0)" ::: "memory");
#pragma unroll
        for (int k = 0; k < 4; ++k) { const int q2 = (lane >> 3) + 8 * k;
            const u32x4 v = *(const LAS u32x4*)(ob + q2 * VPITCH + (lane & 7) * 16);
            const size_t tq2 = (size_t)u.b * SEQ + (size_t)(n0 + 32 * w + q2) * r + u.rho;
            *(u32x4*)(opart + ((size_t)u.g * T + tq2) * 512 + hd * 64 + (lane & 7) * 8) = v; }
        if (hh == 0) lse[((size_t)u.g * T + tq) * 8 + hd] = mx + log2f(den);
    }
}
DI void attn_mix_phase(const Frame& F, const bf16* opart, const float* lse, unsigned char* yatt) {
    const int gw = F.bid * 8 + F.wave, NGW = F.G * 8;
    for (int it = gw; it < T / 2; it += 2 * NGW) {
        const int c16 = F.lane & 31, hd = c16 >> 2;
        int tk[2]; float l[2][3]; u32x4 sv[2][3][2];
#pragma unroll
        for (int q = 0; q < 2; ++q) { tk[q] = 2 * (it + q * NGW) + (F.lane >> 5);
#pragma unroll
            for (int g = 0; g < 3; ++g) { l[q][g] = lse[((size_t)g * T + tk[q]) * 8 + hd]; const u32x4* src = (const u32x4*)(opart + ((size_t)g * T + tk[q]) * 512 + c16 * 16); sv[q][g][0] = src[0]; sv[q][g][1] = src[1]; } }
#pragma unroll
        for (int q = 0; q < 2; ++q) {
            const float m = fmaxf(fmaxf(l[q][0], l[q][1]), l[q][2]);
            float wsum = 0.f, wg[3];
#pragma unroll
            for (int g = 0; g < 3; ++g) { wg[g] = exp2f(l[q][g] - m); wsum += wg[g]; }
            const float inv = 1.0f / wsum;
            f32x4 a0 = {0, 0, 0, 0}, a1 = a0, a2 = a0, a3 = a0;
#pragma unroll
            for (int g = 0; g < 3; ++g) { f32x4 v0, v1, v2, v3; unpack_bf8(sv[q][g][0], v0, v1); unpack_bf8(sv[q][g][1], v2, v3);
                const float ww = wg[g] * inv; a0 += v0 * ww; a1 += v1 * ww; a2 += v2 * ww; a3 += v3 * ww; }
            *(u32x4*)(yatt + (size_t)tk[q] * 512 + c16 * 16) = (u32x4){pk4_fp8(a0[0], a0[1], a0[2], a0[3]), pk4_fp8(a1[0], a1[1], a1[2], a1[3]), pk4_fp8(a2[0], a2[1], a2[2], a2[3]), pk4_fp8(a3[0], a3[1], a3[2], a3[3])};
        }
    }
}

constexpr int HP = 272;
constexpr int HG_QD = 0, HG_KI = 32 * HP, HG_KE = 2 * 32 * HP, HG_VV = 3 * 32 * HP, HG_DD = 4 * 32 * HP, HG_SSQ = HG_DD + 512, HG_TOT = HG_SSQ + 512, HG_Y = HG_TOT + 2048, HGY_P = 136, HG_HALF = HG_Y + 32 * HGY_P;
struct HgRaw { unsigned lfp[8], qp[8]; u32x4 v0, v1; };
DI void hgrn_load(const bf16* R2, size_t tok0, int hd, int cp, int sg, int tidh, HgRaw& w) {
    const bf16* src = R2 + (tok0 + 8 * sg) * NHG + hd * 128 + 2 * cp;
#pragma unroll
    for (int tt = 0; tt < 8; ++tt) { w.lfp[tt] = *(const unsigned*)(src + (size_t)tt * NHG + 1024); w.qp[tt] = *(const unsigned*)(src + (size_t)tt * NHG); }
    const int row = tidh >> 3, ch = tidh & 7; const bf16* vs = R2 + (tok0 + row) * NHG + 2048 + hd * 128;
    w.v0 = *(const u32x4*)(vs + ch * 8); w.v1 = *(const u32x4*)(vs + (ch + 8) * 8);
}
template <bool OUT>
DI void hgrn_phase(const Frame& F, const bf16* R2, float* Lst, float* Dtot, const float* gain, unsigned char* yhg) {
    const int hf = F.wave >> 2, wv = F.wave & 3, tidh = F.tid & 255, lane = F.lane, l31 = lane & 31, hh = lane >> 5;
    const int q4 = (lane & 15) >> 2, p4 = lane & 3, blk = (lane >> 4) & 1;
    LAS unsigned char* base = F.lds + hf * HG_HALF;
    const int cp = tidh & 63, sg = tidh >> 6;
    for (int it0 = F.bid * 2; it0 < 512; it0 += F.G * 2) {
        const int item = it0 + hf, j = item & 7, bhd = item >> 3, hd = bhd & 7, b = bhd >> 3;
        const bool active = OUT || (j < 7);
        f32x16 S[4];
#pragma unroll
        for (int kb = 0; kb < 4; ++kb)
#pragma unroll
            for (int i = 0; i < 16; ++i) S[kb][i] = 0.f;
        if (OUT) {
            for (int i0 = 0; i0 < j; ++i0) {
                const float* Lp = Lst + (size_t)(bhd * 8 + i0) * 16384; const float* Dp = Dtot + (bhd * 8 + i0) * 128;
#pragma unroll
                for (int kb = 0; kb < 4; ++kb)
#pragma unroll
                    for (int i4 = 0; i4 < 4; ++i4) { const f32x4 dd = *(const f32x4*)(Dp + 32 * kb + 8 * i4 + 4 * hh);
#pragma unroll
                        for (int e = 0; e < 4; ++e) S[kb][4 * i4 + e] = S[kb][4 * i4 + e] * dd[e] + Lp[(32 * kb + 8 * i4 + 4 * hh + e) * 128 + 32 * wv + l31]; }
            }
        }
        float dsum0 = 0.f, dsum1 = 0.f;
        const size_t tokI = (size_t)b * SEQ + j * 512;
        HgRaw raw; hgrn_load(R2, tokI, hd, cp, sg, tidh, raw);
        for (int c = 0; c < 16; ++c) {
            const size_t tok0 = tokI + c * 32;
            float lf0[8], lf1[8], cs0[8], cs1[8];
            { float r0 = 0.f, r1 = 0.f;
#pragma unroll
              for (int tt = 0; tt < 8; ++tt) { lf0[tt] = bf2f(raw.lfp[tt] & 0xffffu); lf1[tt] = bf2f(raw.lfp[tt] >> 16); r0 += lf0[tt]; r1 += lf1[tt]; cs0[tt] = r0; cs1[tt] = r1; } }
            LAS float* tot = (LAS float*)(base + HG_TOT);
            *(LAS f32x2*)(tot + sg * 128 + 2 * cp) = (f32x2){cs0[7], cs1[7]};
            __syncthreads();
            if (OUT && c > 0) {
                const int row = tidh >> 3, ch = tidh & 7; const LAS unsigned char* yp = base + HG_Y + row * HGY_P + ch * 16;
                const u32x2 ya = *(const LAS u32x2*)yp, yb = *(const LAS u32x2*)(yp + 8);
                *(u32x4*)(yhg + (tok0 - 32 + row) * D + hd * 128 + ch * 16) = (u32x4){ya.x, ya.y, yb.x, yb.y}; }
            float off0 = 0.f, off1 = 0.f, bl0 = 0.f, bl1 = 0.f;
#pragma unroll
            for (int g2 = 0; g2 < 4; ++g2) { const f32x2 tv = *(const LAS f32x2*)(tot + g2 * 128 + 2 * cp); bl0 += tv.x; bl1 += tv.y; if (g2 < sg) { off0 += tv.x; off1 += tv.y; } }
#pragma unroll
            for (int tt = 0; tt < 8; ++tt) {
                const float bt0 = off0 + cs0[tt], bt1 = off1 + cs1[tt], e0 = __expf(bt0), e1 = __expf(bt1);
                const float key0 = 1.0f - __expf(lf0[tt]), key1 = 1.0f - __expf(lf1[tt]);
                const int t = 8 * sg + tt;
                *(LAS unsigned*)(base + HG_QD + t * HP + cp * 4) = pk2(bf2f(raw.qp[tt] & 0xffffu) * e0, bf2f(raw.qp[tt] >> 16) * e1);
                *(LAS unsigned*)(base + HG_KI + t * HP + cp * 4) = pk2(key0 * __expf(-bt0), key1 * __expf(-bt1));
                *(LAS unsigned*)(base + HG_KE + t * HP + cp * 4) = pk2(key0 * __expf(bl0 - bt0), key1 * __expf(bl1 - bt1));
            }
            { const int row = tidh >> 3, ch = tidh & 7;
              *(LAS u32x4*)(base + HG_VV + row * HP + ch * 16) = raw.v0; *(LAS u32x4*)(base + HG_VV + row * HP + (ch + 8) * 16) = raw.v1; }
            if (sg == 0) { *(LAS f32x2*)(base + HG_DD + cp * 8) = (f32x2){__expf(bl0), __expf(bl1)}; dsum0 += bl0; dsum1 += bl1; }
            __syncthreads();
            if (c < 15) hgrn_load(R2, tok0 + 32, hd, cp, sg, tidh, raw);
            u32x2 sgv[4];
            if (OUT) {
#pragma unroll
                for (int i4 = 0; i4 < 4; ++i4) sgv[i4] = *(const u32x2*)(R2 + (tok0 + l31) * NHG + 3072 + hd * 128 + 32 * wv + 8 * i4 + 4 * hh);
            }
            __builtin_amdgcn_sched_barrier(0);
            f32x16 o;
            if (OUT) {
                f32x16 X;
#pragma unroll
                for (int i = 0; i < 16; ++i) X[i] = 0.f;
#pragma unroll
                for (int s2 = 0; s2 < 8; ++s2) {
                    const bf16x8 af = *(const LAS bf16x8*)(base + HG_KI + l31 * HP + (16 * s2 + 8 * hh) * 2);
                    const bf16x8 bfr = *(const LAS bf16x8*)(base + HG_QD + l31 * HP + (16 * s2 + 8 * hh) * 2);
                    X = MFMA32(af, bfr, X);
                }
                int l31v = l31; asm volatile("" : "+v"(l31v));
#pragma unroll
                for (int i = 0; i < 16; ++i) X[i] = (crow(i, hh) <= l31v) ? X[i] : 0.f;
#pragma unroll
                for (int i = 0; i < 16; ++i) o[i] = 0.f;
#pragma unroll
                for (int s2 = 0; s2 < 2; ++s2) {
                    const LAS unsigned char* vb = base + HG_VV + (16 * s2 + 4 * hh + q4) * HP + (32 * wv + 16 * blk + 4 * p4) * 2;
                    const bf16x8 vf = cat8(vtr(vb), vtr(vb + 8 * HP));
                    o = MFMA32(vf, pack8(X, s2), o);
                }
#pragma unroll
                for (int kb = 0; kb < 4; ++kb)
#pragma unroll
                    for (int s2 = 0; s2 < 2; ++s2) {
                        const LAS unsigned char* qb = base + HG_QD + l31 * HP + (32 * kb + 16 * s2 + 4 * hh) * 2;
                        const bf16x8 qf = cat8(*(const LAS s16x4*)qb, *(const LAS s16x4*)(qb + 16));
                        o = MFMA32(pack8(S[kb], s2), qf, o);
                    }
            }
            if (active) {
#pragma unroll
                for (int kb = 0; kb < 4; ++kb) {
#pragma unroll
                    for (int i4 = 0; i4 < 4; ++i4) { const f32x4 dv = *(const LAS f32x4*)(base + HG_DD + (32 * kb + 8 * i4 + 4 * hh) * 4);
#pragma unroll
                        for (int e = 0; e < 4; ++e) S[kb][4 * i4 + e] *= dv[e]; }
#pragma unroll
                    for (int s2 = 0; s2 < 2; ++s2) {
                        const LAS unsigned char* kb_ = base + HG_KE + (16 * s2 + 8 * hh + q4) * HP + (32 * kb + 16 * blk + 4 * p4) * 2;
                        const LAS unsigned char* vb = base + HG_VV + (16 * s2 + 8 * hh + q4) * HP + (32 * wv + 16 * blk + 4 * p4) * 2;
                        const bf16x8 kf = cat8(vtr(kb_), vtr(kb_ + 4 * HP));
                        const bf16x8 vf = cat8(vtr(vb), vtr(vb + 4 * HP));
                        S[kb] = MFMA32(kf, vf, S[kb]);
                    }
                }
            }
            if (OUT) {
                float ss = 0.f;
#pragma unroll
                for (int i = 0; i < 16; ++i) ss += o[i] * o[i];
                ss = xsum32(ss);
                LAS float* ssq = (LAS float*)(base + HG_SSQ);
                if (hh == 0) ssq[wv * 32 + l31] = ss;
                __syncthreads();
                const float tot2 = ssq[l31] + ssq[32 + l31] + ssq[64 + l31] + ssq[96 + l31];
                const float rinv = rsqrtf(tot2 * (1.0f / 128.0f) + RMS_EPS);
                const size_t tk = tok0 + l31;
#pragma unroll
                for (int i4 = 0; i4 < 4; ++i4) {
                    const int dv0 = 32 * wv + 8 * i4 + 4 * hh;
                    const f32x4 gn = *(const f32x4*)(gain + hd * 128 + dv0);
                    const u32x2 sgg = sgv[i4];
                    const float y0 = o[4 * i4] * rinv * gn[0] * bf2f(sgg.x & 0xffffu), y1 = o[4 * i4 + 1] * rinv * gn[1] * bf2f(sgg.x >> 16);
                    const float y2 = o[4 * i4 + 2] * rinv * gn[2] * bf2f(sgg.y & 0xffffu), y3 = o[4 * i4 + 3] * rinv * gn[3] * bf2f(sgg.y >> 16);
                    *(LAS unsigned*)(base + HG_Y + l31 * HGY_P + dv0) = pk4_fp8(y0, y1, y2, y3);
                }
            }
        }
        if (!OUT && active) {
            float* Lp = Lst + (size_t)item * 16384;
#pragma unroll
            for (int kb = 0; kb < 4; ++kb)
#pragma unroll
                for (int i = 0; i < 16; ++i) Lp[(32 * kb + crow(i, hh)) * 128 + 32 * wv + l31] = S[kb][i];
            if (sg == 0) *(f32x2*)(Dtot + item * 128 + 2 * cp) = (f32x2){__expf(dsum0), __expf(dsum1)};
        }
        __syncthreads();
        if (OUT) { const int row = tidh >> 3, ch = tidh & 7; const LAS unsigned char* yp = base + HG_Y + row * HGY_P + ch * 16;
            const u32x2 ya = *(const LAS u32x2*)yp, yb = *(const LAS u32x2*)(yp + 8);
            *(u32x4*)(yhg + ((size_t)b * SEQ + j * 512 + 15 * 32 + row) * D + hd * 128 + ch * 16) = (u32x4){ya.x, ya.y, yb.x, yb.y}; }
    }
}

constexpr int H1_KE = 0, H1_VV = 64 * HP, H1_DD = 2 * 64 * HP, H1_TOT = H1_DD + 512, H1_HALF = H1_TOT + 2048;
struct Hg1Raw { unsigned lfp[16]; u32x4 v[4]; };
DI void hgrn1_load(const bf16* R2, size_t tok0, int hd, int cp, int sg, int tidh, Hg1Raw& w) {
    const bf16* src = R2 + (tok0 + 16 * sg) * NHG + hd * 128 + 1024 + 2 * cp;
#pragma unroll
    for (int tt = 0; tt < 16; ++tt) w.lfp[tt] = *(const unsigned*)(src + (size_t)tt * NHG);
#pragma unroll
    for (int i = 0; i < 4; ++i) { const int id = tidh + 256 * i, row = id >> 4, ch = id & 15; w.v[i] = *(const u32x4*)(R2 + (tok0 + row) * NHG + 2048 + hd * 128 + ch * 8); }
}
DI void hgrn_l1_phase(const Frame& F, const bf16* R2, float* Lst, float* Dtot) {
    const int hf = F.wave >> 2, wv = F.wave & 3, tidh = F.tid & 255, lane = F.lane, l31 = lane & 31, hh = lane >> 5;
    const int q4 = (lane & 15) >> 2, p4 = lane & 3, blk = (lane >> 4) & 1;
    LAS unsigned char* base = F.lds + hf * H1_HALF;
    const int cp = tidh & 63, sg = tidh >> 6;
    for (int it0 = F.bid * 2; it0 < 512; it0 += F.G * 2) {
        const int item = it0 + hf, j = item & 7, bhd = item >> 3, hd = bhd & 7, b = bhd >> 3;
        const bool active = j < 7;
        f32x16 S[4];
#pragma unroll
        for (int kb = 0; kb < 4; ++kb)
#pragma unroll
            for (int i = 0; i < 16; ++i) S[kb][i] = 0.f;
        float dsum0 = 0.f, dsum1 = 0.f;
        const size_t tokI = (size_t)b * SEQ + j * 512;
        Hg1Raw raw; hgrn1_load(R2, tokI, hd, cp, sg, tidh, raw);
        for (int c = 0; c < 8; ++c) {
            float lf0[16], lf1[16], cs0[16], cs1[16];
            { float r0 = 0.f, r1 = 0.f;
#pragma unroll
              for (int tt = 0; tt < 16; ++tt) { lf0[tt] = bf2f(raw.lfp[tt] & 0xffffu); lf1[tt] = bf2f(raw.lfp[tt] >> 16); r0 += lf0[tt]; r1 += lf1[tt]; cs0[tt] = r0; cs1[tt] = r1; } }
            LAS float* tot = (LAS float*)(base + H1_TOT);
            *(LAS f32x2*)(tot + sg * 128 + 2 * cp) = (f32x2){cs0[15], cs1[15]};
            __syncthreads();
            float off0 = 0.f, off1 = 0.f, bl0 = 0.f, bl1 = 0.f;
#pragma unroll
            for (int g2 = 0; g2 < 4; ++g2) { const f32x2 tv = *(const LAS f32x2*)(tot + g2 * 128 + 2 * cp); bl0 += tv.x; bl1 += tv.y; if (g2 < sg) { off0 += tv.x; off1 += tv.y; } }
#pragma unroll
            for (int tt = 0; tt < 16; ++tt) {
                const float key0 = 1.0f - __expf(lf0[tt]), key1 = 1.0f - __expf(lf1[tt]);
                *(LAS unsigned*)(base + H1_KE + (16 * sg + tt) * HP + cp * 4) = pk2(key0 * __expf(bl0 - off0 - cs0[tt]), key1 * __expf(bl1 - off1 - cs1[tt]));
            }
#pragma unroll
            for (int i = 0; i < 4; ++i) { const int id = tidh + 256 * i, row = id >> 4, ch = id & 15; *(LAS u32x4*)(base + H1_VV + row * HP + ch * 16) = raw.v[i]; }
            if (sg == 0) { *(LAS f32x2*)(base + H1_DD + cp * 8) = (f32x2){__expf(bl0), __expf(bl1)}; dsum0 += bl0; dsum1 += bl1; }
            __syncthreads();
            if (c < 7) hgrn1_load(R2, tokI + 64 * (c + 1), hd, cp, sg, tidh, raw);
            __builtin_amdgcn_sched_barrier(0);
            if (active) {
#pragma unroll
                for (int kb = 0; kb < 4; ++kb) {
#pragma unroll
                    for (int i4 = 0; i4 < 4; ++i4) { const f32x4 dv = *(const LAS f32x4*)(base + H1_DD + (32 * kb + 8 * i4 + 4 * hh) * 4);
#pragma unroll
                        for (int e = 0; e < 4; ++e) S[kb][4 * i4 + e] *= dv[e]; }
#pragma unroll
                    for (int s2 = 0; s2 < 4; ++s2) {
                        const LAS unsigned char* kb_ = base + H1_KE + (16 * s2 + 8 * hh + q4) * HP + (32 * kb + 16 * blk + 4 * p4) * 2;
                        const LAS unsigned char* vb = base + H1_VV + (16 * s2 + 8 * hh + q4) * HP + (32 * wv + 16 * blk + 4 * p4) * 2;
                        S[kb] = MFMA32(cat8(vtr(kb_), vtr(kb_ + 4 * HP)), cat8(vtr(vb), vtr(vb + 4 * HP)), S[kb]);
                    }
                }
            }
        }
        if (active) {
            float* Lp = Lst + (size_t)item * 16384;
#pragma unroll
            for (int kb = 0; kb < 4; ++kb)
#pragma unroll
                for (int i = 0; i < 16; ++i) Lp[(32 * kb + crow(i, hh)) * 128 + 32 * wv + l31] = S[kb][i];
            if (sg == 0) *(f32x2*)(Dtot + item * 128 + 2 * cp) = (f32x2){__expf(dsum0), __expf(dsum1)};
        }
        __syncthreads();
    }
}

DI void ln_router_phase(const Frame& F, const Args& a, const bf16* pre1, bf16* x1b, unsigned char* x18, const bf16* wrt, int* tok_e, float* tok_g, unsigned* cnt_tbl) {
    constexpr int XP = 2048 + 16;
    LAS unsigned char* XS = F.lds; LAS float* LG = (LAS float*)(F.lds + 32 * XP);
    LAS unsigned* hist = (LAS unsigned*)(F.lds + TABL_OFF);
    const int lane = F.lane, w = F.wave, mt = w >> 2, nt = w & 3, l15 = lane & 15, lq = lane >> 4;
    if (F.tid < 64) hist[F.tid] = 0u;
    bf16x8 Bf[32];
    { const bf16* wp = wrt + (size_t)(16 * nt + l15) * 1024 + 8 * lq;
#pragma unroll
      for (int s2 = 0; s2 < 32; ++s2) Bf[s2] = *(const bf16x8*)(wp + 32 * s2); }
    const float rbias = a.router_b[lane];
    u32x2 pfr[4][4];
#pragma unroll
    for (int r = 0; r < 4; ++r)
#pragma unroll
        for (int j = 0; j < 4; ++j) pfr[r][j] = *((const u32x2*)(pre1 + (size_t)(F.bid * 128 + w * 4 + r) * D) + lane + 64 * j);
    for (int bt = 0; bt < 4; ++bt) {
        const int rowb = F.bid * 128 + bt * 32;
        __syncthreads();
#pragma unroll
        for (int r = 0; r < 4; ++r) {
            const int lr = w * 4 + r;
            f32x4 v[4]; float sm = 0.f;
#pragma unroll
            for (int j = 0; j < 4; ++j) { const u32x2 pv = pfr[r][j]; v[j] = (f32x4){bf2f(pv.x & 0xffffu), bf2f(pv.x >> 16), bf2f(pv.y & 0xffffu), bf2f(pv.y >> 16)}; sm += (v[j].x + v[j].y) + (v[j].z + v[j].w); }
            const float mean = wave_sum(sm) * (1.f / D); float s2 = 0.f;
#pragma unroll
            for (int j = 0; j < 4; ++j) { v[j] = v[j] - mean; s2 += (v[j].x * v[j].x + v[j].y * v[j].y) + (v[j].z * v[j].z + v[j].w * v[j].w); }
            const float rstd = rsqrtf(wave_sum(s2) * (1.f / D) + LN_EPS);
            u32x2* o8 = (u32x2*)(x1b + (size_t)(rowb + lr) * D) + lane; unsigned* o4 = (unsigned*)(x18 + (size_t)(rowb + lr) * D) + lane;
#pragma unroll
            for (int j = 0; j < 4; ++j) {
                const f32x4 w4 = *((const f32x4*)a.ln1_w + lane + 64 * j), b4 = *((const f32x4*)a.ln1_b + lane + 64 * j);
                const f32x4 y = v[j] * rstd * w4 + b4;
                const u32x2 yb = (u32x2){pk2(y.x, y.y), pk2(y.z, y.w)};
                o8[64 * j] = yb; o4[64 * j] = pk4_fp8(y.x, y.y, y.z, y.w);
                *(LAS u32x2*)(XS + lr * XP + (lane + 64 * j) * 8) = yb;
            }
        }
        __syncthreads();
        if (bt < 3) {
#pragma unroll
            for (int r = 0; r < 4; ++r)
#pragma unroll
                for (int j = 0; j < 4; ++j) pfr[r][j] = *((const u32x2*)(pre1 + (size_t)(rowb + 32 + w * 4 + r) * D) + lane + 64 * j);
        }
        f32x4 acc = {0.f, 0.f, 0.f, 0.f};
        { const LAS unsigned char* ap = XS + (16 * mt + l15) * XP + 16 * lq;
#pragma unroll
          for (int s2 = 0; s2 < 32; ++s2) acc = __builtin_amdgcn_mfma_f32_16x16x32_bf16(*(const LAS bf16x8*)(ap + 64 * s2), Bf[s2], acc, 0, 0, 0); }
#pragma unroll
        for (int i = 0; i < 4; ++i) LG[(16 * mt + 4 * lq + i) * 64 + 16 * nt + l15] = acc[i];
        __syncthreads();
#pragma unroll
        for (int r = 0; r < 4; ++r) {
            const int lr = w * 4 + r; const float lgt = LG[lr * 64 + lane];
            const float sgm = 1.0f / (1.0f + expf(-lgt)), sel = sgm + rbias;
            float m1 = sel;
            m1 = fmaxf(m1, xshf<1>(m1)); m1 = fmaxf(m1, xshf<2>(m1)); m1 = fmaxf(m1, xshf<4>(m1));
            const unsigned long long eqm = __ballot(sel == m1);
            const unsigned grpbits = (unsigned)((eqm >> (lane & 56)) & 0xffull);
            const int first = __builtin_ctz(grpbits) + (lane & 56);
            float m2 = (lane == first) ? -3.0e38f : sel;
            m2 = fmaxf(m2, xshf<1>(m2)); m2 = fmaxf(m2, xshf<2>(m2)); m2 = fmaxf(m2, xshf<4>(m2));
            const float gs = m1 + m2;
            int grank = 0;
#pragma unroll
            for (int g2 = 0; g2 < 8; ++g2) { const float og = __builtin_bit_cast(float, __builtin_amdgcn_readlane(__builtin_bit_cast(int, gs), 8 * g2));
                grank += (og > gs || (og == gs && g2 < (lane >> 3))) ? 1 : 0; }
            const bool gsel = grank < 4;
            const float ms = gsel ? sel : -INFINITY;
            int rank = 0;
#pragma unroll 8
            for (int e2 = 0; e2 < 64; ++e2) { const float oe = __builtin_bit_cast(float, __builtin_amdgcn_readlane(__builtin_bit_cast(int, ms), e2));
                rank += (oe > ms || (oe == ms && e2 < lane)) ? 1 : 0; }
            const bool chosen = gsel && rank < 8;
            const float ssum = wave_sum(chosen ? sgm : 0.f);
            if (chosen) {
                const size_t o = (size_t)(rowb + lr) * 8 + rank;
                tok_e[o] = lane; tok_g[o] = sgm / ssum * 2.5f;
                __hip_atomic_fetch_add(hist + lane, 1u, __ATOMIC_RELAXED, __HIP_MEMORY_SCOPE_WORKGROUP);
            }
        }
    }
    __syncthreads();
    if (F.tid < 64) cnt_tbl[F.bid * 64 + F.tid] = hist[F.tid];
}
DI void p8_convert(const Frame& F, const Args& a, unsigned char* wed, bf16* pb) {
    tr_run(F, 64 * 128, [&](int it) LAMBDA_INL { return p8_item(a, wed, it); });
    const int gw = F.bid * 8 + F.wave, NGW = F.G * 8;
    for (int m0 = gw * 8; m0 < T; m0 += NGW * 8) { f32x4 v[8];
#pragma unroll
        for (int q = 0; q < 8; ++q) v[q] = *((const f32x4*)(a.p + (size_t)(m0 + q) * 256) + F.lane);
#pragma unroll
        for (int q = 0; q < 8; ++q) *((u32x2*)(pb + (size_t)(m0 + q) * 256) + F.lane) = (u32x2){pk2(v[q].x, v[q].y), pk2(v[q].z, v[q].w)}; }
}
DI void scatter_phase(const Frame& F, const unsigned* cnt_tbl, const int* tok_e, const float* tok_g, int* pos_of, int* tok_list, float* gate_list, unsigned* tabw) {
    LAS unsigned* part = (LAS unsigned*)(F.lds);
    LAS unsigned* cur = (LAS unsigned*)(F.lds + 8192);
    LAS unsigned* segs = (LAS unsigned*)(F.lds + 8192 + 256);
    constexpr int WPB = 256 / NBLK, WPP = WPB / 8;
    const int w = F.bid, blk = w / WPB, wl = w % WPB, e = F.tid & 63, part_i = F.tid >> 6;
    __syncthreads();
    { unsigned tot = 0, below = 0;
      for (int q = 0; q < WPP; ++q) { const int w2 = part_i * WPP + q; const unsigned c = cnt_tbl[(blk * WPB + w2) * 64 + e]; tot += c; below += (w2 < wl) ? c : 0u; }
      part[part_i * 64 + e] = tot; part[512 + part_i * 64 + e] = below; }
    __syncthreads();
    if (F.tid < 64) { unsigned tot = 0, below = 0;
        for (int q = 0; q < 8; ++q) { tot += part[q * 64 + e]; below += part[512 + q * 64 + e]; }
        segs[64 + e] = tot; segs[128 + e] = (tot + 255u) >> 8; cur[e] = below; }
    __syncthreads();
    if (F.tid == 0) { unsigned run = 0; for (int q = 0; q < 64; ++q) { segs[q] = run * 256u; run += segs[128 + q]; } segs[192] = run; }
    __syncthreads();
    if (F.tid < 64) cur[e] += segs[e];
    __syncthreads();
    int* tl = tok_list + (size_t)blk * MAXROWS; float* gl = gate_list + (size_t)blk * MAXROWS;
    for (int i = F.tid; i < 128 * 8; i += 512) {
        const int tk = w * 128 + (i >> 3); const int ex = tok_e[(size_t)tk * 8 + (i & 7)];
        const unsigned pos = __hip_atomic_fetch_add(cur + ex, 1u, __ATOMIC_RELAXED, __HIP_MEMORY_SCOPE_WORKGROUP);
        tl[pos] = tk; gl[pos] = tok_g[(size_t)tk * 8 + (i & 7)]; pos_of[(size_t)tk * 8 + (i & 7)] = (int)pos;
    }
    if (wl < 64) { const unsigned st = segs[wl] + segs[64 + wl], en = segs[wl] + segs[128 + wl] * 256u;
      for (unsigned pz = st + F.tid; pz < en; pz += 512) { tl[pz] = blk * TB; gl[pz] = 0.f; } }
    if (wl == 0) {
        if (F.tid == 0) tabw[TB_NT + blk * 64] = segs[192];
        if (F.tid < 64) { const unsigned t0 = segs[e] >> 8, nt_ = segs[128 + e]; for (unsigned q = 0; q < nt_; ++q) tabw[TB_TEXP + blk * MAXTILES + t0 + q] = (unsigned)e; }
    }
}
struct CombHdr { int pos[8]; u32x2 xv[4], dv[4]; };
DI void comb_load_hdr(CombHdr& h, size_t tk, const bf16* x1b, const bf16* dense, const int* pos_of, int lane) {
#pragma unroll
    for (int k = 0; k < 8; ++k) h.pos[k] = pos_of[tk * 8 + k];
#pragma unroll
    for (int j = 0; j < 4; ++j) { h.xv[j] = *((const u32x2*)(x1b + tk * D) + lane + 64 * j); h.dv[j] = *((const u32x2*)(dense + tk * D) + lane + 64 * j); }
}
DI void combine_phase(const Frame& F, const Args& a, int blk, const bf16* x1b, const bf16* dense, const unsigned char* ye, const unsigned char* ye2, const int* pos_of) {
    const int gw = F.bid * 8 + F.wave, NGW = F.G * 8, lane = F.lane;
    CombHdr h[2];
    if (gw < TB) { comb_load_hdr(h[0], (size_t)blk * TB + gw, x1b, dense, pos_of, lane); comb_load_hdr(h[1], (size_t)blk * TB + gw + NGW, x1b, dense, pos_of, lane); }
    for (int it = gw; it < TB; it += 2 * NGW) {
        unsigned yv[2][8][4];
#pragma unroll
        for (int q = 0; q < 2; ++q)
#pragma unroll
            for (int k = 0; k < 8; ++k) { const int p = h[q].pos[k]; const unsigned char* yr = p < YE_SPLIT ? ye + (size_t)p * D : ye2 + (size_t)(p - YE_SPLIT) * D;
#pragma unroll
                for (int j = 0; j < 4; ++j) yv[q][k][j] = *((const unsigned*)yr + lane + 64 * j); }
        f32x4 v[2][4];
#pragma unroll
        for (int q = 0; q < 2; ++q)
#pragma unroll
            for (int j = 0; j < 4; ++j) { const u32x2 xv = h[q].xv[j], dv = h[q].dv[j];
                v[q][j] = (f32x4){bf2f(xv.x & 0xffffu), bf2f(xv.x >> 16), bf2f(xv.y & 0xffffu), bf2f(xv.y >> 16)} * ALPHA
                        + (f32x4){bf2f(dv.x & 0xffffu), bf2f(dv.x >> 16), bf2f(dv.y & 0xffffu), bf2f(dv.y >> 16)}; }
        const int itn = it + 2 * NGW;
        if (itn < TB) { comb_load_hdr(h[0], (size_t)blk * TB + itn, x1b, dense, pos_of, lane); comb_load_hdr(h[1], (size_t)blk * TB + itn + NGW, x1b, dense, pos_of, lane); }
#pragma unroll
        for (int q = 0; q < 2; ++q) {
            const size_t tk = (size_t)blk * TB + it + q * NGW;
#pragma unroll
            for (int k = 0; k < 8; ++k)
#pragma unroll
                for (int j = 0; j < 4; ++j) v[q][j] += unpk4_fp8(yv[q][k][j]) * YEI;
            float sm = 0.f;
#pragma unroll
            for (int j = 0; j < 4; ++j) sm += (v[q][j].x + v[q][j].y) + (v[q][j].z + v[q][j].w);
            const float mean = wave_sum(sm) * (1.f / D); float s2 = 0.f;
#pragma unroll
            for (int j = 0; j < 4; ++j) { v[q][j] = v[q][j] - mean; s2 += (v[q][j].x * v[q][j].x + v[q][j].y * v[q][j].y) + (v[q][j].z * v[q][j].z + v[q][j].w * v[q][j].w); }
            const float rstd = rsqrtf(wave_sum(s2) * (1.f / D) + LN_EPS);
#pragma unroll
            for (int j = 0; j < 4; ++j) {
                const f32x4 w4 = *((const f32x4*)a.ln2_w + lane + 64 * j), b4 = *((const f32x4*)a.ln2_b + lane + 64 * j);
                *((f32x4*)(a.out + tk * D) + lane + 64 * j) = v[q][j] * rstd * w4 + b4;
            }
        }
    }
}

#ifndef PHASE_MASK
#define PHASE_MASK 0xffffffffu
#endif
#define PH(k) ((PHASE_MASK >> (k)) & 1u)
#ifndef REPEAT_MASK
#define REPEAT_MASK 0u
#endif
#define RP(k) (1 + (int)((REPEAT_MASK >> (k)) & 1u))
typedef const __attribute__((address_space(4))) Args* KArgsPtr;
DI KArgsPtr kargs_ptr() { KArgsPtr p = (KArgsPtr)__builtin_amdgcn_kernarg_segment_ptr(); asm volatile("" : "+s"(p)); return p; }
__global__ void __launch_bounds__(512, 2) fwd_kernel(Args a_by_value) {
    extern __shared__ __attribute__((aligned(16))) unsigned char lds_raw[];
    (void)a_by_value;
#if defined(__HIP_DEVICE_COMPILE__)
    const int wave0 = __builtin_amdgcn_readfirstlane((int)threadIdx.x >> 6) & 7;
#define LEADER() (wave0 == 0 && lane_id_asm() == 0)
#define FRAME() Frame F; { const int l_ = lane_id_asm(); F.tid = wave0 * 64 + l_; F.lane = l_; F.wave = wave0; F.G = gridDim.x; F.bid = blockIdx.x; F.lds = (LAS unsigned char*)lds_raw; } \
                const Args a = *kargs_ptr(); unsigned char* const ws = a.ws; unsigned char* const dob = (unsigned char*)a.out; unsigned* const tabw = (unsigned*)(ws + WS_TAB); (void)dob; (void)tabw;
#define STAMP() do {} while (0)
#define GRIDBAR() do { GRIDBAR_(); STAMP(); } while (0)
#define GRIDBAR_() do { XcdBarrier bar_; bar_.bar = (unsigned*)(kargs_ptr()->ws + WS_CTL) + 4096; bar_.x = xb_xcc_id(); bar_.st = (volatile LAS unsigned*)((LAS unsigned char*)lds_raw + MISC_OFF) + 8; xcd_barrier(bar_, LEADER()); } while (0)
    {
        for (int u = threadIdx.x; u < (LDS_BYTES - LDSCTL_OFF) / 4; u += 512) ((LAS unsigned*)((LAS unsigned char*)lds_raw + LDSCTL_OFF))[u] = 0u;
        __syncthreads();
        (void)xcd_barrier_post((unsigned*)(kargs_ptr()->ws + WS_CTL) + 4096, (volatile LAS unsigned*)((LAS unsigned char*)lds_raw + MISC_OFF) + 8, LEADER());
        STAMP();
    }
    _Pragma("unroll 1") for (int rep_ = 0; rep_ < RP(0); ++rep_) if (PH(0)) { FRAME(); p0_prologue(F, a); }
    GRIDBAR();
    _Pragma("unroll 1") for (int rep_ = 0; rep_ < RP(1); ++rep_) if (PH(1)) { FRAME(); ProbQKV P; P.init(ws + WS_X8, ws + WS_WIN8, T, NATT, 512, F.G, F.bid); P.O = (bf16*)(ws + WS_R); P.xl = F.lds; pg8::gemm_phase(F.lds, P, wave0); }
    GRIDBAR();
    _Pragma("unroll 1") for (int rep_ = 0; rep_ < RP(2); ++rep_) if (PH(2)) { FRAME(); attn_phase(F, (const bf16*)(ws + WS_R), (bf16*)dob, (float*)(dob + DO_LSE)); }
    GRIDBAR();
    _Pragma("unroll 1") for (int rep_ = 0; rep_ < RP(3); ++rep_) if (PH(3)) { FRAME(); attn_mix_phase(F, (const bf16*)dob, (const float*)(dob + DO_LSE), ws + WS_YATT); }
    GRIDBAR();
    _Pragma("unroll 1") for (int rep_ = 0; rep_ < RP(4); ++rep_) if (PH(4)) { FRAME(); ProbHG P; P.init(ws + WS_X8, ws + WS_WIN8 + (size_t)NATT * 1024, T, NHG + NGATE, 512, F.G, F.bid); P.R2 = (bf16*)(ws + WS_R); P.gates = (bf16*)dob; P.lbl = a.lb_logits; pg8::gemm_phase(F.lds, P, wave0); }
    GRIDBAR();
    _Pragma("unroll 1") for (int rep_ = 0; rep_ < RP(5); ++rep_) if (PH(5)) { FRAME(); hgrn_l1_phase(F, (const bf16*)(ws + WS_R), (float*)(ws + WS_L), (float*)(ws + WS_TAB + 128 * 1024)); }
    GRIDBAR();
    _Pragma("unroll 1") for (int rep_ = 0; rep_ < RP(7); ++rep_) if (PH(7)) { FRAME(); hgrn_phase<true>(F, (const bf16*)(ws + WS_R), (float*)(ws + WS_L), (float*)(ws + WS_TAB + 128 * 1024), a.hg_norm_w, ws + WS_XB); }
    GRIDBAR();
    _Pragma("unroll 1") for (int rep_ = 0; rep_ < RP(8); ++rep_) if (PH(8)) { FRAME(); ProbBrA P; P.init(ws + WS_YATT, ws + WS_WA, T, 1024, 256, F.G, F.bid); P.gates = (const bf16*)dob; P.O = (bf16*)(ws + WS_MERGED); pg8::gemm_phase(F.lds, P, wave0); }
    __syncthreads();
    _Pragma("unroll 1") for (int rep_ = 0; rep_ < RP(9); ++rep_) if (PH(9)) { FRAME(); ProbBrH P; P.init(ws + WS_XB, ws + WS_WH, T, 1024, 512, F.G, F.bid); P.gates = (const bf16*)dob; P.M1 = (const bf16*)(ws + WS_MERGED); P.O = ws + 320 * MiB; pg8::gemm_phase(F.lds, P, wave0); }
    GRIDBAR();
    _Pragma("unroll 1") for (int rep_ = 0; rep_ < RP(10); ++rep_) if (PH(10)) { FRAME(); ProbWo P; P.init(ws + 320 * MiB, ws + WS_WO, T, 1024, 512, F.G, F.bid); P.x = a.x; P.O = (bf16*)(ws + WS_PRE1); pg8::gemm_phase(F.lds, P, wave0); }
    GRIDBAR();
    _Pragma("unroll 1") for (int rep_ = 0; rep_ < RP(11); ++rep_) if (PH(11)) { FRAME(); ln_router_phase(F, a, (const bf16*)(ws + WS_PRE1), (bf16*)(ws + WS_X1B), ws + WS_X8, (const bf16*)(ws + WS_WRT), (int*)(ws + WS_LISTS + LS_TOKE), (float*)(ws + WS_LISTS + LS_TOKG), tabw + TB_CNT); }
    __syncthreads();
    _Pragma("unroll 1") for (int rep_ = 0; rep_ < RP(12); ++rep_) if (PH(12)) { FRAME(); p8_convert(F, a, dob + DO_WED, (bf16*)(ws + WS_PB)); }
    GRIDBAR();
    _Pragma("unroll 1") for (int rep_ = 0; rep_ < RP(13); ++rep_) if (PH(13)) { FRAME(); scatter_phase(F, tabw + TB_CNT, (const int*)(ws + WS_LISTS + LS_TOKE), (const float*)(ws + WS_LISTS + LS_TOKG), (int*)(ws + WS_LISTS + LS_POS),
                  (int*)(ws + WS_LISTS + LS_TOKLIST), (float*)(ws + WS_LISTS + LS_GATELIST), tabw); }
    __syncthreads();
    _Pragma("unroll 1") for (int rep_ = 0; rep_ < RP(14); ++rep_) if (PH(14)) { FRAME(); ProbPP P; P.init(ws + WS_PB, ws + WS_WPP, T, 1024, 256, F.G, F.bid); P.O = (bf16*)(ws + WS_XB); pg8::gemm_phase(F.lds, P, wave0); }
    __syncthreads();
    _Pragma("unroll 1") for (int rep_ = 0; rep_ < RP(15); ++rep_) if (PH(15)) { FRAME(); ProbPG P; P.init(ws + WS_X8, ws + WS_WPG, T, 1024, 512, F.G, F.bid); P.O = (bf16*)(ws + WS_XB); pg8::gemm_phase(F.lds, P, wave0); }
    __syncthreads();
    _Pragma("unroll 1") for (int rep_ = 0; rep_ < RP(16); ++rep_) if (PH(16)) { FRAME(); ProbSGU P; P.init(ws + WS_X1B, ws + WS_WSGU, T, 512, 1024, F.G, F.bid); P.O = (bf16*)(ws + WS_HS); pg8::gemm_phase(F.lds, P, wave0); }
    GRIDBAR();
#pragma unroll 1
    for (int blk = 0; blk < NBLK; ++blk) {
        {
            FRAME(); LAS int* texp = (LAS int*)(F.lds + TABL_OFF);
            const int ntl = (int)tabw[TB_NT + blk * 64];
            __syncthreads();
            for (int i = F.tid; i < ntl; i += 512) texp[i] = (int)tabw[TB_TEXP + blk * MAXTILES + i];
            __syncthreads();
            LAS unsigned short* ltok = (LAS unsigned short*)(F.lds + XL_TOK); LAS float* lgate = (LAS float*)(F.lds + XL_GATE);
            { const int* tl_ = (const int*)(ws + WS_LISTS + LS_TOKLIST) + (size_t)blk * MAXROWS; const float* gl_ = (const float*)(ws + WS_LISTS + LS_GATELIST) + (size_t)blk * MAXROWS;
              const int pm0_ = ((F.bid >> 3) >> 1) * 8 + (F.bid & 7);
#pragma unroll 1
              for (int i = 0; i < XL_UNITS; ++i) { const int pm_ = i * 128 + pm0_; if (pm_ >= ntl) break;
                  if (F.tid < 256) ltok[i * 256 + F.tid] = (unsigned short)tl_[pm_ * 256 + F.tid]; else lgate[i * 256 + F.tid - 256] = gl_[pm_ * 256 + F.tid - 256]; } }
            __syncthreads();
            _Pragma("unroll 1") for (int rep_ = 0; rep_ < RP(18); ++rep_) if (PH(18)) { ProbMoeUp P; P.A = (const char*)(ws + WS_X8); P.Bt = (const char*)(ws + WS_WEGU8); P.K = 512; P.ntiles = ntl; P.G = F.G; P.c = F.bid; P.texp = texp;
              P.ltok = ltok; P.lgate = lgate; P.H = dob; pg8::gemm_phase(F.lds, P, wave0); }
            __syncthreads();
            _Pragma("unroll 1") for (int rep_ = 0; rep_ < RP(17); ++rep_) if (PH(17)) { ProbSD P; P.init(ws + WS_HS, ws + WS_WSD, T, 1024, 256, F.G, F.bid); P.O = (bf16*)(ws + WS_XB);
              const int x_ = F.bid & 7, sl_ = F.bid >> 3, q_ = (sl_ >> 1) * 8 + x_, full_ = ntl - 8 * 128;
              const int fl_ = full_ < 0 ? 0 : (full_ > 128 ? 128 : full_);
              P.nlight = 2 * (128 - fl_); P.rank = (q_ >= fl_ && P.nlight > 0) ? 2 * (q_ - fl_) + (sl_ & 1) : -1;
              if (P.nlight == 0) { P.nlight = 256; P.rank = F.bid; }
              pg8::gemm_phase(F.lds, P, wave0); }
        }
        GRIDBAR();
        {
            FRAME(); LAS int* texp = (LAS int*)(F.lds + TABL_OFF);
            const int ntl = (int)tabw[TB_NT + blk * 64];
            _Pragma("unroll 1") for (int rep_ = 0; rep_ < RP(19); ++rep_) if (PH(19)) { ProbMoeDown P; P.A = (const char*)dob; P.Bt = (const char*)(dob + DO_WED); P.K = 128; P.ntiles = ntl; P.G = F.G; P.c = F.bid; P.texp = texp;
              P.Y = ws + WS_YE; P.Y2 = ws + WS_YE2; P.xb = F.lds + (TABL_OFF + 6144); pg8::gemm_phase(F.lds, P, wave0); }
        }
        GRIDBAR();
        _Pragma("unroll 1") for (int rep_ = 0; rep_ < RP(20); ++rep_) if (PH(20)) { FRAME(); combine_phase(F, a, blk, (const bf16*)(ws + WS_X1B), (const bf16*)(ws + WS_XB), ws + WS_YE, ws + WS_YE2, (const int*)(ws + WS_LISTS + LS_POS)); }
    }
#endif
}

extern "C" void kernel_launch(void* const* d_in, const int* in_sizes, int n_in, void* d_out, int out_size, void* d_ws, size_t ws_size, hipStream_t stream) {
    static int grid = 0;
    if (grid == 0) {
        if (n_in != 22 || in_sizes[0] != T * D || out_size != T * D || ws_size < WS_END) { fprintf(stderr, "kernel_launch: unexpected shapes (n_in %d, in0 %d, out %d, ws %zu)\n", n_in, n_in > 0 ? in_sizes[0] : -1, out_size, ws_size); grid = -1; return; }
        int dev = 0, cus = 0, per_cu = 0;
        if (hipGetDevice(&dev) != hipSuccess || hipDeviceGetAttribute(&cus, hipDeviceAttributeMultiprocessorCount, dev) != hipSuccess) { grid = -1; return; }
        if (hipFuncSetAttribute((const void*)fwd_kernel, hipFuncAttributeMaxDynamicSharedMemorySize, LDS_BYTES) != hipSuccess) { fprintf(stderr, "kernel_launch: hipFuncSetAttribute failed\n"); grid = -1; return; }
        if (hipOccupancyMaxActiveBlocksPerMultiprocessor(&per_cu, (const void*)fwd_kernel, 512, LDS_BYTES) != hipSuccess || per_cu < 1) fprintf(stderr, "kernel_launch: occupancy query says %d\n", per_cu);
        (void)hipGetLastError();
        grid = cus;
        if (grid != 256) { fprintf(stderr, "kernel_launch: built for 256 CUs, device has %d\n", cus); grid = -1; return; }
    }
    if (grid < 0) return;
    if (hipMemsetAsync((char*)d_ws + WS_CTL, 0, CTL_ZERO_BYTES, stream) != hipSuccess) return;
    Args a{};
    const float** pp = (const float**)&a;
    for (int i = 0; i < 22; ++i) pp[i] = (const float*)d_in[i];
    a.out = (float*)d_out; a.ws = (unsigned char*)d_ws;
    hipLaunchKernelGGL(fwd_kernel, dim3(grid), dim3(512), LDS_BYTES, stream, a);
}
```

```cpp
#include <hip/hip_runtime.h>
#include <cstdio>
#include <cstdint>

#define LAS __attribute__((address_space(3)))
#define GAS __attribute__((address_space(1)))
#define DI __device__ __forceinline__
typedef unsigned short bf16;
typedef short bf16x8 __attribute__((ext_vector_type(8)));
typedef short s16x4 __attribute__((ext_vector_type(4)));
typedef short v4i16_t __attribute__((ext_vector_type(4)));
typedef float f32x2 __attribute__((ext_vector_type(2)));
typedef float f32x4 __attribute__((ext_vector_type(4)));
typedef float f32x16 __attribute__((ext_vector_type(16)));
typedef unsigned u32x2 __attribute__((ext_vector_type(2)));
typedef unsigned u32x4 __attribute__((ext_vector_type(4)));
typedef __bf16 bf16x2_t __attribute__((ext_vector_type(2)));
typedef int v8i32 __attribute__((ext_vector_type(8)));
typedef short s16x16 __attribute__((ext_vector_type(16)));

constexpr int NB = 8, SEQ = 4096, T = NB * SEQ, D = 1024;
constexpr int NIN = 10752, NATT = 4608, NHG = 4096, NGATE = 2048;
constexpr int NEXP = 64, TOPK = 8, EFF = 256;
constexpr int NBLK = 1, TB = T / NBLK;
constexpr int MAXTILES = TB * TOPK / 256 + NEXP;
constexpr int MAXROWS = MAXTILES * 256;
constexpr float LN_EPS = 1e-5f, RMS_EPS = 1e-6f;
constexpr float ALPHA = 1.18920711500272f;
constexpr float LOG2E = 1.4426950408889634f;
constexpr float QSCALE = 0.125f * LOG2E;
constexpr float W8S = 32.0f, W8I = 1.0f / 32.0f;
constexpr float HGS = 8.0f;
constexpr float YEI = 1.0f / (8.0f * 32.0f);

constexpr size_t MiB = 1u << 20;
constexpr size_t WS_CTL = 0, CTL_ZERO_BYTES = 64 * 1024;
constexpr size_t WS_TAB = 512 * 1024;
constexpr size_t WS_LISTS = 1 * MiB;
constexpr size_t WS_WIN8 = 1 * MiB, WS_WIN = 6 * MiB, WS_WA = 22 * MiB, WS_WH = 23 * MiB, WS_WO = 25 * MiB, WS_WPG = 27 * MiB, WS_WPP = 29 * MiB, WS_WSGU = 30 * MiB, WS_WSD = 31 * MiB, WS_WEGU8 = 32 * MiB, WS_X8 = 64 * MiB;
constexpr size_t WS_WRT = 29 * MiB + 512 * 1024;
constexpr size_t WS_PB = 96 * MiB, WS_HS = 112 * MiB;
constexpr size_t WS_XB = 128 * MiB;
constexpr size_t WS_R = 192 * MiB;
constexpr size_t WS_L = 448 * MiB;
constexpr size_t WS_YATT = 480 * MiB;
constexpr size_t WS_MERGED = 192 * MiB, WS_PRE1 = 256 * MiB, WS_X1B = 448 * MiB;
constexpr size_t WS_YE = 192 * MiB, WS_YE2 = 96 * MiB;
constexpr int YE_SPLIT = 262144;
constexpr size_t WS_END = 512 * MiB;
static_assert(WS_YE + (size_t)YE_SPLIT * 1024 <= WS_X1B && WS_YE2 + (size_t)(MAXROWS - YE_SPLIT) * 1024 <= 128 * MiB && (size_t)MAXROWS * 256 <= 96 * MiB, "ws map");
constexpr size_t LS_TOKE = 0, LS_TOKG = 1 * MiB, LS_POS = 2 * MiB, LS_TOKLIST = 3 * MiB, LS_GATELIST = 3 * MiB + (size_t)NBLK * MAXROWS * 4;
static_assert(LS_GATELIST + (size_t)NBLK * MAXROWS * 4 <= 7 * MiB, "lists");
constexpr size_t DO_LSE = 96 * MiB, DO_WED = 96 * MiB;
constexpr int TB_CNT = 0;
constexpr int TB_NT = 256 * 64;
constexpr int TB_TEXP = TB_NT + 4 * 64;
constexpr int TB_TCNT = TB_TEXP + 4 * MAXTILES;

constexpr int RING_BYTES = 131072, LDSCTL_OFF = RING_BYTES, MISC_OFF = LDSCTL_OFF + 320, TABL_OFF = LDSCTL_OFF + 1024, LDS_BYTES = 163840;

DI float bf2f(unsigned b) { return __uint_as_float(b << 16); }
DI unsigned f2bf(float f) { unsigned u = __float_as_uint(f); return (u + 0x7fffu + ((u >> 16) & 1u)) >> 16; }
DI unsigned pk2(float lo, float hi) { f32x2 v = {lo, hi}; bf16x2_t b = __builtin_convertvector(v, bf16x2_t); return __builtin_bit_cast(unsigned, b); }
DI unsigned pk4_fp8(float a, float b, float c, float d) { int w = 0; w = __builtin_amdgcn_cvt_pk_fp8_f32(a, b, w, false); w = __builtin_amdgcn_cvt_pk_fp8_f32(c, d, w, true); return (unsigned)w; }
DI f32x4 unpk4_fp8(unsigned w) { const f32x2 lo = __builtin_amdgcn_cvt_pk_f32_fp8((int)w, false), hi = __builtin_amdgcn_cvt_pk_f32_fp8((int)w, true); return (f32x4){lo.x, lo.y, hi.x, hi.y}; }
DI float sigmoidf_(float v) { return __builtin_amdgcn_rcpf(1.0f + __expf(-v)); }
DI float siluf_(float v) { return v * sigmoidf_(v); }
template <int M> DI float xshf(float v) {
    if constexpr (M == 32) { const auto rr = __builtin_amdgcn_permlane32_swap(__float_as_uint(v), __float_as_uint(v), false, false); return __uint_as_float(rr[0] == __float_as_uint(v) ? rr[1] : rr[0]); }
    else return __builtin_bit_cast(float, __builtin_amdgcn_ds_swizzle(__builtin_bit_cast(int, v), 0x1F | (M << 10)));
}
DI float xsum32(float v) { const auto rr = __builtin_amdgcn_permlane32_swap(__float_as_uint(v), __float_as_uint(v), false, false); return __uint_as_float(rr[0]) + __uint_as_float(rr[1]); }
DI float xmax32(float v) { const auto rr = __builtin_amdgcn_permlane32_swap(__float_as_uint(v), __float_as_uint(v), false, false); return fmaxf(__uint_as_float(rr[0]), __uint_as_float(rr[1])); }
DI float wave_sum(float v) {
    v += xshf<1>(v); v += xshf<2>(v); v += xshf<4>(v); v += xshf<8>(v); v += xshf<16>(v);
    return xsum32(v);
}
DI int lane_id_asm() { int l; asm volatile("v_mbcnt_lo_u32_b32 %0, -1, 0\n\tv_mbcnt_hi_u32_b32 %0, -1, %0" : "=v"(l)); return l & 63; }
DI int crow(int r, int hi) { return (r & 3) + 8 * (r >> 2) + 4 * hi; }
DI s16x4 vtr(const LAS unsigned char* p) { return __builtin_bit_cast(s16x4, __builtin_amdgcn_ds_read_tr16_b64_v4i16((LAS v4i16_t*)p)); }
DI bf16x8 cat8(s16x4 lo, s16x4 hi) { return (bf16x8){lo[0], lo[1], lo[2], lo[3], hi[0], hi[1], hi[2], hi[3]}; }
DI bf16x8 pack8(const f32x16& x, int s) {
    u32x4 p; p.x = pk2(x[8 * s], x[8 * s + 1]); p.y = pk2(x[8 * s + 2], x[8 * s + 3]); p.z = pk2(x[8 * s + 4], x[8 * s + 5]); p.w = pk2(x[8 * s + 6], x[8 * s + 7]);
    return __builtin_bit_cast(bf16x8, p);
}
#define MFMA32(a, b, c) __builtin_amdgcn_mfma_f32_32x32x16_bf16((a), (b), (c), 0, 0, 0)

#define XB_TMO      128
#define XB_XCNT(j)  (256  + 64 * (j))
#define XB_XSUB(j)  (1280 + 64 * (j))
#define XB_XGEN(j)  (2304 + 64 * (j))
#define XB_TOP      3328
#define XB_TOPGEN   3392
#define XCD_BAR_WORDS 3456
#define XB_SPIN_CAP (1u << 18)
DI unsigned xb_ld(unsigned* p)              { return __hip_atomic_load(p, __ATOMIC_RELAXED, __HIP_MEMORY_SCOPE_AGENT); }
DI unsigned xb_add(unsigned* p, unsigned v) { return __hip_atomic_fetch_add(p, v, __ATOMIC_RELAXED, __HIP_MEMORY_SCOPE_AGENT); }
DI unsigned xb_xcc_id() { return (unsigned)__builtin_amdgcn_s_getreg((3 << 11) | 20) & 0xFu; }
#define XB_SPIN(cond, bar) do { unsigned _sp = 0; while (cond) { __builtin_amdgcn_s_sleep(1); \
    if ((++_sp & 255u) == 0u) { if (xb_ld(&(bar)[XB_TMO])) break; if (_sp > XB_SPIN_CAP) { atomicAdd(&(bar)[XB_TMO], 1u); break; } } } } while (0)
struct XcdBarrier { unsigned* bar; unsigned x; volatile LAS unsigned* st; };
DI XcdBarrier xcd_barrier_post(unsigned* bar, volatile LAS unsigned* st, bool leader) {
    XcdBarrier b; b.bar = bar; b.x = xb_xcc_id(); b.st = st;
    if (leader) (void)xb_add(&bar[XB_XCNT(b.x)], 1u);
    return b;
}
DI void xcd_barrier_complete(unsigned* bar, unsigned x, unsigned& nloc, unsigned& nx) {
    const unsigned G = gridDim.x * gridDim.y * gridDim.z;
    unsigned sum, cnt, mine, sp = 0u;
    for (;;) {
        sum = 0u; cnt = 0u; mine = 0u;
#pragma unroll
        for (unsigned j = 0; j < 16; ++j) { const unsigned c = xb_ld(&bar[XB_XCNT(j)]); sum += c; cnt += (c > 0u) ? 1u : 0u; mine = (j == x) ? c : mine; }
        if (sum == G) break;
        __builtin_amdgcn_s_sleep(1);
        if ((++sp & 255u) == 0u) { if (xb_ld(&bar[XB_TMO])) break; if (sp > XB_SPIN_CAP) { atomicAdd(&bar[XB_TMO], 1u); break; } }
    }
    nloc = mine > 0u ? mine : 1u; nx = cnt > 0u ? cnt : 1u;
}
DI void xcd_barrier(const XcdBarrier& b, bool leader) {
    asm volatile("s_waitcnt vmcnt(0)" ::: "memory");
    __syncthreads();
    if (leader) {
        unsigned* bar = b.bar;
        __builtin_amdgcn_s_waitcnt(0);
        unsigned nloc = b.st[0], nx = b.st[1];
        if (nloc == 0u) { xcd_barrier_complete(bar, b.x, nloc, nx); b.st[0] = nloc; b.st[1] = nx; }
        const unsigned old = xb_add(&bar[XB_XSUB(b.x)], 1u);
        const unsigned gen = old / nloc;
        if (old + 1u == (gen + 1u) * nloc) {
            __builtin_amdgcn_fence(__ATOMIC_RELEASE, "agent");
            asm volatile("s_waitcnt vmcnt(0)" ::: "memory");
            const unsigned og = xb_add(&bar[XB_TOP], 1u);
            const unsigned tg = og / nx;
            if (og + 1u == (tg + 1u) * nx) xb_add(&bar[XB_TOPGEN], 1u);
            else XB_SPIN(xb_ld(&bar[XB_TOPGEN]) == tg, bar);
            __builtin_amdgcn_fence(__ATOMIC_ACQUIRE, "agent");
            xb_add(&bar[XB_XGEN(b.x)], 1u);
            asm volatile("s_waitcnt vmcnt(0)" ::: "memory");
        } else {
            XB_SPIN(xb_ld(&bar[XB_XGEN(b.x)]) == gen, bar);
            __builtin_amdgcn_fence(__ATOMIC_ACQUIRE, "agent");
            asm volatile("s_waitcnt vmcnt(0)" ::: "memory");
        }
    }
    __syncthreads();
}

namespace pg8 {
constexpr int BM = 256, BK = 64, HALF = 128, HTB = HALF * BK * 2, STAGE_BYTES = 8 * HTB, NXCD = 8, WGM = 8;
DI int lds_byte(int r, int c) { const int st = (r >> 4) * 2 + (c >> 5), rr = r & 15, cc = c & 31, ob = rr * 64 + cc * 2; return st * 1024 + (ob ^ (((ob >> 9) & 1) << 5)); }
DI void stage_rc(int b, int& R, int& C) { const int st = b / 1024, sb = b % 1024, swz = sb ^ (((sb >> 9) & 1) << 5); R = (st >> 1) * 16 + swz / 64; C = (st & 1) * 32 + (swz % 64) / 2; }
DI int perm32(int rho) { const int n = rho >> 4, i = rho & 15; return 8 * (i >> 2) + 4 * n + (i & 3); }
DI void glds16_s(const char* sbase, unsigned voff, unsigned lds_dst) { unsigned keep;
    asm volatile("s_mov_b32 %0, m0\n\ts_mov_b32 m0, %3\n\ts_nop 0\n\tglobal_load_lds_dwordx4 %1, %2\n\ts_mov_b32 m0, %0" : "=&s"(keep) : "v"(voff), "s"(sbase), "s"(lds_dst) : "memory"); }
struct Unit { int pm, pn; };
struct StaticOrder {
    int nM, nN, nwg, G, c;
    DI void init(int M, int N, int G_, int c_) { nM = M / BM; nN = N / BM; nwg = nM * nN; G = G_; c = c_; }
    DI bool next(int i, Unit& u) const {
        const long L = (long)i * G + c; if (L >= nwg) return false;
        int wgid = (int)L; { const int q = nwg / NXCD, r = nwg % NXCD, xcd = wgid % NXCD, off = wgid / NXCD; wgid = (xcd < r ? xcd * (q + 1) : r * (q + 1) + (xcd - r) * q) + off; }
        const int nig = WGM * nN, gid = wgid / nig, fm = gid * WGM, gsz = (nM - fm) < WGM ? (nM - fm) : WGM;
        u.pm = fm + ((wgid % nig) % gsz); u.pn = (wgid % nig) / gsz; return true;
    }
};
template <class P>
DI void gemm_phase(LAS unsigned char* lds, const P& S, const int wave0) {
    const int tid = wave0 * 64 + lane_id_asm();
    const int wid = __builtin_amdgcn_readfirstlane(tid >> 6), lane = tid & 63, wr = wid >> 2, wc = wid & 3, fr = lane & 15, fq = lane >> 4;
    const int K = S.K, nt = K / BK;
    int Rr[2], Cc[2];
    unsigned voffB[2], vcur[2][2];
    const size_t hstep = (size_t)HALF * K * 2;
#pragma unroll
    for (int i = 0; i < 2; ++i) { stage_rc(tid * 16 + i * 8192, Rr[i], Cc[i]); const int Rb = P::PERM ? ((Rr[i] & ~31) + perm32(Rr[i] & 31)) : Rr[i];
        voffB[i] = (unsigned)(Rb * K + Cc[i]) * 2u; }
    const size_t kstep = (size_t)(BK * 2);
    const unsigned ldsw = (unsigned)wid * 1024u;
    const unsigned ldsbase = (unsigned)(size_t)lds;
    const int aoff = lds_byte(wr * 64 + fr, fq * 8); int boff = lds_byte(wc * 32 + fr, fq * 8) + 4 * HTB;
    asm volatile("" : "+v"(boff));
#define PG8_SA(b, h) (((b) * 2 + (h)) * HTB)
#define PG8_SB(b, h) ((4 + (b) * 2 + (h)) * HTB)
#define PG8_SBR(b, h) (((b) * 2 + (h)) * HTB)
#define PG8_STAGE(bufoff, gbase, voff) do { _Pragma("unroll") for (int _i = 0; _i < 2; ++_i) \
        glds16_s((const char*)(gbase), (voff)[_i], ldsbase + (unsigned)((bufoff) + _i * 8192) + ldsw); } while (0)
#define PG8_LDA(dst, b, h) do { _Pragma("unroll") for (int m = 0; m < 4; ++m) _Pragma("unroll") for (int k = 0; k < 2; ++k) dst[m][k] = *(const LAS bf16x8*)(lds + PG8_SA(b, h) + aoff + m * 2048 + k * 1024); } while (0)
#define PG8_LDB(dst, b, h) do { _Pragma("unroll") for (int n = 0; n < 2; ++n) _Pragma("unroll") for (int k = 0; k < 2; ++k) dst[n][k] = *(const LAS bf16x8*)(lds + boff + (PG8_SBR(b, h) + n * 2048 + k * 1024)); } while (0)
#define PG8_CAT(x) __builtin_bit_cast(v8i32, __builtin_shufflevector((x)[0], (x)[1], 0, 1, 2, 3, 4, 5, 6, 7, 8, 9, 10, 11, 12, 13, 14, 15))
#define PG8_MMA(ai, bj, At, Bt) do { __builtin_amdgcn_s_setprio(1); _Pragma("unroll") for (int m = 0; m < 4; ++m) _Pragma("unroll") for (int n = 0; n < 2; ++n) { \
        if constexpr (P::FP8) acc[ai][bj][m][n] = __builtin_amdgcn_mfma_scale_f32_16x16x128_f8f6f4(PG8_CAT(Bt[n]), PG8_CAT(At[m]), acc[ai][bj][m][n], 0, 0, 0, 0x7f7f7f7f, 0, 0x7f7f7f7f); \
        else { _Pragma("unroll") for (int k = 0; k < 2; ++k) acc[ai][bj][m][n] = __builtin_amdgcn_mfma_f32_16x16x32_bf16(Bt[n][k], At[m][k], acc[ai][bj][m][n], 0, 0, 0); } } \
        __builtin_amdgcn_s_setprio(0); } while (0)
#define PG8_A1(p) (P::GATHER ? (p) : (p) + hstep)
#define PG8_V1 vcur[P::GATHER ? 1 : 0]
#define PG8_WAIT_V(n) asm volatile("s_waitcnt vmcnt(" #n ")" ::: "memory")
#define PG8_WAIT_L(n) asm volatile("s_waitcnt lgkmcnt(" #n ")" ::: "memory")
#define PG8_BAR __builtin_amdgcn_s_barrier()
#define PG8_SCHED __builtin_amdgcn_sched_barrier(0)
    Unit cur, nxt; int ui = 0;
    if (!S.next(0, cur)) return;
#define PG8_AOFFS(dst, u) do { const int _t = wave0 * 64 + lane_id_asm(); _Pragma("unroll") for (int _i = 0; _i < 2; ++_i) { int _R, _C; stage_rc(_t * 16 + _i * 8192, _R, _C); \
        _Pragma("unroll") for (int _h = 0; _h < 2; ++_h) \
        dst[_h][_i] = P::GATHER ? (unsigned)(((size_t)S.gather_row(u, _h * HALF + _R) * K + _C) * 2u) : (unsigned)((size_t)(_R * K + _C) * 2u); } } while (0)
    PG8_AOFFS(vcur, cur);
    LAS u32x4* const gslot = (LAS u32x4*)(lds + (TABL_OFF + 6144)) + tid;
    f32x4 acc[2][2][4][2];
#pragma unroll
    for (int a = 0; a < 2; ++a)
#pragma unroll
        for (int b = 0; b < 2; ++b)
#pragma unroll
            for (int m = 0; m < 4; ++m)
#pragma unroll
                for (int n = 0; n < 2; ++n) acc[a][b][m][n] = (f32x4){0.f, 0.f, 0.f, 0.f};
    bf16x8 At[4][2], B0[2][2], B1[2][2];
    const char* cA = S.a_ptr(cur); const char* cB = S.b_ptr(cur);
    PG8_STAGE(PG8_SB(0, 0), cB, voffB); PG8_STAGE(PG8_SB(0, 1), cB + hstep, voffB); PG8_STAGE(PG8_SA(0, 0), cA, vcur[0]); PG8_STAGE(PG8_SA(0, 1), PG8_A1(cA), PG8_V1);
    if (wr == 1) PG8_BAR;
    PG8_WAIT_V(2); PG8_BAR;
    PG8_STAGE(PG8_SB(1, 0), cB + kstep, voffB); PG8_STAGE(PG8_SA(1, 0), cA + kstep, vcur[0]); PG8_STAGE(PG8_SB(1, 1), cB + hstep + kstep, voffB);
    PG8_WAIT_V(6); PG8_BAR;
    for (;;) {
        const bool has_next = S.next(ui + 1, nxt);
        const char* nA = has_next ? S.a_ptr(nxt) : cA; const char* nB = has_next ? S.b_ptr(nxt) : cB;
        if (P::GATHER) { if (has_next) { unsigned vn_[2][2]; PG8_AOFFS(vn_, nxt); *gslot = (u32x4){vn_[0][0], vn_[0][1], vn_[1][0], vn_[1][1]}; } }
        for (int t = 0; t < nt; t += 2) {
            const bool last = (t == nt - 2);
            const char* a1 = cA + (size_t)(t + 1) * kstep;
            const char* a2 = last ? nA : cA + (size_t)(t + 2) * kstep; const char* b2 = last ? nB : cB + (size_t)(t + 2) * kstep;
            const char* a3 = a2 + kstep; const char* b3 = b2 + kstep;
            PG8_LDB(B0, 0, 0); PG8_LDB(B1, 0, 1); PG8_SCHED; PG8_LDA(At, 0, 0); PG8_STAGE(PG8_SA(1, 1), PG8_A1(a1), PG8_V1);
            PG8_WAIT_V(8); PG8_WAIT_L(0); PG8_BAR; PG8_MMA(0, 0, At, B0); PG8_MMA(0, 1, At, B1); PG8_BAR; PG8_SCHED;
            if (P::GATHER) { if (last && has_next) { const u32x4 vn_ = *gslot; vcur[0][0] = vn_.x; vcur[0][1] = vn_.y; vcur[1][0] = vn_.z; vcur[1][1] = vn_.w; } }
            PG8_LDA(At, 0, 1); PG8_STAGE(PG8_SB(0, 0), b2, voffB); PG8_STAGE(PG8_SB(0, 1), b2 + hstep, voffB); PG8_STAGE(PG8_SA(0, 0), a2, vcur[0]);
            PG8_WAIT_V(8); PG8_WAIT_L(0); PG8_BAR; PG8_MMA(1, 0, At, B0); PG8_MMA(1, 1, At, B1); PG8_BAR; PG8_SCHED;
            PG8_LDB(B0, 1, 0); PG8_LDB(B1, 1, 1); PG8_SCHED; PG8_LDA(At, 1, 0); PG8_STAGE(PG8_SA(0, 1), PG8_A1(a2), PG8_V1);
            PG8_WAIT_V(8); PG8_WAIT_L(0); PG8_BAR; PG8_MMA(0, 0, At, B0); PG8_MMA(0, 1, At, B1); PG8_BAR; PG8_SCHED;
            PG8_LDA(At, 1, 1); PG8_STAGE(PG8_SB(1, 0), b3, voffB); PG8_STAGE(PG8_SB(1, 1), b3 + hstep, voffB); PG8_STAGE(PG8_SA(1, 0), a3, vcur[0]);
            PG8_WAIT_V(8); PG8_WAIT_L(0); PG8_BAR; PG8_MMA(1, 0, At, B0); PG8_MMA(1, 1, At, B1); PG8_BAR; PG8_SCHED;
        }
        if (wr == 0) PG8_BAR;
        PG8_SCHED;
        { const int l2 = lane_id_asm();
          S.epi(acc, cur, wave0 >> 2, wave0 & 3, l2 & 15, l2 >> 4); }
        if (!has_next) break;
#pragma unroll
        for (int a = 0; a < 2; ++a)
#pragma unroll
            for (int b = 0; b < 2; ++b)
#pragma unroll
                for (int m = 0; m < 4; ++m)
#pragma unroll
                    for (int n = 0; n < 2; ++n) acc[a][b][m][n] = (f32x4){0.f, 0.f, 0.f, 0.f};
        cur = nxt; cA = nA; cB = nB; ++ui;
        if (wr == 1) PG8_BAR;
    }
    PG8_WAIT_V(0);
    PG8_BAR;
#undef PG8_AOFFS
#undef PG8_SA
#undef PG8_SB
#undef PG8_SBR
#undef PG8_STAGE
#undef PG8_LDA
#undef PG8_LDB
#undef PG8_MMA
#undef PG8_CAT
#undef PG8_WAIT_V
#undef PG8_A1
#undef PG8_V1
#undef PG8_WAIT_L
#undef PG8_BAR
#undef PG8_SCHED
}
}
using pg8::Unit;
typedef f32x4 AccT[2][2][4][2];

struct Args {
    const float* x; const float* p; const float* w_in; const float* lb_logits; const float* hg_norm_w; const float* w_a; const float* w_h; const float* w_o;
    const float* ln1_w; const float* ln1_b; const float* router_w; const float* router_b; const float* ew_gate; const float* ew_up; const float* ew_down;
    const float* sw_gate; const float* sw_up; const float* sw_down; const float* w_pg; const float* w_pp; const float* ln2_w; const float* ln2_b;
    float* out; unsigned char* ws;
};
struct Frame { LAS unsigned char* lds; int tid, lane, wave, G, bid; };

#define LAMBDA_INL __attribute__((always_inline))
struct TrItem { const float* W; unsigned char* WT; int ldw, ldt, k0, n0, drow0, f8; };
DI void tr_load(const TrItem& d, int lane, float (&v)[32]) {
#pragma unroll
    for (int i = 0; i < 32; ++i) v[i] = __builtin_nontemporal_load(d.W + (size_t)(d.k0 + 2 * i + (lane >> 5)) * d.ldw + d.n0 + (lane & 31));
}
DI void tr_store(const TrItem& d, const float (&v)[32], LAS float* scr, int lane) {
#pragma unroll
    for (int i = 0; i < 32; ++i) scr[(2 * i + (lane >> 5)) * 33 + (lane & 31)] = v[i];
    asm volatile("s_waitcnt lgkmcnt(0)" ::: "memory");
    const int c = lane & 7;
#pragma unroll
    for (int j = 0; j < 4; ++j) { const int n = (lane >> 3) + 8 * j; const LAS float* s = scr + (8 * c) * 33 + n;
        if (d.f8) { u32x2 o; o.x = pk4_fp8(s[0 * 33] * W8S, s[1 * 33] * W8S, s[2 * 33] * W8S, s[3 * 33] * W8S); o.y = pk4_fp8(s[4 * 33] * W8S, s[5 * 33] * W8S, s[6 * 33] * W8S, s[7 * 33] * W8S);
            *(u32x2*)(d.WT + (size_t)(d.drow0 + n) * d.ldt + d.k0 + 8 * c) = o; }
        else { u32x4 o; o.x = pk2(s[0 * 33], s[1 * 33]); o.y = pk2(s[2 * 33], s[3 * 33]); o.z = pk2(s[4 * 33], s[5 * 33]); o.w = pk2(s[6 * 33], s[7 * 33]);
            *(u32x4*)((bf16*)d.WT + (size_t)(d.drow0 + n) * d.ldt + d.k0 + 8 * c) = o; } }
    asm volatile("s_waitcnt lgkmcnt(0)" ::: "memory");
}
DI TrItem tr_plain_item(const float* W, int N, void* WT, int ldt, int f8, int r) { const int nblk = N / 32, kb = r / nblk, nb = r % nblk; return TrItem{W, (unsigned char*)WT, N, ldt, 64 * kb, 32 * nb, 32 * nb, f8}; }
DI TrItem tr_gu_item(const float* Wg, const float* Wu, void* WT, int f8, int r) { const int which = r >> 7, rr = r & 127, kb = rr >> 3, nb = rr & 7, n0 = 32 * nb;
    return TrItem{which ? Wu : Wg, (unsigned char*)WT, 256, 1024, 64 * kb, n0, (n0 >> 7) * 256 + which * 128 + (n0 & 127), f8}; }
constexpr int I_WIN = 16 * (NIN / 32), I_WA = 8 * 32, I_WH = 16 * 32, I_WPP = 4 * 32, I_SGU = 256, I_SD = 4 * 32, I_WR = 16 * 2, I_EGU = 64 * 256;
constexpr int P0_NITEMS = I_WIN + I_WA + 3 * I_WH + I_WPP + I_SGU + I_SD + I_WR + I_EGU;
DI TrItem p0_item(const Args& a, int it) {
    unsigned char* ws = a.ws; int r = it;
    if (r < I_WIN) return tr_plain_item(a.w_in, NIN, ws + WS_WIN8, 1024, 1, r); r -= I_WIN;
    if (r < I_WA) return tr_plain_item(a.w_a, 1024, ws + WS_WA, 512, 1, r); r -= I_WA;
    if (r < I_WH) return tr_plain_item(a.w_h, 1024, ws + WS_WH, 1024, 1, r); r -= I_WH;
    if (r < I_WH) return tr_plain_item(a.w_o, 1024, ws + WS_WO, 1024, 1, r); r -= I_WH;
    if (r < I_WH) return tr_plain_item(a.w_pg, 1024, ws + WS_WPG, 1024, 1, r); r -= I_WH;
    if (r < I_WPP) return tr_plain_item(a.w_pp, 1024, ws + WS_WPP, 256, 0, r); r -= I_WPP;
    if (r < I_SGU) return tr_gu_item(a.sw_gate, a.sw_up, ws + WS_WSGU, 0, r); r -= I_SGU;
    if (r < I_SD) return tr_plain_item(a.sw_down, 1024, ws + WS_WSD, 256, 0, r); r -= I_SD;
    if (r < I_WR) return tr_plain_item(a.router_w, 64, ws + WS_WRT, 1024, 0, r); r -= I_WR;
    const int e = r >> 8; return tr_gu_item(a.ew_gate + (size_t)e * 1024 * 256, a.ew_up + (size_t)e * 1024 * 256, ws + WS_WEGU8 + (size_t)e * 512 * 1024, 1, r & 255);
}
DI TrItem p8_item(const Args& a, unsigned char* wed, int it) { const int e = it >> 7; return tr_plain_item(a.ew_down + (size_t)e * 256 * 1024, 1024, wed + (size_t)e * 1024 * 256, 256, 1, it & 127); }
template <class ItemFn>
DI void tr_run(const Frame& F, int nitems, ItemFn item) {
    LAS float* scr = (LAS float*)(F.lds + F.wave * 16384);
    const int gw = F.bid * 8 + F.wave, NGW = F.G * 8;
    float va[32], vb[32]; TrItem da, db; int it = gw;
    if (it < nitems) { da = item(it); tr_load(da, F.lane, va); }
    for (; it < nitems; it += 2 * NGW) {
        const int it2 = it + NGW, it3 = it2 + NGW;
        if (it2 < nitems) { db = item(it2); tr_load(db, F.lane, vb); }
        tr_store(da, va, scr, F.lane);
        if (it3 < nitems) { da = item(it3); tr_load(da, F.lane, va); }
        if (it2 < nitems) tr_store(db, vb, scr, F.lane);
    }
}
DI void p0_prologue(const Frame& F, const Args& a) {
    tr_run(F, P0_NITEMS, [&](int it) LAMBDA_INL { return p0_item(a, it); });
    unsigned char* ws = a.ws; const int gw = F.bid * 8 + F.wave, NGW = F.G * 8;
    for (int m0 = gw * 4; m0 < T; m0 += NGW * 4) {
        f32x4 v[4][4];
#pragma unroll
        for (int q = 0; q < 4; ++q)
#pragma unroll
            for (int j = 0; j < 4; ++j) v[q][j] = __builtin_nontemporal_load((const f32x4*)(a.x + (size_t)(m0 + q) * D) + F.lane + 64 * j);
#pragma unroll
        for (int q = 0; q < 4; ++q) { unsigned* o4 = (unsigned*)(ws + WS_X8 + (size_t)(m0 + q) * D) + F.lane;
#pragma unroll
            for (int j = 0; j < 4; ++j) { const f32x4 w4 = v[q][j]; o4[64 * j] = pk4_fp8(w4.x, w4.y, w4.z, w4.w); } }
    }
}

struct DenseBase {
    static constexpr bool GATHER = false, FP8 = false;
    pg8::StaticOrder S; const char* A; const char* Bt; int K;
    DI void init(const void* A_, const void* Bt_, int M, int N, int K_, int G, int c) { A = (const char*)A_; Bt = (const char*)Bt_; K = K_; S.init(M, N, G, c); }
    DI bool next(int i, Unit& u) const { return S.next(i, u); }
    DI const char* a_ptr(const Unit& u) const { return A + (size_t)u.pm * 256 * K * 2; }
    DI const char* b_ptr(const Unit& u) const { return Bt + (size_t)u.pn * 256 * K * 2; }
    DI int gather_row(const Unit&, int) const { return 0; }
};
DI u32x4 pack_bf8(const f32x4& v0, const f32x4& v1) { u32x4 w; w.x = pk2(v0[0], v0[1]); w.y = pk2(v0[2], v0[3]); w.z = pk2(v1[0], v1[1]); w.w = pk2(v1[2], v1[3]); return w; }
DI void unpack_bf8(const u32x4& w, f32x4& v0, f32x4& v1) {
    v0 = (f32x4){bf2f(w.x & 0xffffu), bf2f(w.x >> 16), bf2f(w.y & 0xffffu), bf2f(w.y >> 16)};
    v1 = (f32x4){bf2f(w.z & 0xffffu), bf2f(w.z >> 16), bf2f(w.w & 0xffffu), bf2f(w.w >> 16)};
}
template <class Fn> DI void epi_walk(const AccT& acc, const Unit& u, int wr, int wc, int fr, int fq, Fn fn) {
#pragma unroll
    for (int ai = 0; ai < 2; ++ai)
#pragma unroll
        for (int m = 0; m < 4; ++m) { const int row = u.pm * 256 + ai * 128 + wr * 64 + m * 16 + fr;
#pragma unroll
            for (int bj = 0; bj < 2; ++bj) { const int col = u.pn * 256 + bj * 128 + wc * 32 + 8 * fq; fn(row, col, bj, acc[ai][bj][m][0], acc[ai][bj][m][1]); } }
}

template <class Op, class Ld, class Fn> DI void epi_walk_ld(const AccT& acc, const Unit& u, int wr, int wc, int fr, int fq, Ld ld, Fn fn) {
#pragma unroll
    for (int ai = 0; ai < 2; ++ai) {
        Op ops[4][2];
#pragma unroll
        for (int m = 0; m < 4; ++m)
#pragma unroll
            for (int bj = 0; bj < 2; ++bj) ops[m][bj] = ld(u.pm * 256 + ai * 128 + wr * 64 + m * 16 + fr, u.pn * 256 + bj * 128 + wc * 32 + 8 * fq);
#pragma unroll
        for (int m = 0; m < 4; ++m)
#pragma unroll
            for (int bj = 0; bj < 2; ++bj) fn(u.pm * 256 + ai * 128 + wr * 64 + m * 16 + fr, u.pn * 256 + bj * 128 + wc * 32 + 8 * fq, acc[ai][bj][m][0], acc[ai][bj][m][1], ops[m][bj]);
    }
}
constexpr int XR_RING = 3 * 16384, XR_TAIL = TABL_OFF + 6144;
constexpr int XL_UNITS = 10, XL_TOK = TABL_OFF + 6144 + 8192, XL_GATE = XL_TOK + XL_UNITS * 512;
static_assert(XL_GATE + XL_UNITS * 1024 <= LDS_BYTES && (MAXTILES + 127) / 128 <= XL_UNITS, "MoE list images");
template <class Fn> DI void epi_walk_rows(const AccT& acc, const Unit& u, int wr, int wc, int fr, int fq, LAS unsigned char* lds, bf16* O, int ldo, Fn fn) {
    const int tid = (wr * 4 + wc) * 64 + fq * 16 + fr, wrow = wr * 16 + fr, rl = tid >> 5;
    const int woff = wrow * 512 + (((wc * 4 + fq) ^ (wrow & 7)) << 4);
    const int roff = rl * 512 + ((tid & 31) << 4);
    bf16* gp = O + (size_t)(u.pm * 256 + rl) * ldo + u.pn * 256 + (((tid & 31) ^ (rl & 7)) << 3);
#pragma unroll
    for (int ai = 0; ai < 2; ++ai)
#pragma unroll
        for (int m = 0; m < 4; ++m) { LAS unsigned char* xb = lds + ((m & 1) ? XR_TAIL : XR_RING);
#pragma unroll
            for (int bj = 0; bj < 2; ++bj) *(LAS u32x4*)(xb + woff + bj * 256) = fn(u.pm * 256 + ai * 128 + wr * 64 + m * 16 + fr, u.pn * 256 + bj * 128 + wc * 32 + 8 * fq, bj, acc[ai][bj][m][0], acc[ai][bj][m][1]);
            asm volatile("s_waitcnt lgkmcnt(0)" ::: "memory"); __builtin_amdgcn_s_barrier(); asm volatile("" ::: "memory");
#pragma unroll
            for (int j = 0; j < 2; ++j) { const u32x4 v = *(const LAS u32x4*)(xb + roff + j * 8192); *(u32x4*)(gp + (size_t)(ai * 128 + m * 16 + j * 64) * ldo) = v; } }
}
struct ProbQKV : DenseBase { static constexpr bool PERM = true, FP8 = true; bf16* O; LAS unsigned char* xl;
    DI void epi(const AccT& acc, const Unit& u, int wr, int wc, int fr, int fq) const {
        const float sc = (u.pn < 6 ? QSCALE : 1.0f) * W8I; bf16* o = O;
        epi_walk_rows(acc, u, wr, wc, fr, fq, xl, o, NATT, [=](int, int, int, f32x4 v0, f32x4 v1) LAMBDA_INL { return pack_bf8(v0 * sc, v1 * sc); });
    } };
struct ProbHG : DenseBase { static constexpr bool PERM = true, FP8 = true; bf16* R2; bf16* gates; const float* lbl;
    DI void epi(const AccT& acc, const Unit& u, int wr, int wc, int fr, int fq) const {
        const int seg = u.pn >> 2; bf16* r2 = R2; bf16* gt = gates;
        if (seg == 0) { epi_walk(acc, u, wr, wc, fr, fq, [=](int row, int col, int, f32x4 v0, f32x4 v1) LAMBDA_INL { *((u32x4*)(r2 + (size_t)row * NHG + col)) = pack_bf8(v0 * W8I, v1 * W8I); }); }
        else if (seg == 1) {
            const float* lbp = lbl + (u.pn - 4) * 256 + wc * 32 + 8 * fq;
            float la[2][8];
#pragma unroll
            for (int bj = 0; bj < 2; ++bj) { const f32x4 a0 = *(const f32x4*)(lbp + bj * 128), a1 = *(const f32x4*)(lbp + bj * 128 + 4), b0 = *(const f32x4*)(lbp + 1024 + bj * 128), b1 = *(const f32x4*)(lbp + 1024 + bj * 128 + 4);
#pragma unroll
                for (int j = 0; j < 4; ++j) { la[bj][j] = __builtin_amdgcn_rcpf(1.0f + __expf(b0[j] - a0[j])); la[bj][4 + j] = __builtin_amdgcn_rcpf(1.0f + __expf(b1[j] - a1[j])); } }
            epi_walk(acc, u, wr, wc, fr, fq, [&](int row, int col, int bj, f32x4 v0, f32x4 v1) LAMBDA_INL {
#pragma unroll
                for (int j = 0; j < 4; ++j) { const float l0 = bj ? la[1][j] : la[0][j], l1 = bj ? la[1][4 + j] : la[0][4 + j];
                    v0[j] = __logf(l0 + (1.0f - l0) * sigmoidf_(v0[j] * W8I)); v1[j] = __logf(l1 + (1.0f - l1) * sigmoidf_(v1[j] * W8I)); }
                *((u32x4*)(r2 + (size_t)row * NHG + col)) = pack_bf8(v0, v1); });
        } else if (seg < 4) {
            epi_walk(acc, u, wr, wc, fr, fq, [=](int row, int col, int, f32x4 v0, f32x4 v1) LAMBDA_INL {
#pragma unroll
                for (int j = 0; j < 4; ++j) { v0[j] = siluf_(v0[j] * W8I); v1[j] = siluf_(v1[j] * W8I); }
                *((u32x4*)(r2 + (size_t)row * NHG + col)) = pack_bf8(v0, v1); });
        } else {
            epi_walk(acc, u, wr, wc, fr, fq, [=](int row, int col, int, f32x4 v0, f32x4 v1) LAMBDA_INL {
#pragma unroll
                for (int j = 0; j < 4; ++j) { v0[j] = sigmoidf_(v0[j] * W8I); v1[j] = sigmoidf_(v1[j] * W8I); }
                *((u32x4*)(gt + (size_t)row * NGATE + (col - 4096))) = pack_bf8(v0, v1); });
        }
    } };
struct ProbBrA : DenseBase { static constexpr bool PERM = true, FP8 = true; const bf16* gates; bf16* O;
    DI void epi(const AccT& acc, const Unit& u, int wr, int wc, int fr, int fq) const {
        const bf16* gt = gates; bf16* o = O;
        epi_walk_ld<u32x4>(acc, u, wr, wc, fr, fq, [=](int row, int col) LAMBDA_INL { return *(const u32x4*)(gt + (size_t)row * NGATE + col); },
            [=](int row, int col, f32x4 v0, f32x4 v1, u32x4 gw) LAMBDA_INL { f32x4 g0, g1; unpack_bf8(gw, g0, g1); *(u32x4*)(o + (size_t)row * D + col) = pack_bf8(v0 * g0 * W8I, v1 * g1 * W8I); });
    } };
constexpr float MGS = 8.0f;
struct ProbBrH : DenseBase { static constexpr bool PERM = true, FP8 = true; const bf16* gates; const bf16* M1; unsigned char* O;
    DI void epi(const AccT& acc, const Unit& u, int wr, int wc, int fr, int fq) const {
        const bf16* gt = gates; const bf16* m1 = M1; unsigned char* o = O;
        struct Op2 { u32x4 g, p; };
        epi_walk_ld<Op2>(acc, u, wr, wc, fr, fq, [=](int row, int col) LAMBDA_INL { return Op2{*(const u32x4*)(gt + (size_t)row * NGATE + 1024 + col), *(const u32x4*)(m1 + (size_t)row * D + col)}; },
            [=](int row, int col, f32x4 v0, f32x4 v1, Op2 w) LAMBDA_INL {
                f32x4 g0, g1, p0, p1; unpack_bf8(w.g, g0, g1); unpack_bf8(w.p, p0, p1);
                v0 = (v0 * g0 * W8I + p0) * MGS; v1 = (v1 * g1 * W8I + p1) * MGS;
                *(u32x2*)(o + (size_t)row * D + col) = (u32x2){pk4_fp8(v0[0], v0[1], v0[2], v0[3]), pk4_fp8(v1[0], v1[1], v1[2], v1[3])}; });
    } };
struct ProbWo : DenseBase { static constexpr bool PERM = true, FP8 = true; const float* x; bf16* O;
    DI void epi(const AccT& acc, const Unit& u, int wr, int wc, int fr, int fq) const {
        const float* xp = x; bf16* o = O;
        struct OpX { f32x4 a, b; };
        epi_walk_ld<OpX>(acc, u, wr, wc, fr, fq, [=](int row, int col) LAMBDA_INL { return OpX{*(const f32x4*)(xp + (size_t)row * D + col), *(const f32x4*)(xp + (size_t)row * D + col + 4)}; },
            [=](int row, int col, f32x4 v0, f32x4 v1, OpX w) LAMBDA_INL { *(u32x4*)(o + (size_t)row * D + col) = pack_bf8(w.a * ALPHA + v0 * (W8I / MGS), w.b * ALPHA + v1 * (W8I / MGS)); });
    } };
struct ProbPP : DenseBase { static constexpr bool PERM = true; bf16* O;
    DI void epi(const AccT& acc, const Unit& u, int wr, int wc, int fr, int fq) const { bf16* o = O;
        epi_walk(acc, u, wr, wc, fr, fq, [=](int row, int col, int, f32x4 v0, f32x4 v1) LAMBDA_INL { *(u32x4*)(o + (size_t)row * D + col) = pack_bf8(v0, v1); }); } };
struct ProbPG : DenseBase { static constexpr bool PERM = true, FP8 = true; bf16* O;
    DI void epi(const AccT& acc, const Unit& u, int wr, int wc, int fr, int fq) const { bf16* o = O;
        epi_walk_ld<u32x4>(acc, u, wr, wc, fr, fq, [=](int row, int col) LAMBDA_INL { return *(const u32x4*)(o + (size_t)row * D + col); },
            [=](int row, int col, f32x4 v0, f32x4 v1, u32x4 pw) LAMBDA_INL { f32x4 p0, p1; unpack_bf8(pw, p0, p1);
#pragma unroll
                for (int j = 0; j < 4; ++j) { v0[j] = sigmoidf_(v0[j] * W8I) * p0[j]; v1[j] = sigmoidf_(v1[j] * W8I) * p1[j]; }
                *(u32x4*)(o + (size_t)row * D + col) = pack_bf8(v0, v1); });
    } };
template <bool SCALED>
DI void epi_swiglu(const AccT& acc, bf16* O, int ldo, int row0, int hcol0, int wr, int wc, int fr, int fq) {
    const float cs = SCALED ? W8I : 1.0f;
#pragma unroll
    for (int ai = 0; ai < 2; ++ai)
#pragma unroll
        for (int m = 0; m < 4; ++m) { const int row = row0 + ai * 128 + wr * 64 + m * 16 + fr; f32x4 h0, h1;
#pragma unroll
            for (int j = 0; j < 4; ++j) { h0[j] = siluf_(acc[ai][0][m][0][j] * cs) * (acc[ai][1][m][0][j] * cs); h1[j] = siluf_(acc[ai][0][m][1][j] * cs) * (acc[ai][1][m][1][j] * cs); }
            *(u32x4*)(O + (size_t)row * ldo + hcol0 + wc * 32 + 8 * fq) = pack_bf8(h0, h1); }
}
DI void epi_swiglu_moe(const AccT& acc, unsigned char* O, const LAS float* gate, int row0, int hcol0, int wr, int wc, int fr, int fq) {
#pragma unroll
    for (int ai = 0; ai < 2; ++ai)
#pragma unroll
        for (int m = 0; m < 4; ++m) { const int lr = ai * 128 + wr * 64 + m * 16 + fr, row = row0 + lr; const float gs = gate[lr] * (HGS * W8I); f32x4 h0, h1;
#pragma unroll
            for (int j = 0; j < 4; ++j) { h0[j] = siluf_(acc[ai][0][m][0][j] * W8I) * (acc[ai][1][m][0][j] * gs); h1[j] = siluf_(acc[ai][0][m][1][j] * W8I) * (acc[ai][1][m][1][j] * gs); }
            *(u32x2*)(O + (size_t)row * 256 + hcol0 + wc * 32 + 8 * fq) = (u32x2){pk4_fp8(h0[0], h0[1], h0[2], h0[3]), pk4_fp8(h1[0], h1[1], h1[2], h1[3])}; }
}
struct ProbSGU : DenseBase { static constexpr bool PERM = true; bf16* O;
    DI void epi(const AccT& acc, const Unit& u, int wr, int wc, int fr, int fq) const { epi_swiglu<false>(acc, O, 256, u.pm * 256, u.pn * 128, wr, wc, fr, fq); } };
struct ProbSD : DenseBase { static constexpr bool PERM = true; bf16* O; int rank, nlight;
    DI bool next(int i, Unit& u) const { if (rank < 0) return false; const int L = rank + i * nlight; if (L >= 512) return false; u.pm = L >> 2; u.pn = L & 3; return true; }
    DI void epi(const AccT& acc, const Unit& u, int wr, int wc, int fr, int fq) const {
        bf16* o = O;
        epi_walk_ld<u32x4>(acc, u, wr, wc, fr, fq, [=](int row, int col) LAMBDA_INL { return *(const u32x4*)(o + (size_t)row * D + col); },
            [=](int row, int col, f32x4 v0, f32x4 v1, u32x4 pw) LAMBDA_INL { f32x4 p0, p1; unpack_bf8(pw, p0, p1); *(u32x4*)(o + (size_t)row * D + col) = pack_bf8(v0 + p0, v1 + p1); });
    } };
struct ProbMoeUp { static constexpr bool PERM = true, GATHER = true, FP8 = true;
    const char* A; const char* Bt; int K; int ntiles, G, c; const LAS int* texp; const LAS unsigned short* ltok; const LAS float* lgate; unsigned char* H;
    DI bool next(int i, Unit& u) const { const int x = c & 7, sl = c >> 3; u.pm = i * 128 + (sl >> 1) * 8 + x; u.pn = sl & 1; return u.pm < ntiles; }
    DI const char* a_ptr(const Unit&) const { return A; }
    DI const char* b_ptr(const Unit& u) const { return Bt + ((size_t)__builtin_amdgcn_readfirstlane(texp[u.pm]) * 512 + (size_t)u.pn * 256) * 1024; }
    DI int gather_row(const Unit& u, int r) const { return (int)ltok[(u.pm >> 7) * 256 + r]; }
    DI void epi(const AccT& acc, const Unit& u, int wr, int wc, int fr, int fq) const { epi_swiglu_moe(acc, H, lgate + (u.pm >> 7) * 256, u.pm * 256, u.pn * 128, wr, wc, fr, fq); } };
constexpr int XPITCH = 272, XBUF = 32 * XPITCH;
struct ProbMoeDown { static constexpr bool PERM = true, GATHER = false, FP8 = true;
    const char* A; const char* Bt; static constexpr int K = 128; int ntiles, G, c; const LAS int* texp; unsigned char* Y; unsigned char* Y2;
    DI bool next(int i, Unit& u) const { const int x = c & 7, sl = c >> 3; u.pm = i * 64 + (sl >> 2) * 8 + x; u.pn = sl & 3; return u.pm < ntiles; }
    DI const char* a_ptr(const Unit& u) const { return A + (size_t)u.pm * 256 * 256; }
    DI const char* b_ptr(const Unit& u) const { return Bt + ((size_t)__builtin_amdgcn_readfirstlane(texp[u.pm]) * 1024 + (size_t)u.pn * 256) * 256; }
    DI int gather_row(const Unit&, int) const { return 0; }
    LAS unsigned char* xb;
    DI void epi(const AccT& acc, const Unit& u, int wr, int wc, int fr, int fq) const {
        unsigned char* y = (u.pm * 256 < YE_SPLIT ? Y : Y2 - (size_t)YE_SPLIT * D) + (size_t)u.pm * 256 * D + u.pn * 256;
        const int tid = (wr * 4 + wc) * 64 + fq * 16 + fr, rl = tid >> 4;
        LAS unsigned char* wp = xb + (wr * 16 + fr) * XPITCH + wc * 32 + 8 * fq;
        const LAS unsigned char* rp = xb + rl * XPITCH + (tid & 15) * 16;
        unsigned char* gp = y + (size_t)(64 * (rl >> 4) + (rl & 15)) * D + (tid & 15) * 16;
#pragma unroll
        for (int ai = 0; ai < 2; ++ai)
#pragma unroll
            for (int m = 0; m < 4; ++m) { const int bo = (m & 1) * XBUF;
#pragma unroll
                for (int bj = 0; bj < 2; ++bj) { const f32x4 v0 = acc[ai][bj][m][0], v1 = acc[ai][bj][m][1];
                    *(LAS u32x2*)(wp + bo + bj * 128) = (u32x2){pk4_fp8(v0[0], v0[1], v0[2], v0[3]), pk4_fp8(v1[0], v1[1], v1[2], v1[3])}; }
                asm volatile("s_waitcnt lgkmcnt(0)" ::: "memory"); __builtin_amdgcn_s_barrier(); asm volatile("" ::: "memory");
                const u32x4 v = *(const LAS u32x4*)(rp + bo);
                *(u32x4*)(gp + (size_t)(128 * ai + 16 * m) * D) = v; }
    } };

constexpr int VPITCH = 144;
constexpr int ATT_K = 0, ATT_V = 384 * VPITCH, ATT_O = 2 * 384 * VPITCH, ATT_O2 = TABL_OFF + 6144;
struct AttnU { int b, hd, g, r, rho, n0; };
DI AttnU attn_decode(int ui) {
    AttnU u; const int w16 = ui & 15; u.g = (ui >> 4) % 3; const int bh = (ui >> 4) / 3; u.hd = bh & 7; u.b = bh >> 3;
    u.r = u.g == 0 ? 1 : (u.g == 1 ? 4 : 16);
    u.rho = u.g == 0 ? 0 : (u.g == 1 ? (w16 & 3) : w16); const int pair = u.g == 0 ? w16 : (u.g == 1 ? (w16 >> 2) : 0);
    u.n0 = 256 * pair; return u;
}
DI void attn_load_kv(const bf16* qkv, const AttnU& u, int tid, u32x4 (&kreg)[6], u32x4 (&vreg)[6]) {
    const size_t tokb = (size_t)u.b * SEQ; const int colq = u.g * 512 + u.hd * 64;
#pragma unroll
    for (int i = 0; i < 6; ++i) { const int c = tid + 512 * i, row = c >> 3, ch = c & 7; int nk = u.n0 - 128 + row; nk = nk < 0 ? 0 : nk;
        const bf16* p = qkv + (tokb + (size_t)nk * u.r + u.rho) * NATT + colq + ch * 8;
        kreg[i] = *(const u32x4*)(p + 1536); vreg[i] = *(const u32x4*)(p + 3072); }
}
DI void attn_load_q(const bf16* qkv, const AttnU& u, int w, int l31, int hh, bf16x8 (&Qf)[4]) {
    const size_t tq = (size_t)u.b * SEQ + (size_t)(u.n0 + 32 * w + l31) * u.r + u.rho; const int colq = u.g * 512 + u.hd * 64;
#pragma unroll
    for (int s = 0; s < 4; ++s) Qf[s] = *(const bf16x8*)(qkv + tq * NATT + colq + 16 * s + 8 * hh);
}
DI void attn_phase(const Frame& F, const bf16* qkv, bf16* opart, float* lse) {
    LAS unsigned char* Kl = F.lds + ATT_K; LAS unsigned char* Vl = F.lds + ATT_V;
    const int lane = F.lane, l31 = lane & 31, hh = lane >> 5, w = F.wave;
    const int q4 = (lane & 15) >> 2, p4 = lane & 3, blk = (lane >> 4) & 1;
    constexpr int NU = NB * 8 * 3 * 16;
    if (F.bid >= NU) return;
    u32x4 kreg[6], vreg[6]; bf16x8 Qn[4];
    { const AttnU u0 = attn_decode(F.bid); attn_load_kv(qkv, u0, F.tid, kreg, vreg); attn_load_q(qkv, u0, w, l31, hh, Qn); }
    for (int ui = F.bid; ui < NU; ui += F.G) {
        const AttnU u = attn_decode(ui);
        const int r = u.r, n0 = u.n0, hd = u.hd;
        __syncthreads();
#pragma unroll
        for (int i = 0; i < 6; ++i) { const int c = F.tid + 512 * i, row = c >> 3, ch = c & 7;
            *(LAS u32x4*)(Kl + row * VPITCH + ch * 16) = kreg[i]; *(LAS u32x4*)(Vl + row * VPITCH + ch * 16) = vreg[i]; }
        bf16x8 Qf[4];
#pragma unroll
        for (int s = 0; s < 4; ++s) Qf[s] = Qn[s];
        __syncthreads();
        { const int un = ui + F.G < NU ? ui + F.G : ui; const AttnU u2 = attn_decode(un); attn_load_kv(qkv, u2, F.tid, kreg, vreg); attn_load_q(qkv, u2, w, l31, hh, Qn); }
        __builtin_amdgcn_sched_barrier(0);
        const int qq = 32 * w + l31; const size_t tq = (size_t)u.b * SEQ + (size_t)(n0 + qq) * r + u.rho;
        f32x16 sc[5];
        bf16x8 kf[2][4];
        { const LAS unsigned char* kr = Kl + (32 * w + l31) * VPITCH + 16 * hh;
#pragma unroll
          for (int s = 0; s < 4; ++s) kf[0][s] = *(const LAS bf16x8*)(kr + 32 * s); }
#pragma unroll
        for (int J = 0; J < 5; ++J) {
            if (J < 4) { const LAS unsigned char* kr = Kl + (32 * (w + J + 1) + l31) * VPITCH + 16 * hh;
#pragma unroll
                for (int s = 0; s < 4; ++s) kf[(J + 1) & 1][s] = *(const LAS bf16x8*)(kr + 32 * s); }
            f32x16 a;
#pragma unroll
            for (int i = 0; i < 16; ++i) a[i] = 0.f;
#pragma unroll
            for (int s = 0; s < 4; ++s) a = MFMA32(kf[J & 1][s], Qf[s], a);
            sc[J] = a;
            __builtin_amdgcn_sched_barrier(0);
        }
        const float slope2 = exp2f(-(float)(hd + 1)) * (float)r * LOG2E;
        int l31v = l31; asm volatile("" : "+v"(l31v));
        const int cb = 4 * hh;
        float nb[5]; bool tok[5];
#pragma unroll
        for (int J = 0; J < 5; ++J) { tok[J] = (n0 > 0) || (w + J >= 4); nb[J] = -slope2 * (float)(l31v + 128 - 32 * J - cb); }
        float mx = -3.0e38f;
#pragma unroll
        for (int J = 0; J < 5; ++J) {
            if (tok[J]) {
#pragma unroll
                for (int i = 0; i < 16; ++i) {
                    const int ci = (i & 3) + 8 * (i >> 2);
                    const float s2 = fmaf(slope2, (float)ci, sc[J][i] + nb[J]);
                    if (J == 0) mx = (ci + cb >= l31v) ? fmaxf(mx, s2) : mx;
                    else if (J == 4) mx = (ci + cb <= l31v) ? fmaxf(mx, s2) : mx;
                    else mx = fmaxf(mx, s2);
                }
            }
        }
        mx = xmax32(mx);
        float den = 0.f;
#pragma unroll
        for (int J = 0; J < 5; ++J) {
            if (tok[J]) {
                const float c2 = nb[J] - mx;
#pragma unroll
                for (int i = 0; i < 16; ++i) {
                    const int ci = (i & 3) + 8 * (i >> 2);
                    float pv = exp2f(fmaf(slope2, (float)ci, sc[J][i] + c2));
                    if (J == 0) pv = (ci + cb >= l31v) ? pv : 0.f;
                    if (J == 4) pv = (ci + cb <= l31v) ? pv : 0.f;
                    sc[J][i] = pv; den += pv;
                }
            } else {
#pragma unroll
                for (int i = 0; i < 16; ++i) sc[J][i] = 0.f;
            }
        }
        den = xsum32(den);
        f32x16 o[2];
#pragma unroll
        for (int c = 0; c < 2; ++c)
#pragma unroll
            for (int i = 0; i < 16; ++i) o[c][i] = 0.f;
#pragma unroll
        for (int J = 0; J < 5; ++J) {
#pragma unroll
            for (int s = 0; s < 2; ++s) {
                const bf16x8 pf = pack8(sc[J], s);
#pragma unroll
                for (int c = 0; c < 2; ++c) {
                    const LAS unsigned char* vb = Vl + (32 * (w + J) + 16 * s + 4 * hh + q4) * VPITCH + (32 * c + 16 * blk + 4 * p4) * 2;
                    const bf16x8 vf = cat8(vtr(vb), vtr(vb + 8 * VPITCH));
                    o[c] = MFMA32(vf, pf, o[c]);
                }
            }
            __builtin_amdgcn_sched_barrier(0);
        }
        const float inv = 1.0f / den;
        LAS unsigned char* ob = F.lds + (w < 4 ? ATT_O + w * (32 * VPITCH) : ATT_O2 + (w - 4) * (32 * VPITCH));
#pragma unroll
        for (int c = 0; c < 2; ++c)
#pragma unroll
            for (int i4 = 0; i4 < 4; ++i4) {
                const int d0 = 32 * c + 8 * i4 + 4 * hh;
                *(LAS u32x2*)(ob + l31 * VPITCH + d0 * 2) = (u32x2){pk2(o[c][4 * i4] * inv, o[c][4 * i4 + 1] * inv), pk2(o[c][4 * i4 + 2] * inv, o[c][4 * i4 + 3] * inv)};
            }
        asm volatile("s_waitcnt lgkmcnt(0)" ::: "memory");
#pragma unroll
        for (int k = 0; k < 4; ++k) { const int q2 = (lane >> 3) + 8 * k;
            const u32x4 v = *(const LAS u32x4*)(ob + q2 * VPITCH + (lane & 7) * 16);
            const size_t tq2 = (size_t)u.b * SEQ + (size_t)(n0 + 32 * w + q2) * r + u.rho;
            *(u32x4*)(opart + ((size_t)u.g * T + tq2) * 512 + hd * 64 + (lane & 7) * 8) = v; }
        if (hh == 0) lse[((size_t)u.g * T + tq) * 8 + hd] = mx + log2f(den);
    }
}
DI void attn_mix_phase(const Frame& F, const bf16* opart, const float* lse, unsigned char* yatt) {
    const int gw = F.bid * 8 + F.wave, NGW = F.G * 8;
    for (int it = gw; it < T / 2; it += 2 * NGW) {
        const int c16 = F.lane & 31, hd = c16 >> 2;
        int tk[2]; float l[2][3]; u32x4 sv[2][3][2];
#pragma unroll
        for (int q = 0; q < 2; ++q) { tk[q] = 2 * (it + q * NGW) + (F.lane >> 5);
#pragma unroll
            for (int g = 0; g < 3; ++g) { l[q][g] = lse[((size_t)g * T + tk[q]) * 8 + hd]; const u32x4* src = (const u32x4*)(opart + ((size_t)g * T + tk[q]) * 512 + c16 * 16); sv[q][g][0] = src[0]; sv[q][g][1] = src[1]; } }
#pragma unroll
        for (int q = 0; q < 2; ++q) {
            const float m = fmaxf(fmaxf(l[q][0], l[q][1]), l[q][2]);
            float wsum = 0.f, wg[3];
#pragma unroll
            for (int g = 0; g < 3; ++g) { wg[g] = exp2f(l[q][g] - m); wsum += wg[g]; }
            const float inv = 1.0f / wsum;
            f32x4 a0 = {0, 0, 0, 0}, a1 = a0, a2 = a0, a3 = a0;
#pragma unroll
            for (int g = 0; g < 3; ++g) { f32x4 v0, v1, v2, v3; unpack_bf8(sv[q][g][0], v0, v1); unpack_bf8(sv[q][g][1], v2, v3);
                const float ww = wg[g] * inv; a0 += v0 * ww; a1 += v1 * ww; a2 += v2 * ww; a3 += v3 * ww; }
            *(u32x4*)(yatt + (size_t)tk[q] * 512 + c16 * 16) = (u32x4){pk4_fp8(a0[0], a0[1], a0[2], a0[3]), pk4_fp8(a1[0], a1[1], a1[2], a1[3]), pk4_fp8(a2[0], a2[1], a2[2], a2[3]), pk4_fp8(a3[0], a3[1], a3[2], a3[3])};
        }
    }
}

constexpr int HP = 272;
constexpr int HG_QD = 0, HG_KI = 32 * HP, HG_KE = 2 * 32 * HP, HG_VV = 3 * 32 * HP, HG_DD = 4 * 32 * HP, HG_SSQ = HG_DD + 512, HG_TOT = HG_SSQ + 512, HG_Y = HG_TOT + 2048, HGY_P = 136, HG_HALF = HG_Y + 32 * HGY_P;
struct HgRaw { unsigned lfp[8], qp[8]; u32x4 v0, v1; };
DI void hgrn_load(const bf16* R2, size_t tok0, int hd, int cp, int sg, int tidh, HgRaw& w) {
    const bf16* src = R2 + (tok0 + 8 * sg) * NHG + hd * 128 + 2 * cp;
#pragma unroll
    for (int tt = 0; tt < 8; ++tt) { w.lfp[tt] = *(const unsigned*)(src + (size_t)tt * NHG + 1024); w.qp[tt] = *(const unsigned*)(src + (size_t)tt * NHG); }
    const int row = tidh >> 3, ch = tidh & 7; const bf16* vs = R2 + (tok0 + row) * NHG + 2048 + hd * 128;
    w.v0 = *(const u32x4*)(vs + ch * 8); w.v1 = *(const u32x4*)(vs + (ch + 8) * 8);
}
template <bool OUT>
DI void hgrn_phase(const Frame& F, const bf16* R2, float* Lst, float* Dtot, const float* gain, unsigned char* yhg) {
    const int hf = F.wave >> 2, wv = F.wave & 3, tidh = F.tid & 255, lane = F.lane, l31 = lane & 31, hh = lane >> 5;
    const int q4 = (lane & 15) >> 2, p4 = lane & 3, blk = (lane >> 4) & 1;
    LAS unsigned char* base = F.lds + hf * HG_HALF;
    const int cp = tidh & 63, sg = tidh >> 6;
    for (int it0 = F.bid * 2; it0 < 512; it0 += F.G * 2) {
        const int item = it0 + hf, j = item & 7, bhd = item >> 3, hd = bhd & 7, b = bhd >> 3;
        const bool active = OUT || (j < 7);
        f32x16 S[4];
#pragma unroll
        for (int kb = 0; kb < 4; ++kb)
#pragma unroll
            for (int i = 0; i < 16; ++i) S[kb][i] = 0.f;
        if (OUT) {
            for (int i0 = 0; i0 < j; ++i0) {
                const float* Lp = Lst + (size_t)(bhd * 8 + i0) * 16384; const float* Dp = Dtot + (bhd * 8 + i0) * 128;
#pragma unroll
                for (int kb = 0; kb < 4; ++kb)
#pragma unroll
                    for (int i4 = 0; i4 < 4; ++i4) { const f32x4 dd = *(const f32x4*)(Dp + 32 * kb + 8 * i4 + 4 * hh);
#pragma unroll
                        for (int e = 0; e < 4; ++e) S[kb][4 * i4 + e] = S[kb][4 * i4 + e] * dd[e] + Lp[(32 * kb + 8 * i4 + 4 * hh + e) * 128 + 32 * wv + l31]; }
            }
        }
        float dsum0 = 0.f, dsum1 = 0.f;
        const size_t tokI = (size_t)b * SEQ + j * 512;
        HgRaw raw; hgrn_load(R2, tokI, hd, cp, sg, tidh, raw);
        for (int c = 0; c < 16; ++c) {
            const size_t tok0 = tokI + c * 32;
            float lf0[8], lf1[8], cs0[8], cs1[8];
            { float r0 = 0.f, r1 = 0.f;
#pragma unroll
              for (int tt = 0; tt < 8; ++tt) { lf0[tt] = bf2f(raw.lfp[tt] & 0xffffu); lf1[tt] = bf2f(raw.lfp[tt] >> 16); r0 += lf0[tt]; r1 += lf1[tt]; cs0[tt] = r0; cs1[tt] = r1; } }
            LAS float* tot = (LAS float*)(base + HG_TOT);
            *(LAS f32x2*)(tot + sg * 128 + 2 * cp) = (f32x2){cs0[7], cs1[7]};
            __syncthreads();
            if (OUT && c > 0) {
                const int row = tidh >> 3, ch = tidh & 7; const LAS unsigned char* yp = base + HG_Y + row * HGY_P + ch * 16;
                const u32x2 ya = *(const LAS u32x2*)yp, yb = *(const LAS u32x2*)(yp + 8);
                *(u32x4*)(yhg + (tok0 - 32 + row) * D + hd * 128 + ch * 16) = (u32x4){ya.x, ya.y, yb.x, yb.y}; }
            float off0 = 0.f, off1 = 0.f, bl0 = 0.f, bl1 = 0.f;
#pragma unroll
            for (int g2 = 0; g2 < 4; ++g2) { const f32x2 tv = *(const LAS f32x2*)(tot + g2 * 128 + 2 * cp); bl0 += tv.x; bl1 += tv.y; if (g2 < sg) { off0 += tv.x; off1 += tv.y; } }
#pragma unroll
            for (int tt = 0; tt < 8; ++tt) {
                const float bt0 = off0 + cs0[tt], bt1 = off1 + cs1[tt], e0 = __expf(bt0), e1 = __expf(bt1);
                const float key0 = 1.0f - __expf(lf0[tt]), key1 = 1.0f - __expf(lf1[tt]);
                const int t = 8 * sg + tt;
                *(LAS unsigned*)(base + HG_QD + t * HP + cp * 4) = pk2(bf2f(raw.qp[tt] & 0xffffu) * e0, bf2f(raw.qp[tt] >> 16) * e1);
                *(LAS unsigned*)(base + HG_KI + t * HP + cp * 4) = pk2(key0 * __expf(-bt0), key1 * __expf(-bt1));
                *(LAS unsigned*)(base + HG_KE + t * HP + cp * 4) = pk2(key0 * __expf(bl0 - bt0), key1 * __expf(bl1 - bt1));
            }
            { const int row = tidh >> 3, ch = tidh & 7;
              *(LAS u32x4*)(base + HG_VV + row * HP + ch * 16) = raw.v0; *(LAS u32x4*)(base + HG_VV + row * HP + (ch + 8) * 16) = raw.v1; }
            if (sg == 0) { *(LAS f32x2*)(base + HG_DD + cp * 8) = (f32x2){__expf(bl0), __expf(bl1)}; dsum0 += bl0; dsum1 += bl1; }
            __syncthreads();
            if (c < 15) hgrn_load(R2, tok0 + 32, hd, cp, sg, tidh, raw);
            u32x2 sgv[4];
            if (OUT) {
#pragma unroll
                for (int i4 = 0; i4 < 4; ++i4) sgv[i4] = *(const u32x2*)(R2 + (tok0 + l31) * NHG + 3072 + hd * 128 + 32 * wv + 8 * i4 + 4 * hh);
            }
            __builtin_amdgcn_sched_barrier(0);
            f32x16 o;
            if (OUT) {
                f32x16 X;
#pragma unroll
                for (int i = 0; i < 16; ++i) X[i] = 0.f;
#pragma unroll
                for (int s2 = 0; s2 < 8; ++s2) {
                    const bf16x8 af = *(const LAS bf16x8*)(base + HG_KI + l31 * HP + (16 * s2 + 8 * hh) * 2);
                    const bf16x8 bfr = *(const LAS bf16x8*)(base + HG_QD + l31 * HP + (16 * s2 + 8 * hh) * 2);
                    X = MFMA32(af, bfr, X);
                }
                int l31v = l31; asm volatile("" : "+v"(l31v));
#pragma unroll
                for (int i = 0; i < 16; ++i) X[i] = (crow(i, hh) <= l31v) ? X[i] : 0.f;
#pragma unroll
                for (int i = 0; i < 16; ++i) o[i] = 0.f;
#pragma unroll
                for (int s2 = 0; s2 < 2; ++s2) {
                    const LAS unsigned char* vb = base + HG_VV + (16 * s2 + 4 * hh + q4) * HP + (32 * wv + 16 * blk + 4 * p4) * 2;
                    const bf16x8 vf = cat8(vtr(vb), vtr(vb + 8 * HP));
                    o = MFMA32(vf, pack8(X, s2), o);
                }
#pragma unroll
                for (int kb = 0; kb < 4; ++kb)
#pragma unroll
                    for (int s2 = 0; s2 < 2; ++s2) {
                        const LAS unsigned char* qb = base + HG_QD + l31 * HP + (32 * kb + 16 * s2 + 4 * hh) * 2;
                        const bf16x8 qf = cat8(*(const LAS s16x4*)qb, *(const LAS s16x4*)(qb + 16));
                        o = MFMA32(pack8(S[kb], s2), qf, o);
                    }
            }
            if (active) {
#pragma unroll
                for (int kb = 0; kb < 4; ++kb) {
#pragma unroll
                    for (int i4 = 0; i4 < 4; ++i4) { const f32x4 dv = *(const LAS f32x4*)(base + HG_DD + (32 * kb + 8 * i4 + 4 * hh) * 4);
#pragma unroll
                        for (int e = 0; e < 4; ++e) S[kb][4 * i4 + e] *= dv[e]; }
#pragma unroll
                    for (int s2 = 0; s2 < 2; ++s2) {
                        const LAS unsigned char* kb_ = base + HG_KE + (16 * s2 + 8 * hh + q4) * HP + (32 * kb + 16 * blk + 4 * p4) * 2;
                        const LAS unsigned char* vb = base + HG_VV + (16 * s2 + 8 * hh + q4) * HP + (32 * wv + 16 * blk + 4 * p4) * 2;
                        const bf16x8 kf = cat8(vtr(kb_), vtr(kb_ + 4 * HP));
                        const bf16x8 vf = cat8(vtr(vb), vtr(vb + 4 * HP));
                        S[kb] = MFMA32(kf, vf, S[kb]);
                    }
                }
            }
            if (OUT) {
                float ss = 0.f;
#pragma unroll
                for (int i = 0; i < 16; ++i) ss += o[i] * o[i];
                ss = xsum32(ss);
                LAS float* ssq = (LAS float*)(base + HG_SSQ);
                if (hh == 0) ssq[wv * 32 + l31] = ss;
                __syncthreads();
                const float tot2 = ssq[l31] + ssq[32 + l31] + ssq[64 + l31] + ssq[96 + l31];
                const float rinv = rsqrtf(tot2 * (1.0f / 128.0f) + RMS_EPS);
                const size_t tk = tok0 + l31;
#pragma unroll
                for (int i4 = 0; i4 < 4; ++i4) {
                    const int dv0 = 32 * wv + 8 * i4 + 4 * hh;
                    const f32x4 gn = *(const f32x4*)(gain + hd * 128 + dv0);
                    const u32x2 sgg = sgv[i4];
                    const float y0 = o[4 * i4] * rinv * gn[0] * bf2f(sgg.x & 0xffffu), y1 = o[4 * i4 + 1] * rinv * gn[1] * bf2f(sgg.x >> 16);
                    const float y2 = o[4 * i4 + 2] * rinv * gn[2] * bf2f(sgg.y & 0xffffu), y3 = o[4 * i4 + 3] * rinv * gn[3] * bf2f(sgg.y >> 16);
                    *(LAS unsigned*)(base + HG_Y + l31 * HGY_P + dv0) = pk4_fp8(y0, y1, y2, y3);
                }
            }
        }
        if (!OUT && active) {
            float* Lp = Lst + (size_t)item * 16384;
#pragma unroll
            for (int kb = 0; kb < 4; ++kb)
#pragma unroll
                for (int i = 0; i < 16; ++i) Lp[(32 * kb + crow(i, hh)) * 128 + 32 * wv + l31] = S[kb][i];
            if (sg == 0) *(f32x2*)(Dtot + item * 128 + 2 * cp) = (f32x2){__expf(dsum0), __expf(dsum1)};
        }
        __syncthreads();
        if (OUT) { const int row = tidh >> 3, ch = tidh & 7; const LAS unsigned char* yp = base + HG_Y + row * HGY_P + ch * 16;
            const u32x2 ya = *(const LAS u32x2*)yp, yb = *(const LAS u32x2*)(yp + 8);
            *(u32x4*)(yhg + ((size_t)b * SEQ + j * 512 + 15 * 32 + row) * D + hd * 128 + ch * 16) = (u32x4){ya.x, ya.y, yb.x, yb.y}; }
    }
}

constexpr int H1_KE = 0, H1_VV = 64 * HP, H1_DD = 2 * 64 * HP, H1_TOT = H1_DD + 512, H1_HALF = H1_TOT + 2048;
struct Hg1Raw { unsigned lfp[16]; u32x4 v[4]; };
DI void hgrn1_load(const bf16* R2, size_t tok0, int hd, int cp, int sg, int tidh, Hg1Raw& w) {
    const bf16* src = R2 + (tok0 + 16 * sg) * NHG + hd * 128 + 1024 + 2 * cp;
#pragma unroll
    for (int tt = 0; tt < 16; ++tt) w.lfp[tt] = *(const unsigned*)(src + (size_t)tt * NHG);
#pragma unroll
    for (int i = 0; i < 4; ++i) { const int id = tidh + 256 * i, row = id >> 4, ch = id & 15; w.v[i] = *(const u32x4*)(R2 + (tok0 + row) * NHG + 2048 + hd * 128 + ch * 8); }
}
DI void hgrn_l1_phase(const Frame& F, const bf16* R2, float* Lst, float* Dtot) {
    const int hf = F.wave >> 2, wv = F.wave & 3, tidh = F.tid & 255, lane = F.lane, l31 = lane & 31, hh = lane >> 5;
    const int q4 = (lane & 15) >> 2, p4 = lane & 3, blk = (lane >> 4) & 1;
    LAS unsigned char* base = F.lds + hf * H1_HALF;
    const int cp = tidh & 63, sg = tidh >> 6;
    for (int it0 = F.bid * 2; it0 < 512; it0 += F.G * 2) {
        const int item = it0 + hf, j = item & 7, bhd = item >> 3, hd = bhd & 7, b = bhd >> 3;
        const bool active = j < 7;
        f32x16 S[4];
#pragma unroll
        for (int kb = 0; kb < 4; ++kb)
#pragma unroll
            for (int i = 0; i < 16; ++i) S[kb][i] = 0.f;
        float dsum0 = 0.f, dsum1 = 0.f;
        const size_t tokI = (size_t)b * SEQ + j * 512;
        Hg1Raw raw; hgrn1_load(R2, tokI, hd, cp, sg, tidh, raw);
        for (int c = 0; c < 8; ++c) {
            float lf0[16], lf1[16], cs0[16], cs1[16];
            { float r0 = 0.f, r1 = 0.f;
#pragma unroll
              for (int tt = 0; tt < 16; ++tt) { lf0[tt] = bf2f(raw.lfp[tt] & 0xffffu); lf1[tt] = bf2f(raw.lfp[tt] >> 16); r0 += lf0[tt]; r1 += lf1[tt]; cs0[tt] = r0; cs1[tt] = r1; } }
            LAS float* tot = (LAS float*)(base + H1_TOT);
            *(LAS f32x2*)(tot + sg * 128 + 2 * cp) = (f32x2){cs0[15], cs1[15]};
            __syncthreads();
            float off0 = 0.f, off1 = 0.f, bl0 = 0.f, bl1 = 0.f;
#pragma unroll
            for (int g2 = 0; g2 < 4; ++g2) { const f32x2 tv = *(const LAS f32x2*)(tot + g2 * 128 + 2 * cp); bl0 += tv.x; bl1 += tv.y; if (g2 < sg) { off0 += tv.x; off1 += tv.y; } }
#pragma unroll
            for (int tt = 0; tt < 16; ++tt) {
                const float key0 = 1.0f - __expf(lf0[tt]), key1 = 1.0f - __expf(lf1[tt]);
                *(LAS unsigned*)(base + H1_KE + (16 * sg + tt) * HP + cp * 4) = pk2(key0 * __expf(bl0 - off0 - cs0[tt]), key1 * __expf(bl1 - off1 - cs1[tt]));
            }
#pragma unroll
            for (int i = 0; i < 4; ++i) { const int id = tidh + 256 * i, row = id >> 4, ch = id & 15; *(LAS u32x4*)(base + H1_VV + row * HP + ch * 16) = raw.v[i]; }
            if (sg == 0) { *(LAS f32x2*)(base + H1_DD + cp * 8) = (f32x2){__expf(bl0), __expf(bl1)}; dsum0 += bl0; dsum1 += bl1; }
            __syncthreads();
            if (c < 7) hgrn1_load(R2, tokI + 64 * (c + 1), hd, cp, sg, tidh, raw);
            __builtin_amdgcn_sched_barrier(0);
            if (active) {
#pragma unroll
                for (int kb = 0; kb < 4; ++kb) {
#pragma unroll
                    for (int i4 = 0; i4 < 4; ++i4) { const f32x4 dv = *(const LAS f32x4*)(base + H1_DD + (32 * kb + 8 * i4 + 4 * hh) * 4);
#pragma unroll
                        for (int e = 0; e < 4; ++e) S[kb][4 * i4 + e] *= dv[e]; }
#pragma unroll
                    for (int s2 = 0; s2 < 4; ++s2) {
                        const LAS unsigned char* kb_ = base + H1_KE + (16 * s2 + 8 * hh + q4) * HP + (32 * kb + 16 * blk + 4 * p4) * 2;
                        const LAS unsigned char* vb = base + H1_VV + (16 * s2 + 8 * hh + q4) * HP + (32 * wv + 16 * blk + 4 * p4) * 2;
                        S[kb] = MFMA32(cat8(vtr(kb_), vtr(kb_ + 4 * HP)), cat8(vtr(vb), vtr(vb + 4 * HP)), S[kb]);
                    }
                }
            }
        }
        if (active) {
            float* Lp = Lst + (size_t)item * 16384;
#pragma unroll
            for (int kb = 0; kb < 4; ++kb)
#pragma unroll
                for (int i = 0; i < 16; ++i) Lp[(32 * kb + crow(i, hh)) * 128 + 32 * wv + l31] = S[kb][i];
            if (sg == 0) *(f32x2*)(Dtot + item * 128 + 2 * cp) = (f32x2){__expf(dsum0), __expf(dsum1)};
        }
        __syncthreads();
    }
}

DI void ln_router_phase(const Frame& F, const Args& a, const bf16* pre1, bf16* x1b, unsigned char* x18, const bf16* wrt, int* tok_e, float* tok_g, unsigned* cnt_tbl) {
    constexpr int XP = 2048 + 16;
    LAS unsigned char* XS = F.lds; LAS float* LG = (LAS float*)(F.lds + 32 * XP);
    LAS unsigned* hist = (LAS unsigned*)(F.lds + TABL_OFF);
    const int lane = F.lane, w = F.wave, mt = w >> 2, nt = w & 3, l15 = lane & 15, lq = lane >> 4;
    if (F.tid < 64) hist[F.tid] = 0u;
    bf16x8 Bf[32];
    { const bf16* wp = wrt + (size_t)(16 * nt + l15) * 1024 + 8 * lq;
#pragma unroll
      for (int s2 = 0; s2 < 32; ++s2) Bf[s2] = *(const bf16x8*)(wp + 32 * s2); }
    const float rbias = a.router_b[lane];
    u32x2 pfr[4][4];
#pragma unroll
    for (int r = 0; r < 4; ++r)
#pragma unroll
        for (int j = 0; j < 4; ++j) pfr[r][j] = *((const u32x2*)(pre1 + (size_t)(F.bid * 128 + w * 4 + r) * D) + lane + 64 * j);
    for (int bt = 0; bt < 4; ++bt) {
        const int rowb = F.bid * 128 + bt * 32;
        __syncthreads();
#pragma unroll
        for (int r = 0; r < 4; ++r) {
            const int lr = w * 4 + r;
            f32x4 v[4]; float sm = 0.f;
#pragma unroll
            for (int j = 0; j < 4; ++j) { const u32x2 pv = pfr[r][j]; v[j] = (f32x4){bf2f(pv.x & 0xffffu), bf2f(pv.x >> 16), bf2f(pv.y & 0xffffu), bf2f(pv.y >> 16)}; sm += (v[j].x + v[j].y) + (v[j].z + v[j].w); }
            const float mean = wave_sum(sm) * (1.f / D); float s2 = 0.f;
#pragma unroll
            for (int j = 0; j < 4; ++j) { v[j] = v[j] - mean; s2 += (v[j].x * v[j].x + v[j].y * v[j].y) + (v[j].z * v[j].z + v[j].w * v[j].w); }
            const float rstd = rsqrtf(wave_sum(s2) * (1.f / D) + LN_EPS);
            u32x2* o8 = (u32x2*)(x1b + (size_t)(rowb + lr) * D) + lane; unsigned* o4 = (unsigned*)(x18 + (size_t)(rowb + lr) * D) + lane;
#pragma unroll
            for (int j = 0; j < 4; ++j) {
                const f32x4 w4 = *((const f32x4*)a.ln1_w + lane + 64 * j), b4 = *((const f32x4*)a.ln1_b + lane + 64 * j);
                const f32x4 y = v[j] * rstd * w4 + b4;
                const u32x2 yb = (u32x2){pk2(y.x, y.y), pk2(y.z, y.w)};
                o8[64 * j] = yb; o4[64 * j] = pk4_fp8(y.x, y.y, y.z, y.w);
                *(LAS u32x2*)(XS + lr * XP + (lane + 64 * j) * 8) = yb;
            }
        }
        __syncthreads();
        if (bt < 3) {
#pragma unroll
            for (int r = 0; r < 4; ++r)
#pragma unroll
                for (int j = 0; j < 4; ++j) pfr[r][j] = *((const u32x2*)(pre1 + (size_t)(rowb + 32 + w * 4 + r) * D) + lane + 64 * j);
        }
        f32x4 acc = {0.f, 0.f, 0.f, 0.f};
        { const LAS unsigned char* ap = XS + (16 * mt + l15) * XP + 16 * lq;
#pragma unroll
          for (int s2 = 0; s2 < 32; ++s2) acc = __builtin_amdgcn_mfma_f32_16x16x32_bf16(*(const LAS bf16x8*)(ap + 64 * s2), Bf[s2], acc, 0, 0, 0); }
#pragma unroll
        for (int i = 0; i < 4; ++i) LG[(16 * mt + 4 * lq + i) * 64 + 16 * nt + l15] = acc[i];
        __syncthreads();
#pragma unroll
        for (int r = 0; r < 4; ++r) {
            const int lr = w * 4 + r; const float lgt = LG[lr * 64 + lane];
            const float sgm = 1.0f / (1.0f + expf(-lgt)), sel = sgm + rbias;
            float m1 = sel;
            m1 = fmaxf(m1, xshf<1>(m1)); m1 = fmaxf(m1, xshf<2>(m1)); m1 = fmaxf(m1, xshf<4>(m1));
            const unsigned long long eqm = __ballot(sel == m1);
            const unsigned grpbits = (unsigned)((eqm >> (lane & 56)) & 0xffull);
            const int first = __builtin_ctz(grpbits) + (lane & 56);
            float m2 = (lane == first) ? -3.0e38f : sel;
            m2 = fmaxf(m2, xshf<1>(m2)); m2 = fmaxf(m2, xshf<2>(m2)); m2 = fmaxf(m2, xshf<4>(m2));
            const float gs = m1 + m2;
            int grank = 0;
#pragma unroll
            for (int g2 = 0; g2 < 8; ++g2) { const float og = __builtin_bit_cast(float, __builtin_amdgcn_readlane(__builtin_bit_cast(int, gs), 8 * g2));
                grank += (og > gs || (og == gs && g2 < (lane >> 3))) ? 1 : 0; }
            const bool gsel = grank < 4;
            const float ms = gsel ? sel : -INFINITY;
            int rank = 0;
#pragma unroll 8
            for (int e2 = 0; e2 < 64; ++e2) { const float oe = __builtin_bit_cast(float, __builtin_amdgcn_readlane(__builtin_bit_cast(int, ms), e2));
                rank += (oe > ms || (oe == ms && e2 < lane)) ? 1 : 0; }
            const bool chosen = gsel && rank < 8;
            const float ssum = wave_sum(chosen ? sgm : 0.f);
            if (chosen) {
                const size_t o = (size_t)(rowb + lr) * 8 + rank;
                tok_e[o] = lane; tok_g[o] = sgm / ssum * 2.5f;
                __hip_atomic_fetch_add(hist + lane, 1u, __ATOMIC_RELAXED, __HIP_MEMORY_SCOPE_WORKGROUP);
            }
        }
    }
    __syncthreads();
    if (F.tid < 64) cnt_tbl[F.bid * 64 + F.tid] = hist[F.tid];
}
DI void p8_convert(const Frame& F, const Args& a, unsigned char* wed, bf16* pb) {
    tr_run(F, 64 * 128, [&](int it) LAMBDA_INL { return p8_item(a, wed, it); });
    const int gw = F.bid * 8 + F.wave, NGW = F.G * 8;
    for (int m0 = gw * 8; m0 < T; m0 += NGW * 8) { f32x4 v[8];
#pragma unroll
        for (int q = 0; q < 8; ++q) v[q] = *((const f32x4*)(a.p + (size_t)(m0 + q) * 256) + F.lane);
#pragma unroll
        for (int q = 0; q < 8; ++q) *((u32x2*)(pb + (size_t)(m0 + q) * 256) + F.lane) = (u32x2){pk2(v[q].x, v[q].y), pk2(v[q].z, v[q].w)}; }
}
DI void scatter_phase(const Frame& F, const unsigned* cnt_tbl, const int* tok_e, const float* tok_g, int* pos_of, int* tok_list, float* gate_list, unsigned* tabw) {
    LAS unsigned* part = (LAS unsigned*)(F.lds);
    LAS unsigned* cur = (LAS unsigned*)(F.lds + 8192);
    LAS unsigned* segs = (LAS unsigned*)(F.lds + 8192 + 256);
    constexpr int WPB = 256 / NBLK, WPP = WPB / 8;
    const int w = F.bid, blk = w / WPB, wl = w % WPB, e = F.tid & 63, part_i = F.tid >> 6;
    __syncthreads();
    { unsigned tot = 0, below = 0;
      for (int q = 0; q < WPP; ++q) { const int w2 = part_i * WPP + q; const unsigned c = cnt_tbl[(blk * WPB + w2) * 64 + e]; tot += c; below += (w2 < wl) ? c : 0u; }
      part[part_i * 64 + e] = tot; part[512 + part_i * 64 + e] = below; }
    __syncthreads();
    if (F.tid < 64) { unsigned tot = 0, below = 0;
        for (int q = 0; q < 8; ++q) { tot += part[q * 64 + e]; below += part[512 + q * 64 + e]; }
        segs[64 + e] = tot; segs[128 + e] = (tot + 255u) >> 8; cur[e] = below; }
    __syncthreads();
    if (F.tid == 0) { unsigned run = 0; for (int q = 0; q < 64; ++q) { segs[q] = run * 256u; run += segs[128 + q]; } segs[192] = run; }
    __syncthreads();
    if (F.tid < 64) cur[e] += segs[e];
    __syncthreads();
    int* tl = tok_list + (size_t)blk * MAXROWS; float* gl = gate_list + (size_t)blk * MAXROWS;
    for (int i = F.tid; i < 128 * 8; i += 512) {
        const int tk = w * 128 + (i >> 3); const int ex = tok_e[(size_t)tk * 8 + (i & 7)];
        const unsigned pos = __hip_atomic_fetch_add(cur + ex, 1u, __ATOMIC_RELAXED, __HIP_MEMORY_SCOPE_WORKGROUP);
        tl[pos] = tk; gl[pos] = tok_g[(size_t)tk * 8 + (i & 7)]; pos_of[(size_t)tk * 8 + (i & 7)] = (int)pos;
    }
    if (wl < 64) { const unsigned st = segs[wl] + segs[64 + wl], en = segs[wl] + segs[128 + wl] * 256u;
      for (unsigned pz = st + F.tid; pz < en; pz += 512) { tl[pz] = blk * TB; gl[pz] = 0.f; } }
    if (wl == 0) {
        if (F.tid == 0) tabw[TB_NT + blk * 64] = segs[192];
        if (F.tid < 64) { const unsigned t0 = segs[e] >> 8, nt_ = segs[128 + e]; for (unsigned q = 0; q < nt_; ++q) tabw[TB_TEXP + blk * MAXTILES + t0 + q] = (unsigned)e; }
    }
}
struct CombHdr { int pos[8]; u32x2 xv[4], dv[4]; };
DI void comb_load_hdr(CombHdr& h, size_t tk, const bf16* x1b, const bf16* dense, const int* pos_of, int lane) {
#pragma unroll
    for (int k = 0; k < 8; ++k) h.pos[k] = pos_of[tk * 8 + k];
#pragma unroll
    for (int j = 0; j < 4; ++j) { h.xv[j] = *((const u32x2*)(x1b + tk * D) + lane + 64 * j); h.dv[j] = *((const u32x2*)(dense + tk * D) + lane + 64 * j); }
}
DI void combine_phase(const Frame& F, const Args& a, int blk, const bf16* x1b, const bf16* dense, const unsigned char* ye, const unsigned char* ye2, const int* pos_of) {
    const int gw = F.bid * 8 + F.wave, NGW = F.G * 8, lane = F.lane;
    CombHdr h[2];
    if (gw < TB) { comb_load_hdr(h[0], (size_t)blk * TB + gw, x1b, dense, pos_of, lane); comb_load_hdr(h[1], (size_t)blk * TB + gw + NGW, x1b, dense, pos_of, lane); }
    for (int it = gw; it < TB; it += 2 * NGW) {
        unsigned yv[2][8][4];
#pragma unroll
        for (int q = 0; q < 2; ++q)
#pragma unroll
            for (int k = 0; k < 8; ++k) { const int p = h[q].pos[k]; const unsigned char* yr = p < YE_SPLIT ? ye + (size_t)p * D : ye2 + (size_t)(p - YE_SPLIT) * D;
#pragma unroll
                for (int j = 0; j < 4; ++j) yv[q][k][j] = *((const unsigned*)yr + lane + 64 * j); }
        f32x4 v[2][4];
#pragma unroll
        for (int q = 0; q < 2; ++q)
#pragma unroll
            for (int j = 0; j < 4; ++j) { const u32x2 xv = h[q].xv[j], dv = h[q].dv[j];
                v[q][j] = (f32x4){bf2f(xv.x & 0xffffu), bf2f(xv.x >> 16), bf2f(xv.y & 0xffffu), bf2f(xv.y >> 16)} * ALPHA
                        + (f32x4){bf2f(dv.x & 0xffffu), bf2f(dv.x >> 16), bf2f(dv.y & 0xffffu), bf2f(dv.y >> 16)}; }
        const int itn = it + 2 * NGW;
        if (itn < TB) { comb_load_hdr(h[0], (size_t)blk * TB + itn, x1b, dense, pos_of, lane); comb_load_hdr(h[1], (size_t)blk * TB + itn + NGW, x1b, dense, pos_of, lane); }
#pragma unroll
        for (int q = 0; q < 2; ++q) {
            const size_t tk = (size_t)blk * TB + it + q * NGW;
#pragma unroll
            for (int k = 0; k < 8; ++k)
#pragma unroll
                for (int j = 0; j < 4; ++j) v[q][j] += unpk4_fp8(yv[q][k][j]) * YEI;
            float sm = 0.f;
#pragma unroll
            for (int j = 0; j < 4; ++j) sm += (v[q][j].x + v[q][j].y) + (v[q][j].z + v[q][j].w);
            const float mean = wave_sum(sm) * (1.f / D); float s2 = 0.f;
#pragma unroll
            for (int j = 0; j < 4; ++j) { v[q][j] = v[q][j] - mean; s2 += (v[q][j].x * v[q][j].x + v[q][j].y * v[q][j].y) + (v[q][j].z * v[q][j].z + v[q][j].w * v[q][j].w); }
            const float rstd = rsqrtf(wave_sum(s2) * (1.f / D) + LN_EPS);
#pragma unroll
            for (int j = 0; j < 4; ++j) {
                const f32x4 w4 = *((const f32x4*)a.ln2_w + lane + 64 * j), b4 = *((const f32x4*)a.ln2_b + lane + 64 * j);
                *((f32x4*)(a.out + tk * D) + lane + 64 * j) = v[q][j] * rstd * w4 + b4;
            }
        }
    }
}

#ifndef PHASE_MASK
#define PHASE_MASK 0xffffffffu
#endif
#define PH(k) ((PHASE_MASK >> (k)) & 1u)
#ifndef REPEAT_MASK
#define REPEAT_MASK 0u
#endif
#define RP(k) (1 + (int)((REPEAT_MASK >> (k)) & 1u))
typedef const __attribute__((address_space(4))) Args* KArgsPtr;
DI KArgsPtr kargs_ptr() { KArgsPtr p = (KArgsPtr)__builtin_amdgcn_kernarg_segment_ptr(); asm volatile("" : "+s"(p)); return p; }
__global__ void __launch_bounds__(512, 2) fwd_kernel(Args a_by_value) {
    extern __shared__ __attribute__((aligned(16))) unsigned char lds_raw[];
    (void)a_by_value;
#if defined(__HIP_DEVICE_COMPILE__)
    const int wave0 = __builtin_amdgcn_readfirstlane((int)threadIdx.x >> 6) & 7;
#define LEADER() (wave0 == 0 && lane_id_asm() == 0)
#define FRAME() Frame F; { const int l_ = lane_id_asm(); F.tid = wave0 * 64 + l_; F.lane = l_; F.wave = wave0; F.G = gridDim.x; F.bid = blockIdx.x; F.lds = (LAS unsigned char*)lds_raw; } \
                const Args a = *kargs_ptr(); unsigned char* const ws = a.ws; unsigned char* const dob = (unsigned char*)a.out; unsigned* const tabw = (unsigned*)(ws + WS_TAB); (void)dob; (void)tabw;
#define STAMP() do {} while (0)
#define GRIDBAR() do { GRIDBAR_(); STAMP(); } while (0)
#define GRIDBAR_() do { XcdBarrier bar_; bar_.bar = (unsigned*)(kargs_ptr()->ws + WS_CTL) + 4096; bar_.x = xb_xcc_id(); bar_.st = (volatile LAS unsigned*)((LAS unsigned char*)lds_raw + MISC_OFF) + 8; xcd_barrier(bar_, LEADER()); } while (0)
    {
        for (int u = threadIdx.x; u < (LDS_BYTES - LDSCTL_OFF) / 4; u += 512) ((LAS unsigned*)((LAS unsigned char*)lds_raw + LDSCTL_OFF))[u] = 0u;
        __syncthreads();
        (void)xcd_barrier_post((unsigned*)(kargs_ptr()->ws + WS_CTL) + 4096, (volatile LAS unsigned*)((LAS unsigned char*)lds_raw + MISC_OFF) + 8, LEADER());
        STAMP();
    }
    _Pragma("unroll 1") for (int rep_ = 0; rep_ < RP(0); ++rep_) if (PH(0)) { FRAME(); p0_prologue(F, a); }
    GRIDBAR();
    _Pragma("unroll 1") for (int rep_ = 0; rep_ < RP(1); ++rep_) if (PH(1)) { FRAME(); ProbQKV P; P.init(ws + WS_X8, ws + WS_WIN8, T, NATT, 512, F.G, F.bid); P.O = (bf16*)(ws + WS_R); P.xl = F.lds; pg8::gemm_phase(F.lds, P, wave0); }
    GRIDBAR();
    _Pragma("unroll 1") for (int rep_ = 0; rep_ < RP(2); ++rep_) if (PH(2)) { FRAME(); attn_phase(F, (const bf16*)(ws + WS_R), (bf16*)dob, (float*)(dob + DO_LSE)); }
    GRIDBAR();
    _Pragma("unroll 1") for (int rep_ = 0; rep_ < RP(3); ++rep_) if (PH(3)) { FRAME(); attn_mix_phase(F, (const bf16*)dob, (const float*)(dob + DO_LSE), ws + WS_YATT); }
    GRIDBAR();
    _Pragma("unroll 1") for (int rep_ = 0; rep_ < RP(4); ++rep_) if (PH(4)) { FRAME(); ProbHG P; P.init(ws + WS_X8, ws + WS_WIN8 + (size_t)NATT * 1024, T, NHG + NGATE, 512, F.G, F.bid); P.R2 = (bf16*)(ws + WS_R); P.gates = (bf16*)dob; P.lbl = a.lb_logits; pg8::gemm_phase(F.lds, P, wave0); }
    GRIDBAR();
    _Pragma("unroll 1") for (int rep_ = 0; rep_ < RP(5); ++rep_) if (PH(5)) { FRAME(); hgrn_l1_phase(F, (const bf16*)(ws + WS_R), (float*)(ws + WS_L), (float*)(ws + WS_TAB + 128 * 1024)); }
    GRIDBAR();
    _Pragma("unroll 1") for (int rep_ = 0; rep_ < RP(7); ++rep_) if (PH(7)) { FRAME(); hgrn_phase<true>(F, (const bf16*)(ws + WS_R), (float*)(ws + WS_L), (float*)(ws + WS_TAB + 128 * 1024), a.hg_norm_w, ws + WS_XB); }
    GRIDBAR();
    _Pragma("unroll 1") for (int rep_ = 0; rep_ < RP(8); ++rep_) if (PH(8)) { FRAME(); ProbBrA P; P.init(ws + WS_YATT, ws + WS_WA, T, 1024, 256, F.G, F.bid); P.gates = (const bf16*)dob; P.O = (bf16*)(ws + WS_MERGED); pg8::gemm_phase(F.lds, P, wave0); }
    __syncthreads();
    _Pragma("unroll 1") for (int rep_ = 0; rep_ < RP(9); ++rep_) if (PH(9)) { FRAME(); ProbBrH P; P.init(ws + WS_XB, ws + WS_WH, T, 1024, 512, F.G, F.bid); P.gates = (const bf16*)dob; P.M1 = (const bf16*)(ws + WS_MERGED); P.O = ws + 320 * MiB; pg8::gemm_phase(F.lds, P, wave0); }
    GRIDBAR();
    _Pragma("unroll 1") for (int rep_ = 0; rep_ < RP(10); ++rep_) if (PH(10)) { FRAME(); ProbWo P; P.init(ws + 320 * MiB, ws + WS_WO, T, 1024, 512, F.G, F.bid); P.x = a.x; P.O = (bf16*)(ws + WS_PRE1); pg8::gemm_phase(F.lds, P, wave0); }
    GRIDBAR();
    _Pragma("unroll 1") for (int rep_ = 0; rep_ < RP(11); ++rep_) if (PH(11)) { FRAME(); ln_router_phase(F, a, (const bf16*)(ws + WS_PRE1), (bf16*)(ws + WS_X1B), ws + WS_X8, (const bf16*)(ws + WS_WRT), (int*)(ws + WS_LISTS + LS_TOKE), (float*)(ws + WS_LISTS + LS_TOKG), tabw + TB_CNT); }
    __syncthreads();
    _Pragma("unroll 1") for (int rep_ = 0; rep_ < RP(12); ++rep_) if (PH(12)) { FRAME(); p8_convert(F, a, dob + DO_WED, (bf16*)(ws + WS_PB)); }
    GRIDBAR();
    _Pragma("unroll 1") for (int rep_ = 0; rep_ < RP(13); ++rep_) if (PH(13)) { FRAME(); scatter_phase(F, tabw + TB_CNT, (const int*)(ws + WS_LISTS + LS_TOKE), (const float*)(ws + WS_LISTS + LS_TOKG), (int*)(ws + WS_LISTS + LS_POS),
                  (int*)(ws + WS_LISTS + LS_TOKLIST), (float*)(ws + WS_LISTS + LS_GATELIST), tabw); }
    __syncthreads();
    _Pragma("unroll 1") for (int rep_ = 0; rep_ < RP(14); ++rep_) if (PH(14)) { FRAME(); ProbPP P; P.init(ws + WS_PB, ws + WS_WPP, T, 1024, 256, F.G, F.bid); P.O = (bf16*)(ws + WS_XB); pg8::gemm_phase(F.lds, P, wave0); }
    __syncthreads();
    _Pragma("unroll 1") for (int rep_ = 0; rep_ < RP(15); ++rep_) if (PH(15)) { FRAME(); ProbPG P; P.init(ws + WS_X8, ws + WS_WPG, T, 1024, 512, F.G, F.bid); P.O = (bf16*)(ws + WS_XB); pg8::gemm_phase(F.lds, P, wave0); }
    __syncthreads();
    _Pragma("unroll 1") for (int rep_ = 0; rep_ < RP(16); ++rep_) if (PH(16)) { FRAME(); ProbSGU P; P.init(ws + WS_X1B, ws + WS_WSGU, T, 512, 1024, F.G, F.bid); P.O = (bf16*)(ws + WS_HS); pg8::gemm_phase(F.lds, P, wave0); }
    GRIDBAR();
#pragma unroll 1
    for (int blk = 0; blk < NBLK; ++blk) {
        {
            FRAME(); LAS int* texp = (LAS int*)(F.lds + TABL_OFF);
            const int ntl = (int)tabw[TB_NT + blk * 64];
            __syncthreads();
            for (int i = F.tid; i < ntl; i += 512) texp[i] = (int)tabw[TB_TEXP + blk * MAXTILES + i];
            __syncthreads();
            LAS unsigned short* ltok = (LAS unsigned short*)(F.lds + XL_TOK); LAS float* lgate = (LAS float*)(F.lds + XL_GATE);
            { const int* tl_ = (const int*)(ws + WS_LISTS + LS_TOKLIST) + (size_t)blk * MAXROWS; const float* gl_ = (const float*)(ws + WS_LISTS + LS_GATELIST) + (size_t)blk * MAXROWS;
              const int pm0_ = ((F.bid >> 3) >> 1) * 8 + (F.bid & 7);
#pragma unroll 1
              for (int i = 0; i < XL_UNITS; ++i) { const int pm_ = i * 128 + pm0_; if (pm_ >= ntl) break;
                  if (F.tid < 256) ltok[i * 256 + F.tid] = (unsigned short)tl_[pm_ * 256 + F.tid]; else lgate[i * 256 + F.tid - 256] = gl_[pm_ * 256 + F.tid - 256]; } }
            __syncthreads();
            _Pragma("unroll 1") for (int rep_ = 0; rep_ < RP(18); ++rep_) if (PH(18)) { ProbMoeUp P; P.A = (const char*)(ws + WS_X8); P.Bt = (const char*)(ws + WS_WEGU8); P.K = 512; P.ntiles = ntl; P.G = F.G; P.c = F.bid; P.texp = texp;
              P.ltok = ltok; P.lgate = lgate; P.H = dob; pg8::gemm_phase(F.lds, P, wave0); }
            __syncthreads();
            _Pragma("unroll 1") for (int rep_ = 0; rep_ < RP(17); ++rep_) if (PH(17)) { ProbSD P; P.init(ws + WS_HS, ws + WS_WSD, T, 1024, 256, F.G, F.bid); P.O = (bf16*)(ws + WS_XB);
              const int x_ = F.bid & 7, sl_ = F.bid >> 3, q_ = (sl_ >> 1) * 8 + x_, full_ = ntl - 8 * 128;
              const int fl_ = full_ < 0 ? 0 : (full_ > 128 ? 128 : full_);
              P.nlight = 2 * (128 - fl_); P.rank = (q_ >= fl_ && P.nlight > 0) ? 2 * (q_ - fl_) + (sl_ & 1) : -1;
              if (P.nlight == 0) { P.nlight = 256; P.rank = F.bid; }
              pg8::gemm_phase(F.lds, P, wave0); }
        }
        GRIDBAR();
        {
            FRAME(); LAS int* texp = (LAS int*)(F.lds + TABL_OFF);
            const int ntl = (int)tabw[TB_NT + blk * 64];
            _Pragma("unroll 1") for (int rep_ = 0; rep_ < RP(19); ++rep_) if (PH(19)) { ProbMoeDown P; P.A = (const char*)dob; P.Bt = (const char*)(dob + DO_WED); P.ntiles = ntl; P.G = F.G; P.c = F.bid; P.texp = texp;
              P.Y = ws + WS_YE; P.Y2 = ws + WS_YE2; P.xb = F.lds + (TABL_OFF + 6144); pg8::gemm_phase(F.lds, P, wave0); }
        }
        GRIDBAR();
        _Pragma("unroll 1") for (int rep_ = 0; rep_ < RP(20); ++rep_) if (PH(20)) { FRAME(); combine_phase(F, a, blk, (const bf16*)(ws + WS_X1B), (const bf16*)(ws + WS_XB), ws + WS_YE, ws + WS_YE2, (const int*)(ws + WS_LISTS + LS_POS)); }
    }
#endif
}

extern "C" void kernel_launch(void* const* d_in, const int* in_sizes, int n_in, void* d_out, int out_size, void* d_ws, size_t ws_size, hipStream_t stream) {
    static int grid = 0;
    if (grid == 0) {
        if (n_in != 22 || in_sizes[0] != T * D || out_size != T * D || ws_size < WS_END) { fprintf(stderr, "kernel_launch: unexpected shapes (n_in %d, in0 %d, out %d, ws %zu)\n", n_in, n_in > 0 ? in_sizes[0] : -1, out_size, ws_size); grid = -1; return; }
        int dev = 0, cus = 0, per_cu = 0;
        if (hipGetDevice(&dev) != hipSuccess || hipDeviceGetAttribute(&cus, hipDeviceAttributeMultiprocessorCount, dev) != hipSuccess) { grid = -1; return; }
        if (hipFuncSetAttribute((const void*)fwd_kernel, hipFuncAttributeMaxDynamicSharedMemorySize, LDS_BYTES) != hipSuccess) { fprintf(stderr, "kernel_launch: hipFuncSetAttribute failed\n"); grid = -1; return; }
        if (hipOccupancyMaxActiveBlocksPerMultiprocessor(&per_cu, (const void*)fwd_kernel, 512, LDS_BYTES) != hipSuccess || per_cu < 1) fprintf(stderr, "kernel_launch: occupancy query says %d\n", per_cu);
        (void)hipGetLastError();
        grid = cus;
        if (grid != 256) { fprintf(stderr, "kernel_launch: built for 256 CUs, device has %d\n", cus); grid = -1; return; }
    }
    if (grid < 0) return;
    if (hipMemsetAsync((char*)d_ws + WS_CTL, 0, CTL_ZERO_BYTES, stream) != hipSuccess) return;
    Args a{};
    const float** pp = (const float**)&a;
    for (int i = 0; i < 22; ++i) pp[i] = (const float*)d_in[i];
    a.out = (float*)d_out; a.ws = (unsigned char*)d_ws;
    hipLaunchKernelGGL(fwd_kernel, dim3(grid), dim3(512), LDS_BYTES, stream, a);
}
```

```cpp
#include <hip/hip_runtime.h>
#include <cstdio>
#include <cstdint>

#define LAS __attribute__((address_space(3)))
#define GAS __attribute__((address_space(1)))
#define DI __device__ __forceinline__
typedef unsigned short bf16;
typedef short bf16x8 __attribute__((ext_vector_type(8)));
typedef short s16x4 __attribute__((ext_vector_type(4)));
typedef short v4i16_t __attribute__((ext_vector_type(4)));
typedef float f32x2 __attribute__((ext_vector_type(2)));
typedef float f32x4 __attribute__((ext_vector_type(4)));
typedef float f32x16 __attribute__((ext_vector_type(16)));
typedef unsigned u32x2 __attribute__((ext_vector_type(2)));
typedef unsigned u32x4 __attribute__((ext_vector_type(4)));
typedef __bf16 bf16x2_t __attribute__((ext_vector_type(2)));
typedef int v8i32 __attribute__((ext_vector_type(8)));
typedef short s16x16 __attribute__((ext_vector_type(16)));

constexpr int NB = 8, SEQ = 4096, T = NB * SEQ, D = 1024;
constexpr int NIN = 10752, NATT = 4608, NHG = 4096, NGATE = 2048;
constexpr int NEXP = 64, TOPK = 8, EFF = 256;
constexpr int NBLK = 1, TB = T / NBLK;
constexpr int MAXTILES = TB * TOPK / 256 + NEXP;
constexpr int MAXROWS = MAXTILES * 256;
constexpr float LN_EPS = 1e-5f, RMS_EPS = 1e-6f;
constexpr float ALPHA = 1.18920711500272f;
constexpr float LOG2E = 1.4426950408889634f;
constexpr float QSCALE = 0.125f * LOG2E;
constexpr float LN2 = 0.69314718055994531f;
constexpr float W8S = 32.0f, W8I = 1.0f / 32.0f;
constexpr float HGS = 8.0f;
constexpr float YEI = 1.0f / (8.0f * 32.0f);

constexpr size_t MiB = 1u << 20;
constexpr size_t WS_CTL = 0, CTL_ZERO_BYTES = 64 * 1024;
constexpr size_t WS_TAB = 512 * 1024;
constexpr size_t WS_LISTS = 1 * MiB;
constexpr size_t WS_WIN8 = 1 * MiB, WS_WIN = 6 * MiB, WS_WA = 22 * MiB, WS_WH = 23 * MiB, WS_WO = 25 * MiB, WS_WPG = 27 * MiB, WS_WPP = 29 * MiB, WS_WSGU = 30 * MiB, WS_WSD = 31 * MiB, WS_WEGU8 = 32 * MiB, WS_X8 = 64 * MiB;
constexpr size_t WS_WRT = 29 * MiB + 512 * 1024;
constexpr size_t WS_PB = 96 * MiB, WS_HS = 112 * MiB;
constexpr size_t WS_XB = 128 * MiB;
constexpr size_t WS_R = 192 * MiB;
constexpr size_t WS_L = 448 * MiB;
constexpr size_t WS_YATT = 480 * MiB;
constexpr size_t WS_MERGED = 192 * MiB, WS_PRE1 = 256 * MiB, WS_X1B = 448 * MiB;
constexpr size_t WS_YE = 192 * MiB, WS_YE2 = 96 * MiB;
constexpr int YE_SPLIT = 262144;
constexpr size_t WS_END = 512 * MiB;
static_assert(WS_YE + (size_t)YE_SPLIT * 1024 <= WS_X1B && WS_YE2 + (size_t)(MAXROWS - YE_SPLIT) * 1024 <= 128 * MiB && (size_t)MAXROWS * 256 <= 96 * MiB, "ws map");
constexpr size_t LS_TOKE = 0, LS_TOKG = 1 * MiB, LS_POS = 2 * MiB, LS_TOKLIST = 3 * MiB, LS_GATELIST = 3 * MiB + (size_t)NBLK * MAXROWS * 4;
static_assert(LS_GATELIST + (size_t)NBLK * MAXROWS * 4 <= 7 * MiB, "lists");
constexpr size_t DO_LSE = 96 * MiB, DO_WED = 96 * MiB;
constexpr size_t WS_OPART = 96 * MiB, WS_LSE = 496 * MiB;
static_assert(WS_OPART + (size_t)3 * T * 512 * 2 <= WS_R && WS_LSE + (size_t)3 * T * 8 * 4 <= WS_END, "partials");
constexpr int TB_CNT = 0;
constexpr int TB_NT = 256 * 64;
constexpr int TB_TEXP = TB_NT + 4 * 64;
constexpr int TB_TCNT = TB_TEXP + 4 * MAXTILES;

constexpr int RING_BYTES = 131072, LDSCTL_OFF = RING_BYTES, MISC_OFF = LDSCTL_OFF + 320, TABL_OFF = LDSCTL_OFF + 1024, LDS_BYTES = 163840;

DI float bf2f(unsigned b) { return __uint_as_float(b << 16); }
DI unsigned f2bf(float f) { unsigned u = __float_as_uint(f); return (u + 0x7fffu + ((u >> 16) & 1u)) >> 16; }
DI unsigned pk2(float lo, float hi) { f32x2 v = {lo, hi}; bf16x2_t b = __builtin_convertvector(v, bf16x2_t); return __builtin_bit_cast(unsigned, b); }
DI unsigned pk4_fp8(float a, float b, float c, float d) { int w = 0; w = __builtin_amdgcn_cvt_pk_fp8_f32(a, b, w, false); w = __builtin_amdgcn_cvt_pk_fp8_f32(c, d, w, true); return (unsigned)w; }
DI f32x4 unpk4_fp8(unsigned w) { const f32x2 lo = __builtin_amdgcn_cvt_pk_f32_fp8((int)w, false), hi = __builtin_amdgcn_cvt_pk_f32_fp8((int)w, true); return (f32x4){lo.x, lo.y, hi.x, hi.y}; }
DI float sigmoidf_(float v) { return __builtin_amdgcn_rcpf(1.0f + __expf(-v)); }
DI float siluf_(float v) { return v * sigmoidf_(v); }
template <int M> DI float xshf(float v) {
    if constexpr (M == 32) { const auto rr = __builtin_amdgcn_permlane32_swap(__float_as_uint(v), __float_as_uint(v), false, false); return __uint_as_float(rr[0] == __float_as_uint(v) ? rr[1] : rr[0]); }
    else return __builtin_bit_cast(float, __builtin_amdgcn_ds_swizzle(__builtin_bit_cast(int, v), 0x1F | (M << 10)));
}
DI float xsum32(float v) { const auto rr = __builtin_amdgcn_permlane32_swap(__float_as_uint(v), __float_as_uint(v), false, false); return __uint_as_float(rr[0]) + __uint_as_float(rr[1]); }
DI float xmax32(float v) { const auto rr = __builtin_amdgcn_permlane32_swap(__float_as_uint(v), __float_as_uint(v), false, false); return fmaxf(__uint_as_float(rr[0]), __uint_as_float(rr[1])); }
template <int CTRL, int RM = 0xf, bool BC = true> DI float dppf(float v) { return __builtin_bit_cast(float, __builtin_amdgcn_update_dpp(0, __builtin_bit_cast(int, v), CTRL, RM, 0xf, BC)); }
DI float wave_sum(float v) {
    v += dppf<0x111>(v); v += dppf<0x112>(v); v += dppf<0x114>(v); v += dppf<0x118>(v);
    v += dppf<0x142, 0xa, false>(v); v += dppf<0x143, 0xc, false>(v);
    return __builtin_bit_cast(float, __builtin_amdgcn_readlane(__builtin_bit_cast(int, v), 63));
}
DI float wave_sum_sw(float v) {
    v += xshf<1>(v); v += xshf<2>(v); v += xshf<4>(v); v += xshf<8>(v); v += xshf<16>(v);
    return xsum32(v);
}
DI float grp8_max(float v) {
    v = fmaxf(v, dppf<0xB1>(v)); v = fmaxf(v, dppf<0x4E>(v)); return fmaxf(v, dppf<0x141>(v));
}
DI int lane_id_asm() { int l; asm volatile("v_mbcnt_lo_u32_b32 %0, -1, 0\n\tv_mbcnt_hi_u32_b32 %0, -1, %0" : "=v"(l)); return l & 63; }
DI int crow(int r, int hi) { return (r & 3) + 8 * (r >> 2) + 4 * hi; }
DI s16x4 vtr(const LAS unsigned char* p) { return __builtin_bit_cast(s16x4, __builtin_amdgcn_ds_read_tr16_b64_v4i16((LAS v4i16_t*)p)); }
DI bf16x8 cat8(s16x4 lo, s16x4 hi) { return (bf16x8){lo[0], lo[1], lo[2], lo[3], hi[0], hi[1], hi[2], hi[3]}; }
DI bf16x8 pack8(const f32x16& x, int s) {
    u32x4 p; p.x = pk2(x[8 * s], x[8 * s + 1]); p.y = pk2(x[8 * s + 2], x[8 * s + 3]); p.z = pk2(x[8 * s + 4], x[8 * s + 5]); p.w = pk2(x[8 * s + 6], x[8 * s + 7]);
    return __builtin_bit_cast(bf16x8, p);
}
#define MFMA32(a, b, c) __builtin_amdgcn_mfma_f32_32x32x16_bf16((a), (b), (c), 0, 0, 0)

#define XB_TMO      128
#define XB_XCNT(j)  (256  + 64 * (j))
#define XB_XSUB(j)  (1280 + 64 * (j))
#define XB_XGEN(j)  (2304 + 64 * (j))
#define XB_TOP      3328
#define XB_TOPGEN   3392
#define XCD_BAR_WORDS 3456
#define XB_SPIN_CAP (1u << 18)
DI unsigned xb_ld(unsigned* p)              { return __hip_atomic_load(p, __ATOMIC_RELAXED, __HIP_MEMORY_SCOPE_AGENT); }
DI unsigned xb_add(unsigned* p, unsigned v) { return __hip_atomic_fetch_add(p, v, __ATOMIC_RELAXED, __HIP_MEMORY_SCOPE_AGENT); }
DI unsigned xb_xcc_id() { return (unsigned)__builtin_amdgcn_s_getreg((3 << 11) | 20) & 0xFu; }
#define XB_SPIN(cond, bar) do { unsigned _sp = 0; while (cond) { __builtin_amdgcn_s_sleep(1); \
    if ((++_sp & 255u) == 0u) { if (xb_ld(&(bar)[XB_TMO])) break; if (_sp > XB_SPIN_CAP) { atomicAdd(&(bar)[XB_TMO], 1u); break; } } } } while (0)
struct XcdBarrier { unsigned* bar; unsigned x; volatile LAS unsigned* st; };
DI XcdBarrier xcd_barrier_post(unsigned* bar, volatile LAS unsigned* st, bool leader) {
    XcdBarrier b; b.bar = bar; b.x = xb_xcc_id(); b.st = st;
    if (leader) (void)xb_add(&bar[XB_XCNT(b.x)], 1u);
    return b;
}
DI void xcd_barrier_complete(unsigned* bar, unsigned x, unsigned& nloc, unsigned& nx) {
    const unsigned G = gridDim.x * gridDim.y * gridDim.z;
    unsigned sum, cnt, mine, sp = 0u;
    for (;;) {
        sum = 0u; cnt = 0u; mine = 0u;
#pragma unroll
        for (unsigned j = 0; j < 16; ++j) { const unsigned c = xb_ld(&bar[XB_XCNT(j)]); sum += c; cnt += (c > 0u) ? 1u : 0u; mine = (j == x) ? c : mine; }
        if (sum == G) break;
        __builtin_amdgcn_s_sleep(1);
        if ((++sp & 255u) == 0u) { if (xb_ld(&bar[XB_TMO])) break; if (sp > XB_SPIN_CAP) { atomicAdd(&bar[XB_TMO], 1u); break; } }
    }
    nloc = mine > 0u ? mine : 1u; nx = cnt > 0u ? cnt : 1u;
}
DI void xcd_barrier(const XcdBarrier& b, bool leader) {
    asm volatile("s_waitcnt vmcnt(0)" ::: "memory");
    __syncthreads();
    if (leader) {
        unsigned* bar = b.bar;
        __builtin_amdgcn_s_waitcnt(0);
        unsigned nloc = b.st[0], nx = b.st[1];
        if (nloc == 0u) { xcd_barrier_complete(bar, b.x, nloc, nx); b.st[0] = nloc; b.st[1] = nx; }
        const unsigned old = xb_add(&bar[XB_XSUB(b.x)], 1u);
        const unsigned gen = old / nloc;
        if (old + 1u == (gen + 1u) * nloc) {
            __builtin_amdgcn_fence(__ATOMIC_RELEASE, "agent");
            asm volatile("s_waitcnt vmcnt(0)" ::: "memory");
            const unsigned og = xb_add(&bar[XB_TOP], 1u);
            const unsigned tg = og / nx;
            if (og + 1u == (tg + 1u) * nx) xb_add(&bar[XB_TOPGEN], 1u);
            else XB_SPIN(xb_ld(&bar[XB_TOPGEN]) == tg, bar);
            __builtin_amdgcn_fence(__ATOMIC_ACQUIRE, "agent");
            xb_add(&bar[XB_XGEN(b.x)], 1u);
            asm volatile("s_waitcnt vmcnt(0)" ::: "memory");
        } else {
            XB_SPIN(xb_ld(&bar[XB_XGEN(b.x)]) == gen, bar);
            __builtin_amdgcn_fence(__ATOMIC_ACQUIRE, "agent");
            asm volatile("s_waitcnt vmcnt(0)" ::: "memory");
        }
    }
    __syncthreads();
}

namespace pg8 {
constexpr int BM = 256, BK = 64, HALF = 128, HTB = HALF * BK * 2, STAGE_BYTES = 8 * HTB, NXCD = 8, WGM = 8;
DI int lds_byte(int r, int c) { const int st = (r >> 4) * 2 + (c >> 5), rr = r & 15, cc = c & 31, ob = rr * 64 + cc * 2; return st * 1024 + (ob ^ (((ob >> 9) & 1) << 5)); }
DI void stage_rc(int b, int& R, int& C) { const int st = b / 1024, sb = b % 1024, swz = sb ^ (((sb >> 9) & 1) << 5); R = (st >> 1) * 16 + swz / 64; C = (st & 1) * 32 + (swz % 64) / 2; }
DI int perm32(int rho) { const int n = rho >> 4, i = rho & 15; return 8 * (i >> 2) + 4 * n + (i & 3); }
DI void glds16_s(const char* sbase, unsigned voff, unsigned lds_dst) { unsigned keep;
    asm volatile("s_mov_b32 %0, m0\n\ts_mov_b32 m0, %3\n\ts_nop 0\n\tglobal_load_lds_dwordx4 %1, %2\n\ts_mov_b32 m0, %0" : "=&s"(keep) : "v"(voff), "s"(sbase), "s"(lds_dst) : "memory"); }
struct Unit { int pm, pn; };
struct StaticOrder {
    int nM, nN, nwg, G, c;
    DI void init(int M, int N, int G_, int c_) { nM = M / BM; nN = N / BM; nwg = nM * nN; G = G_; c = c_; }
    DI bool next(int i, Unit& u) const {
        const long L = (long)i * G + c; if (L >= nwg) return false;
        int wgid = (int)L; { const int q = nwg / NXCD, r = nwg % NXCD, xcd = wgid % NXCD, off = wgid / NXCD; wgid = (xcd < r ? xcd * (q + 1) : r * (q + 1) + (xcd - r) * q) + off; }
        const int nig = WGM * nN, gid = wgid / nig, fm = gid * WGM, gsz = (nM - fm) < WGM ? (nM - fm) : WGM;
        u.pm = fm + ((wgid % nig) % gsz); u.pn = (wgid % nig) / gsz; return true;
    }
};
template <class P>
DI void gemm_phase(LAS unsigned char* lds, const P& S, const int wave0) {
    const int tid = wave0 * 64 + lane_id_asm();
    const int wid = __builtin_amdgcn_readfirstlane(tid >> 6), lane = tid & 63, wr = wid >> 2, wc = wid & 3, fr = lane & 15, fq = lane >> 4;
    const int K = S.K, nt = K / BK;
    int Rr[2], Cc[2];
    unsigned voffB[2], vcur[2][2];
    const size_t hstep = (size_t)HALF * K * 2;
#pragma unroll
    for (int i = 0; i < 2; ++i) { stage_rc(tid * 16 + i * 8192, Rr[i], Cc[i]); const int Rb = P::PERM ? ((Rr[i] & ~31) + perm32(Rr[i] & 31)) : Rr[i];
        voffB[i] = (unsigned)(Rb * K + Cc[i]) * 2u; }
    const size_t kstep = (size_t)(BK * 2);
    const unsigned ldsw = (unsigned)wid * 1024u;
    const unsigned ldsbase = (unsigned)(size_t)lds;
    const int aoff = lds_byte(wr * 64 + fr, fq * 8); int boff = lds_byte(wc * 32 + fr, fq * 8) + 4 * HTB;
    asm volatile("" : "+v"(boff));
#define PG8_SA(b, h) (((b) * 2 + (h)) * HTB)
#define PG8_SB(b, h) ((4 + (b) * 2 + (h)) * HTB)
#define PG8_SBR(b, h) (((b) * 2 + (h)) * HTB)
#define PG8_STAGE(bufoff, gbase, voff) do { _Pragma("unroll") for (int _i = 0; _i < 2; ++_i) \
        glds16_s((const char*)(gbase), (voff)[_i], ldsbase + (unsigned)((bufoff) + _i * 8192) + ldsw); } while (0)
#define PG8_LDA(dst, b, h) do { _Pragma("unroll") for (int m = 0; m < 4; ++m) _Pragma("unroll") for (int k = 0; k < 2; ++k) dst[m][k] = *(const LAS bf16x8*)(lds + PG8_SA(b, h) + aoff + m * 2048 + k * 1024); } while (0)
#define PG8_LDB(dst, b, h) do { _Pragma("unroll") for (int n = 0; n < 2; ++n) _Pragma("unroll") for (int k = 0; k < 2; ++k) dst[n][k] = *(const LAS bf16x8*)(lds + boff + (PG8_SBR(b, h) + n * 2048 + k * 1024)); } while (0)
#define PG8_CAT(x) __builtin_bit_cast(v8i32, __builtin_shufflevector((x)[0], (x)[1], 0, 1, 2, 3, 4, 5, 6, 7, 8, 9, 10, 11, 12, 13, 14, 15))
#define PG8_MMA(ai, bj, At, Bt) do { __builtin_amdgcn_s_setprio(1); _Pragma("unroll") for (int m = 0; m < 4; ++m) _Pragma("unroll") for (int n = 0; n < 2; ++n) { \
        if constexpr (P::FP8) acc[ai][bj][m][n] = __builtin_amdgcn_mfma_scale_f32_16x16x128_f8f6f4(PG8_CAT(Bt[n]), PG8_CAT(At[m]), acc[ai][bj][m][n], 0, 0, 0, 0x7f7f7f7f, 0, 0x7f7f7f7f); \
        else { _Pragma("unroll") for (int k = 0; k < 2; ++k) acc[ai][bj][m][n] = __builtin_amdgcn_mfma_f32_16x16x32_bf16(Bt[n][k], At[m][k], acc[ai][bj][m][n], 0, 0, 0); } } \
        __builtin_amdgcn_s_setprio(0); } while (0)
#define PG8_A1(p) (P::GATHER ? (p) : (p) + hstep)
#define PG8_V1 vcur[P::GATHER ? 1 : 0]
#define PG8_WAIT_V(n) asm volatile("s_waitcnt vmcnt(" #n ")" ::: "memory")
#define PG8_WAIT_L(n) asm volatile("s_waitcnt lgkmcnt(" #n ")" ::: "memory")
#define PG8_BAR __builtin_amdgcn_s_barrier()
#define PG8_SCHED __builtin_amdgcn_sched_barrier(0)
    Unit cur, nxt; int ui = 0;
    if (!S.next(0, cur)) return;
#define PG8_AOFFS(dst, u) do { const int _t = wave0 * 64 + lane_id_asm(); _Pragma("unroll") for (int _i = 0; _i < 2; ++_i) { int _R, _C; stage_rc(_t * 16 + _i * 8192, _R, _C); \
        _Pragma("unroll") for (int _h = 0; _h < 2; ++_h) \
        dst[_h][_i] = P::GATHER ? (unsigned)(((size_t)S.gather_row(u, _h * HALF + _R) * K + _C) * 2u) : (unsigned)((size_t)(_R * K + _C) * 2u); } } while (0)
    PG8_AOFFS(vcur, cur);
    LAS u32x4* const gslot = (LAS u32x4*)(lds + (TABL_OFF + 6144)) + tid;
    f32x4 acc[2][2][4][2];
#pragma unroll
    for (int a = 0; a < 2; ++a)
#pragma unroll
        for (int b = 0; b < 2; ++b)
#pragma unroll
            for (int m = 0; m < 4; ++m)
#pragma unroll
                for (int n = 0; n < 2; ++n) acc[a][b][m][n] = (f32x4){0.f, 0.f, 0.f, 0.f};
    bf16x8 At[4][2], B0[2][2], B1[2][2];
    const char* cA = S.a_ptr(cur); const char* cB = S.b_ptr(cur);
    PG8_STAGE(PG8_SB(0, 0), cB, voffB); PG8_STAGE(PG8_SB(0, 1), cB + hstep, voffB); PG8_STAGE(PG8_SA(0, 0), cA, vcur[0]); PG8_STAGE(PG8_SA(0, 1), PG8_A1(cA), PG8_V1);
    if (wr == 1) PG8_BAR;
    PG8_WAIT_V(2); PG8_BAR;
    PG8_STAGE(PG8_SB(1, 0), cB + kstep, voffB); PG8_STAGE(PG8_SA(1, 0), cA + kstep, vcur[0]); PG8_STAGE(PG8_SB(1, 1), cB + hstep + kstep, voffB);
    PG8_WAIT_V(6); PG8_BAR;
    for (;;) {
        const bool has_next = S.next(ui + 1, nxt);
        const char* nA = has_next ? S.a_ptr(nxt) : cA; const char* nB = has_next ? S.b_ptr(nxt) : cB;
        if (P::GATHER) { if (has_next) { unsigned vn_[2][2]; PG8_AOFFS(vn_, nxt); *gslot = (u32x4){vn_[0][0], vn_[0][1], vn_[1][0], vn_[1][1]}; } }
        for (int t = 0; t < nt; t += 2) {
            const bool last = (t == nt - 2);
            const char* a1 = cA + (size_t)(t + 1) * kstep;
            const char* a2 = last ? nA : cA + (size_t)(t + 2) * kstep; const char* b2 = last ? nB : cB + (size_t)(t + 2) * kstep;
            const char* a3 = a2 + kstep; const char* b3 = b2 + kstep;
            PG8_LDB(B0, 0, 0); PG8_LDB(B1, 0, 1); PG8_SCHED; PG8_LDA(At, 0, 0); PG8_STAGE(PG8_SA(1, 1), PG8_A1(a1), PG8_V1);
            PG8_WAIT_V(8); PG8_WAIT_L(0); PG8_BAR; PG8_MMA(0, 0, At, B0); PG8_MMA(0, 1, At, B1); PG8_BAR; PG8_SCHED;
            if (P::GATHER) { if (last && has_next) { const u32x4 vn_ = *gslot; vcur[0][0] = vn_.x; vcur[0][1] = vn_.y; vcur[1][0] = vn_.z; vcur[1][1] = vn_.w; } }
            PG8_LDA(At, 0, 1); PG8_STAGE(PG8_SB(0, 0), b2, voffB); PG8_STAGE(PG8_SB(0, 1), b2 + hstep, voffB); PG8_STAGE(PG8_SA(0, 0), a2, vcur[0]);
            PG8_WAIT_V(8); PG8_WAIT_L(0); PG8_BAR; PG8_MMA(1, 0, At, B0); PG8_MMA(1, 1, At, B1); PG8_BAR; PG8_SCHED;
            PG8_LDB(B0, 1, 0); PG8_LDB(B1, 1, 1); PG8_SCHED; PG8_LDA(At, 1, 0); PG8_STAGE(PG8_SA(0, 1), PG8_A1(a2), PG8_V1);
            PG8_WAIT_V(8); PG8_WAIT_L(0); PG8_BAR; PG8_MMA(0, 0, At, B0); PG8_MMA(0, 1, At, B1); PG8_BAR; PG8_SCHED;
            PG8_LDA(At, 1, 1); PG8_STAGE(PG8_SB(1, 0), b3, voffB); PG8_STAGE(PG8_SB(1, 1), b3 + hstep, voffB); PG8_STAGE(PG8_SA(1, 0), a3, vcur[0]);
            PG8_WAIT_V(8); PG8_WAIT_L(0); PG8_BAR; PG8_MMA(1, 0, At, B0); PG8_MMA(1, 1, At, B1); PG8_BAR; PG8_SCHED;
        }
        if (wr == 0) PG8_BAR;
        PG8_SCHED;
        { const int l2 = lane_id_asm();
          S.epi(acc, cur, wave0 >> 2, wave0 & 3, l2 & 15, l2 >> 4); }
        if (!has_next) break;
#pragma unroll
        for (int a = 0; a < 2; ++a)
#pragma unroll
            for (int b = 0; b < 2; ++b)
#pragma unroll
                for (int m = 0; m < 4; ++m)
#pragma unroll
                    for (int n = 0; n < 2; ++n) acc[a][b][m][n] = (f32x4){0.f, 0.f, 0.f, 0.f};
        cur = nxt; cA = nA; cB = nB; ++ui;
        if (wr == 1) PG8_BAR;
    }
    PG8_WAIT_V(0);
    PG8_BAR;
#undef PG8_AOFFS
#undef PG8_SA
#undef PG8_SB
#undef PG8_SBR
#undef PG8_STAGE
#undef PG8_LDA
#undef PG8_LDB
#undef PG8_MMA
#undef PG8_CAT
#undef PG8_WAIT_V
#undef PG8_A1
#undef PG8_V1
#undef PG8_WAIT_L
#undef PG8_BAR
#undef PG8_SCHED
}
}
using pg8::Unit;
typedef f32x4 AccT[2][2][4][2];

struct Args {
    const float* x; const float* p; const float* w_in; const float* lb_logits; const float* hg_norm_w; const float* w_a; const float* w_h; const float* w_o;
    const float* ln1_w; const float* ln1_b; const float* router_w; const float* router_b; const float* ew_gate; const float* ew_up; const float* ew_down;
    const float* sw_gate; const float* sw_up; const float* sw_down; const float* w_pg; const float* w_pp; const float* ln2_w; const float* ln2_b;
    float* out; unsigned char* ws;
};
struct Frame { LAS unsigned char* lds; int tid, lane, wave, G, bid; };

#define LAMBDA_INL __attribute__((always_inline))
struct TrItem { const float* W; unsigned char* WT; int ldw, ldt, k0, n0, drow0, f8; };
DI void tr_load(const TrItem& d, int lane, float (&v)[32]) {
#pragma unroll
    for (int i = 0; i < 8; ++i) { const f32x4 q = __builtin_nontemporal_load((const f32x4*)(d.W + (size_t)(d.k0 + 8 * i + (lane >> 3)) * d.ldw + d.n0) + (lane & 7));
        v[4 * i] = q.x; v[4 * i + 1] = q.y; v[4 * i + 2] = q.z; v[4 * i + 3] = q.w; }
}
DI void tr_store(const TrItem& d, const float (&v)[32], LAS float* scr, int lane) {
#pragma unroll
    for (int i = 0; i < 8; ++i)
#pragma unroll
        for (int j = 0; j < 4; ++j) scr[(8 * i + (lane >> 3)) * 33 + 4 * (lane & 7) + j] = v[4 * i + j];
    asm volatile("s_waitcnt lgkmcnt(0)" ::: "memory");
    const int c = lane & 7;
#pragma unroll
    for (int j = 0; j < 4; ++j) { const int n = (lane >> 3) + 8 * j; const LAS float* s = scr + (8 * c) * 33 + n;
        if (d.f8) { u32x2 o; o.x = pk4_fp8(s[0 * 33] * W8S, s[1 * 33] * W8S, s[2 * 33] * W8S, s[3 * 33] * W8S); o.y = pk4_fp8(s[4 * 33] * W8S, s[5 * 33] * W8S, s[6 * 33] * W8S, s[7 * 33] * W8S);
            *(u32x2*)(d.WT + (size_t)(d.drow0 + n) * d.ldt + d.k0 + 8 * c) = o; }
        else { u32x4 o; o.x = pk2(s[0 * 33], s[1 * 33]); o.y = pk2(s[2 * 33], s[3 * 33]); o.z = pk2(s[4 * 33], s[5 * 33]); o.w = pk2(s[6 * 33], s[7 * 33]);
            *(u32x4*)((bf16*)d.WT + (size_t)(d.drow0 + n) * d.ldt + d.k0 + 8 * c) = o; } }
    asm volatile("s_waitcnt lgkmcnt(0)" ::: "memory");
}
DI TrItem tr_plain_item(const float* W, int N, void* WT, int ldt, int f8, int r) { const int nblk = N / 32, kb = r / nblk, nb = r % nblk; return TrItem{W, (unsigned char*)WT, N, ldt, 64 * kb, 32 * nb, 32 * nb, f8}; }
DI TrItem tr_gu_item(const float* Wg, const float* Wu, void* WT, int f8, int r) { const int which = r >> 7, rr = r & 127, kb = rr >> 3, nb = rr & 7, n0 = 32 * nb;
    return TrItem{which ? Wu : Wg, (unsigned char*)WT, 256, 1024, 64 * kb, n0, (n0 >> 7) * 256 + which * 128 + (n0 & 127), f8}; }
constexpr int I_WIN = 16 * (NIN / 32), I_WA = 8 * 32, I_WH = 16 * 32, I_WPP = 4 * 32, I_SGU = 256, I_SD = 4 * 32, I_WR = 16 * 2, I_EGU = 64 * 256;
constexpr int P0_NITEMS = I_WIN + I_WA + 3 * I_WH + I_WPP + I_SGU + I_SD + I_WR;
DI TrItem p0_item(const Args& a, int it) {
    unsigned char* ws = a.ws; int r = it;
    if (r < I_WIN) return tr_plain_item(a.w_in, NIN, ws + WS_WIN8, 1024, 1, r); r -= I_WIN;
    if (r < I_WA) return tr_plain_item(a.w_a, 1024, ws + WS_WA, 512, 1, r); r -= I_WA;
    if (r < I_WH) return tr_plain_item(a.w_h, 1024, ws + WS_WH, 1024, 1, r); r -= I_WH;
    if (r < I_WH) return tr_plain_item(a.w_o, 1024, ws + WS_WO, 1024, 1, r); r -= I_WH;
    if (r < I_WH) return tr_plain_item(a.w_pg, 1024, ws + WS_WPG, 1024, 1, r); r -= I_WH;
    if (r < I_WPP) return tr_plain_item(a.w_pp, 1024, ws + WS_WPP, 256, 0, r); r -= I_WPP;
    if (r < I_SGU) return tr_gu_item(a.sw_gate, a.sw_up, ws + WS_WSGU, 1, r); r -= I_SGU;
    if (r < I_SD) return tr_plain_item(a.sw_down, 1024, ws + WS_WSD, 256, 0, r); r -= I_SD;
    return tr_plain_item(a.router_w, 64, ws + WS_WRT, 1024, 0, r);
}
DI TrItem egu_item(const Args& a, int r) { unsigned char* ws = a.ws;
    const int e = r >> 8; return tr_gu_item(a.ew_gate + (size_t)e * 1024 * 256, a.ew_up + (size_t)e * 1024 * 256, ws + WS_WEGU8 + (size_t)e * 512 * 1024, 1, r & 255);
}
DI TrItem p8_item(const Args& a, unsigned char* wed, int it) { const int e = it >> 7; return tr_plain_item(a.ew_down + (size_t)e * 256 * 1024, 1024, wed + (size_t)e * 1024 * 256, 256, 1, it & 127); }
template <class ItemFn>
DI void tr_run(const Frame& F, int nitems, ItemFn item) {
    LAS float* scr = (LAS float*)(F.lds + F.wave * 16384);
    const int gw = F.bid * 8 + F.wave, NGW = F.G * 8;
    float va[32], vb[32]; TrItem da, db; int it = gw;
    if (it < nitems) { da = item(it); tr_load(da, F.lane, va); }
    for (; it < nitems; it += 2 * NGW) {
        const int it2 = it + NGW, it3 = it2 + NGW;
        if (it2 < nitems) { db = item(it2); tr_load(db, F.lane, vb); }
        tr_store(da, va, scr, F.lane);
        if (it3 < nitems) { da = item(it3); tr_load(da, F.lane, va); }
        if (it2 < nitems) tr_store(db, vb, scr, F.lane);
    }
}
DI void p0_prologue(const Frame& F, const Args& a) {
    tr_run(F, P0_NITEMS, [&](int it) LAMBDA_INL { return p0_item(a, it); });
    unsigned char* ws = a.ws; const int gw = F.bid * 8 + F.wave, NGW = F.G * 8;
    for (int m0 = gw * 4; m0 < T; m0 += NGW * 4) {
        f32x4 v[4][4];
#pragma unroll
        for (int q = 0; q < 4; ++q)
#pragma unroll
            for (int j = 0; j < 4; ++j) v[q][j] = __builtin_nontemporal_load((const f32x4*)(a.x + (size_t)(m0 + q) * D) + F.lane + 64 * j);
#pragma unroll
        for (int q = 0; q < 4; ++q) { unsigned* o4 = (unsigned*)(ws + WS_X8 + (size_t)(m0 + q) * D) + F.lane;
#pragma unroll
            for (int j = 0; j < 4; ++j) { const f32x4 w4 = v[q][j]; o4[64 * j] = pk4_fp8(w4.x, w4.y, w4.z, w4.w); } }
    }
}

struct DenseBase {
    static constexpr bool GATHER = false, FP8 = false;
    pg8::StaticOrder S; const char* A; const char* Bt; int K;
    DI void init(const void* A_, const void* Bt_, int M, int N, int K_, int G, int c) { A = (const char*)A_; Bt = (const char*)Bt_; K = K_; S.init(M, N, G, c); }
    DI bool next(int i, Unit& u) const { return S.next(i, u); }
    DI const char* a_ptr(const Unit& u) const { return A + (size_t)u.pm * 256 * K * 2; }
    DI const char* b_ptr(const Unit& u) const { return Bt + (size_t)u.pn * 256 * K * 2; }
    DI int gather_row(const Unit&, int) const { return 0; }
};
DI u32x4 pack_bf8(const f32x4& v0, const f32x4& v1) { u32x4 w; w.x = pk2(v0[0], v0[1]); w.y = pk2(v0[2], v0[3]); w.z = pk2(v1[0], v1[1]); w.w = pk2(v1[2], v1[3]); return w; }
DI void unpack_bf8(const u32x4& w, f32x4& v0, f32x4& v1) {
    v0 = (f32x4){bf2f(w.x & 0xffffu), bf2f(w.x >> 16), bf2f(w.y & 0xffffu), bf2f(w.y >> 16)};
    v1 = (f32x4){bf2f(w.z & 0xffffu), bf2f(w.z >> 16), bf2f(w.w & 0xffffu), bf2f(w.w >> 16)};
}
template <class Fn> DI void epi_walk(const AccT& acc, const Unit& u, int wr, int wc, int fr, int fq, Fn fn) {
#pragma unroll
    for (int ai = 0; ai < 2; ++ai)
#pragma unroll
        for (int m = 0; m < 4; ++m) { const int row = u.pm * 256 + ai * 128 + wr * 64 + m * 16 + fr;
#pragma unroll
            for (int bj = 0; bj < 2; ++bj) { const int col = u.pn * 256 + bj * 128 + wc * 32 + 8 * fq; fn(row, col, bj, acc[ai][bj][m][0], acc[ai][bj][m][1]); } }
}

template <class Op, class Ld, class Fn> DI void epi_walk_ld(const AccT& acc, const Unit& u, int wr, int wc, int fr, int fq, Ld ld, Fn fn) {
#pragma unroll
    for (int ai = 0; ai < 2; ++ai) {
        Op ops[4][2];
#pragma unroll
        for (int m = 0; m < 4; ++m)
#pragma unroll
            for (int bj = 0; bj < 2; ++bj) ops[m][bj] = ld(u.pm * 256 + ai * 128 + wr * 64 + m * 16 + fr, u.pn * 256 + bj * 128 + wc * 32 + 8 * fq);
#pragma unroll
        for (int m = 0; m < 4; ++m)
#pragma unroll
            for (int bj = 0; bj < 2; ++bj) fn(u.pm * 256 + ai * 128 + wr * 64 + m * 16 + fr, u.pn * 256 + bj * 128 + wc * 32 + 8 * fq, acc[ai][bj][m][0], acc[ai][bj][m][1], ops[m][bj]);
    }
}
constexpr int XR_RING = 3 * 16384, XR_TAIL = TABL_OFF + 6144;
constexpr int XL_UNITS = 10, XL_TOK = TABL_OFF + 6144 + 8192, XL_GATE = XL_TOK + XL_UNITS * 512;
static_assert(XL_GATE + XL_UNITS * 1024 <= LDS_BYTES && (MAXTILES + 127) / 128 <= XL_UNITS, "MoE list images");
template <class Fn> DI void epi_walk_rows(const AccT& acc, const Unit& u, int wr, int wc, int fr, int fq, LAS unsigned char* lds, bf16* O, int ldo, Fn fn) {
    const int tid = (wr * 4 + wc) * 64 + fq * 16 + fr, wrow = wr * 16 + fr, rl = tid >> 5;
    const int woff = wrow * 512 + (((wc * 4 + fq) ^ (wrow & 7)) << 4);
    const int roff = rl * 512 + ((tid & 31) << 4);
    bf16* gp = O + (size_t)(u.pm * 256 + rl) * ldo + u.pn * 256 + (((tid & 31) ^ (rl & 7)) << 3);
#pragma unroll
    for (int ai = 0; ai < 2; ++ai)
#pragma unroll
        for (int m = 0; m < 4; ++m) { LAS unsigned char* xb = lds + ((m & 1) ? XR_TAIL : XR_RING);
#pragma unroll
            for (int bj = 0; bj < 2; ++bj) *(LAS u32x4*)(xb + woff + bj * 256) = fn(u.pm * 256 + ai * 128 + wr * 64 + m * 16 + fr, u.pn * 256 + bj * 128 + wc * 32 + 8 * fq, bj, acc[ai][bj][m][0], acc[ai][bj][m][1]);
            asm volatile("s_waitcnt lgkmcnt(0)" ::: "memory"); __builtin_amdgcn_s_barrier(); asm volatile("" ::: "memory");
#pragma unroll
            for (int j = 0; j < 2; ++j) { const u32x4 v = *(const LAS u32x4*)(xb + roff + j * 8192); *(u32x4*)(gp + (size_t)(ai * 128 + m * 16 + j * 64) * ldo) = v; } }
}
struct ProbQKV : DenseBase { static constexpr bool PERM = true, FP8 = true; bf16* O; LAS unsigned char* xl;
    DI void epi(const AccT& acc, const Unit& u, int wr, int wc, int fr, int fq) const {
        const float sc = (u.pn < 6 ? QSCALE : 1.0f) * W8I; bf16* o = O;
        epi_walk_rows(acc, u, wr, wc, fr, fq, xl, o, NATT, [=](int, int, int, f32x4 v0, f32x4 v1) LAMBDA_INL { return pack_bf8(v0 * sc, v1 * sc); });
    } };
struct ProbHG : DenseBase { static constexpr bool PERM = true, FP8 = true; bf16* R2; bf16* gates; const float* lbl;
    DI void epi(const AccT& acc, const Unit& u, int wr, int wc, int fr, int fq) const {
        const int seg = u.pn >> 2; bf16* r2 = R2; bf16* gt = gates;
        if (seg == 0) { epi_walk(acc, u, wr, wc, fr, fq, [=](int row, int col, int, f32x4 v0, f32x4 v1) LAMBDA_INL { *((u32x4*)(r2 + (size_t)row * NHG + col)) = pack_bf8(v0 * W8I, v1 * W8I); }); }
        else if (seg == 1) {
            const float* lbp = lbl + (u.pn - 4) * 256 + wc * 32 + 8 * fq;
            float la[2][8];
#pragma unroll
            for (int bj = 0; bj < 2; ++bj) { const f32x4 a0 = *(const f32x4*)(lbp + bj * 128), a1 = *(const f32x4*)(lbp + bj * 128 + 4), b0 = *(const f32x4*)(lbp + 1024 + bj * 128), b1 = *(const f32x4*)(lbp + 1024 + bj * 128 + 4);
#pragma unroll
                for (int j = 0; j < 4; ++j) { la[bj][j] = __builtin_amdgcn_rcpf(1.0f + __expf(b0[j] - a0[j])); la[bj][4 + j] = __builtin_amdgcn_rcpf(1.0f + __expf(b1[j] - a1[j])); } }
            epi_walk(acc, u, wr, wc, fr, fq, [&](int row, int col, int bj, f32x4 v0, f32x4 v1) LAMBDA_INL {
#pragma unroll
                for (int j = 0; j < 4; ++j) { const float l0 = bj ? la[1][j] : la[0][j], l1 = bj ? la[1][4 + j] : la[0][4 + j];
                    v0[j] = __builtin_amdgcn_logf(l0 + (1.0f - l0) * sigmoidf_(v0[j] * W8I)) * LN2; v1[j] = __builtin_amdgcn_logf(l1 + (1.0f - l1) * sigmoidf_(v1[j] * W8I)) * LN2; }
                *((u32x4*)(r2 + (size_t)row * NHG + col)) = pack_bf8(v0, v1); });
        } else if (seg < 4) {
            epi_walk(acc, u, wr, wc, fr, fq, [=](int row, int col, int, f32x4 v0, f32x4 v1) LAMBDA_INL {
#pragma unroll
                for (int j = 0; j < 4; ++j) { v0[j] = siluf_(v0[j] * W8I); v1[j] = siluf_(v1[j] * W8I); }
                *((u32x4*)(r2 + (size_t)row * NHG + col)) = pack_bf8(v0, v1); });
        } else {
            epi_walk(acc, u, wr, wc, fr, fq, [=](int row, int col, int, f32x4 v0, f32x4 v1) LAMBDA_INL {
#pragma unroll
                for (int j = 0; j < 4; ++j) { v0[j] = sigmoidf_(v0[j] * W8I); v1[j] = sigmoidf_(v1[j] * W8I); }
                *((u32x4*)(gt + (size_t)row * NGATE + (col - 4096))) = pack_bf8(v0, v1); });
        }
    } };
struct ProbBrA : DenseBase { static constexpr bool PERM = true, FP8 = true; const bf16* gates; bf16* O;
    DI void epi(const AccT& acc, const Unit& u, int wr, int wc, int fr, int fq) const {
        const bf16* gt = gates; bf16* o = O;
        epi_walk_ld<u32x4>(acc, u, wr, wc, fr, fq, [=](int row, int col) LAMBDA_INL { return *(const u32x4*)(gt + (size_t)row * NGATE + col); },
            [=](int row, int col, f32x4 v0, f32x4 v1, u32x4 gw) LAMBDA_INL { f32x4 g0, g1; unpack_bf8(gw, g0, g1); *(u32x4*)(o + (size_t)row * D + col) = pack_bf8(v0 * g0 * W8I, v1 * g1 * W8I); });
    } };
constexpr float MGS = 8.0f;
struct ProbBrH : DenseBase { static constexpr bool PERM = true, FP8 = true; const bf16* gates; const bf16* M1; unsigned char* O;
    DI void epi(const AccT& acc, const Unit& u, int wr, int wc, int fr, int fq) const {
        const bf16* gt = gates; const bf16* m1 = M1; unsigned char* o = O;
        struct Op2 { u32x4 g, p; };
        epi_walk_ld<Op2>(acc, u, wr, wc, fr, fq, [=](int row, int col) LAMBDA_INL { return Op2{*(const u32x4*)(gt + (size_t)row * NGATE + 1024 + col), *(const u32x4*)(m1 + (size_t)row * D + col)}; },
            [=](int row, int col, f32x4 v0, f32x4 v1, Op2 w) LAMBDA_INL {
                f32x4 g0, g1, p0, p1; unpack_bf8(w.g, g0, g1); unpack_bf8(w.p, p0, p1);
                v0 = (v0 * g0 * W8I + p0) * MGS; v1 = (v1 * g1 * W8I + p1) * MGS;
                *(u32x2*)(o + (size_t)row * D + col) = (u32x2){pk4_fp8(v0[0], v0[1], v0[2], v0[3]), pk4_fp8(v1[0], v1[1], v1[2], v1[3])}; });
    } };
struct ProbWo : DenseBase { static constexpr bool PERM = true, FP8 = true; const float* x; bf16* O;
    DI void epi(const AccT& acc, const Unit& u, int wr, int wc, int fr, int fq) const {
        const float* xp = x; bf16* o = O;
        struct OpX { f32x4 a, b; };
        epi_walk_ld<OpX>(acc, u, wr, wc, fr, fq, [=](int row, int col) LAMBDA_INL { return OpX{*(const f32x4*)(xp + (size_t)row * D + col), *(const f32x4*)(xp + (size_t)row * D + col + 4)}; },
            [=](int row, int col, f32x4 v0, f32x4 v1, OpX w) LAMBDA_INL { *(u32x4*)(o + (size_t)row * D + col) = pack_bf8(w.a * ALPHA + v0 * (W8I / MGS), w.b * ALPHA + v1 * (W8I / MGS)); });
    } };
struct ProbPP : DenseBase { static constexpr bool PERM = true; bf16* O;
    DI void epi(const AccT& acc, const Unit& u, int wr, int wc, int fr, int fq) const { bf16* o = O;
        epi_walk(acc, u, wr, wc, fr, fq, [=](int row, int col, int, f32x4 v0, f32x4 v1) LAMBDA_INL { *(u32x4*)(o + (size_t)row * D + col) = pack_bf8(v0, v1); }); } };
struct ProbPG : DenseBase { static constexpr bool PERM = true, FP8 = true; bf16* O;
    DI void epi(const AccT& acc, const Unit& u, int wr, int wc, int fr, int fq) const { bf16* o = O;
        epi_walk_ld<u32x4>(acc, u, wr, wc, fr, fq, [=](int row, int col) LAMBDA_INL { return *(const u32x4*)(o + (size_t)row * D + col); },
            [=](int row, int col, f32x4 v0, f32x4 v1, u32x4 pw) LAMBDA_INL { f32x4 p0, p1; unpack_bf8(pw, p0, p1);
#pragma unroll
                for (int j = 0; j < 4; ++j) { v0[j] = sigmoidf_(v0[j] * W8I) * p0[j]; v1[j] = sigmoidf_(v1[j] * W8I) * p1[j]; }
                *(u32x4*)(o + (size_t)row * D + col) = pack_bf8(v0, v1); });
    } };
template <bool SCALED>
DI void epi_swiglu(const AccT& acc, bf16* O, int ldo, int row0, int hcol0, int wr, int wc, int fr, int fq) {
    const float cs = SCALED ? W8I : 1.0f;
#pragma unroll
    for (int ai = 0; ai < 2; ++ai)
#pragma unroll
        for (int m = 0; m < 4; ++m) { const int row = row0 + ai * 128 + wr * 64 + m * 16 + fr; f32x4 h0, h1;
#pragma unroll
            for (int j = 0; j < 4; ++j) { h0[j] = siluf_(acc[ai][0][m][0][j] * cs) * (acc[ai][1][m][0][j] * cs); h1[j] = siluf_(acc[ai][0][m][1][j] * cs) * (acc[ai][1][m][1][j] * cs); }
            *(u32x4*)(O + (size_t)row * ldo + hcol0 + wc * 32 + 8 * fq) = pack_bf8(h0, h1); }
}
DI void epi_swiglu_moe(const AccT& acc, unsigned char* O, const LAS float* gate, int row0, int hcol0, int wr, int wc, int fr, int fq) {
#pragma unroll
    for (int ai = 0; ai < 2; ++ai)
#pragma unroll
        for (int m = 0; m < 4; ++m) { const int lr = ai * 128 + wr * 64 + m * 16 + fr, row = row0 + lr; const float gs = gate[lr] * (HGS * W8I); f32x4 h0, h1;
#pragma unroll
            for (int j = 0; j < 4; ++j) { h0[j] = siluf_(acc[ai][0][m][0][j] * W8I) * (acc[ai][1][m][0][j] * gs); h1[j] = siluf_(acc[ai][0][m][1][j] * W8I) * (acc[ai][1][m][1][j] * gs); }
            *(u32x2*)(O + (size_t)row * 256 + hcol0 + wc * 32 + 8 * fq) = (u32x2){pk4_fp8(h0[0], h0[1], h0[2], h0[3]), pk4_fp8(h1[0], h1[1], h1[2], h1[3])}; }
}
struct ProbSGU : DenseBase { static constexpr bool PERM = true, FP8 = true; bf16* O;
    DI void epi(const AccT& acc, const Unit& u, int wr, int wc, int fr, int fq) const { epi_swiglu<true>(acc, O, 256, u.pm * 256, u.pn * 128, wr, wc, fr, fq); } };
struct ProbSD : DenseBase { static constexpr bool PERM = true; bf16* O; int rank, nlight;
    DI bool next(int i, Unit& u) const { if (rank < 0) return false; const int L = rank + i * nlight; if (L >= 512) return false; u.pm = L >> 2; u.pn = L & 3; return true; }
    DI void epi(const AccT& acc, const Unit& u, int wr, int wc, int fr, int fq) const {
        bf16* o = O;
        epi_walk_ld<u32x4>(acc, u, wr, wc, fr, fq, [=](int row, int col) LAMBDA_INL { return *(const u32x4*)(o + (size_t)row * D + col); },
            [=](int row, int col, f32x4 v0, f32x4 v1, u32x4 pw) LAMBDA_INL { f32x4 p0, p1; unpack_bf8(pw, p0, p1); *(u32x4*)(o + (size_t)row * D + col) = pack_bf8(v0 + p0, v1 + p1); });
    } };
struct ProbMoeUp { static constexpr bool PERM = true, GATHER = true, FP8 = true;
    const char* A; const char* Bt; int K; int ntiles, G, c; const LAS int* texp; const LAS unsigned short* ltok; const LAS float* lgate; unsigned char* H;
    DI bool next(int i, Unit& u) const { const int x = c & 7, sl = c >> 3; u.pm = i * 128 + (sl >> 1) * 8 + x; u.pn = sl & 1; return u.pm < ntiles; }
    DI const char* a_ptr(const Unit&) const { return A; }
    DI const char* b_ptr(const Unit& u) const { return Bt + ((size_t)__builtin_amdgcn_readfirstlane(texp[u.pm]) * 512 + (size_t)u.pn * 256) * 1024; }
    DI int gather_row(const Unit& u, int r) const { return (int)ltok[(u.pm >> 7) * 256 + r]; }
    DI void epi(const AccT& acc, const Unit& u, int wr, int wc, int fr, int fq) const { epi_swiglu_moe(acc, H, lgate + (u.pm >> 7) * 256, u.pm * 256, u.pn * 128, wr, wc, fr, fq); } };
constexpr int XPITCH = 272, XBUF = 32 * XPITCH;
struct ProbMoeDown { static constexpr bool PERM = true, GATHER = false, FP8 = true;
    const char* A; const char* Bt; static constexpr int K = 128; int ntiles, G, c; const LAS int* texp; unsigned char* Y; unsigned char* Y2;
    DI bool next(int i, Unit& u) const { const int x = c & 7, sl = c >> 3; u.pm = i * 64 + (sl >> 2) * 8 + x; u.pn = sl & 3; return u.pm < ntiles; }
    DI const char* a_ptr(const Unit& u) const { return A + (size_t)u.pm * 256 * 256; }
    DI const char* b_ptr(const Unit& u) const { return Bt + ((size_t)__builtin_amdgcn_readfirstlane(texp[u.pm]) * 1024 + (size_t)u.pn * 256) * 256; }
    DI int gather_row(const Unit&, int) const { return 0; }
    LAS unsigned char* xb;
    DI void epi(const AccT& acc, const Unit& u, int wr, int wc, int fr, int fq) const {
        unsigned char* y = (u.pm * 256 < YE_SPLIT ? Y : Y2 - (size_t)YE_SPLIT * D) + (size_t)u.pm * 256 * D + u.pn * 256;
        const int tid = (wr * 4 + wc) * 64 + fq * 16 + fr, rl = tid >> 4;
        LAS unsigned char* wp = xb + (wr * 16 + fr) * XPITCH + wc * 32 + 8 * fq;
        const LAS unsigned char* rp = xb + rl * XPITCH + (tid & 15) * 16;
        unsigned char* gp = y + (size_t)(64 * (rl >> 4) + (rl & 15)) * D + (tid & 15) * 16;
#pragma unroll
        for (int ai = 0; ai < 2; ++ai)
#pragma unroll
            for (int m = 0; m < 4; ++m) { const int bo = (m & 1) * XBUF;
#pragma unroll
                for (int bj = 0; bj < 2; ++bj) { const f32x4 v0 = acc[ai][bj][m][0], v1 = acc[ai][bj][m][1];
                    *(LAS u32x2*)(wp + bo + bj * 128) = (u32x2){pk4_fp8(v0[0], v0[1], v0[2], v0[3]), pk4_fp8(v1[0], v1[1], v1[2], v1[3])}; }
                asm volatile("s_waitcnt lgkmcnt(0)" ::: "memory"); __builtin_amdgcn_s_barrier(); asm volatile("" ::: "memory");
                const u32x4 v = *(const LAS u32x4*)(rp + bo);
                *(u32x4*)(gp + (size_t)(128 * ai + 16 * m) * D) = v; }
    } };

constexpr int VPITCH = 144;
constexpr int ATT_K = 0, ATT_V = 384 * VPITCH, ATT_O = 2 * 384 * VPITCH, ATT_O2 = TABL_OFF + 6144;
struct AttnU { int b, hd, g, r, rho, n0; };
DI AttnU attn_decode(int ui) {
    AttnU u; const int w16 = ui & 15; u.g = (ui >> 4) % 3; const int bh = (ui >> 4) / 3; u.hd = bh & 7; u.b = bh >> 3;
    u.r = u.g == 0 ? 1 : (u.g == 1 ? 4 : 16);
    u.rho = u.g == 0 ? 0 : (u.g == 1 ? (w16 & 3) : w16); const int pair = u.g == 0 ? w16 : (u.g == 1 ? (w16 >> 2) : 0);
    u.n0 = 256 * pair; return u;
}
DI void attn_load_kv(const bf16* qkv, const AttnU& u, int tid, u32x4 (&kreg)[6], u32x4 (&vreg)[6]) {
    const size_t tokb = (size_t)u.b * SEQ; const int colq = u.g * 512 + u.hd * 64;
#pragma unroll
    for (int i = 0; i < 6; ++i) { const int c = tid + 512 * i, row = c >> 3, ch = c & 7; int nk = u.n0 - 128 + row; nk = nk < 0 ? 0 : nk;
        const bf16* p = qkv + (tokb + (size_t)nk * u.r + u.rho) * NATT + colq + ch * 8;
        kreg[i] = *(const u32x4*)(p + 1536); vreg[i] = *(const u32x4*)(p + 3072); }
}
DI void attn_load_q(const bf16* qkv, const AttnU& u, int w, int l31, int hh, bf16x8 (&Qf)[4]) {
    const size_t tq = (size_t)u.b * SEQ + (size_t)(u.n0 + 32 * w + l31) * u.r + u.rho; const int colq = u.g * 512 + u.hd * 64;
#pragma unroll
    for (int s = 0; s < 4; ++s) Qf[s] = *(const bf16x8*)(qkv + tq * NATT + colq + 16 * s + 8 * hh);
}
DI void attn_phase(const Frame& F, const bf16* qkv, bf16* opart, float* lse) {
    LAS unsigned char* Kl = F.lds + ATT_K; LAS unsigned char* Vl = F.lds + ATT_V;
    const int lane = F.lane, l31 = lane & 31, hh = lane >> 5, w = F.wave;
    const int q4 = (lane & 15) >> 2, p4 = lane & 3, blk = (lane >> 4) & 1;
    constexpr int NU = NB * 8 * 3 * 16;
    if (F.bid >= NU) return;
    u32x4 kreg[6], vreg[6]; bf16x8 Qn[4];
    { const AttnU u0 = attn_decode(F.bid); attn_load_kv(qkv, u0, F.tid, kreg, vreg); attn_load_q(qkv, u0, w, l31, hh, Qn); }
    for (int ui = F.bid; ui < NU; ui += F.G) {
        const AttnU u = attn_decode(ui);
        const int r = u.r, n0 = u.n0, hd = u.hd;
        __syncthreads();
#pragma unroll
        for (int i = 0; i < 6; ++i) { const int c = F.tid + 512 * i, row = c >> 3, ch = c & 7;
            *(LAS u32x4*)(Kl + row * VPITCH + ch * 16) = kreg[i]; *(LAS u32x4*)(Vl + row * VPITCH + ch * 16) = vreg[i]; }
        bf16x8 Qf[4];
#pragma unroll
        for (int s = 0; s < 4; ++s) Qf[s] = Qn[s];
        __syncthreads();
        { const int un = ui + F.G < NU ? ui + F.G : ui; const AttnU u2 = attn_decode(un); attn_load_kv(qkv, u2, F.tid, kreg, vreg); attn_load_q(qkv, u2, w, l31, hh, Qn); }
        __builtin_amdgcn_sched_barrier(0);
        const int qq = 32 * w + l31; const size_t tq = (size_t)u.b * SEQ + (size_t)(n0 + qq) * r + u.rho;
        f32x16 sc[5];
        bf16x8 kf[2][4];
        { const LAS unsigned char* kr = Kl + (32 * w + l31) * VPITCH + 16 * hh;
#pragma unroll
          for (int s = 0; s < 4; ++s) kf[0][s] = *(const LAS bf16x8*)(kr + 32 * s); }
#pragma unroll
        for (int J = 0; J < 5; ++J) {
            if (J < 4) { const LAS unsigned char* kr = Kl + (32 * (w + J + 1) + l31) * VPITCH + 16 * hh;
#pragma unroll
                for (int s = 0; s < 4; ++s) kf[(J + 1) & 1][s] = *(const LAS bf16x8*)(kr + 32 * s); }
            f32x16 a;
#pragma unroll
            for (int i = 0; i < 16; ++i) a[i] = 0.f;
#pragma unroll
            for (int s = 0; s < 4; ++s) a = MFMA32(kf[J & 1][s], Qf[s], a);
            sc[J] = a;
            __builtin_amdgcn_sched_barrier(0);
        }
        const float slope2 = exp2f(-(float)(hd + 1)) * (float)r * LOG2E;
        int l31v = l31; asm volatile("" : "+v"(l31v));
        const int cb = 4 * hh;
        float nb[5]; bool tok[5];
#pragma unroll
        for (int J = 0; J < 5; ++J) { tok[J] = (n0 > 0) || (w + J >= 4); nb[J] = -slope2 * (float)(l31v + 128 - 32 * J - cb); }
        float mx = -3.0e38f;
#pragma unroll
        for (int J = 0; J < 5; ++J) {
            if (tok[J]) {
#pragma unroll
                for (int i = 0; i < 16; ++i) {
                    const int ci = (i & 3) + 8 * (i >> 2);
                    const float s2 = fmaf(slope2, (float)ci, sc[J][i] + nb[J]);
                    if (J == 0) mx = (ci + cb >= l31v) ? fmaxf(mx, s2) : mx;
                    else if (J == 4) mx = (ci + cb <= l31v) ? fmaxf(mx, s2) : mx;
                    else mx = fmaxf(mx, s2);
                }
            }
        }
        mx = xmax32(mx);
        float den = 0.f;
#pragma unroll
        for (int J = 0; J < 5; ++J) {
            if (tok[J]) {
                const float c2 = nb[J] - mx;
#pragma unroll
                for (int i = 0; i < 16; ++i) {
                    const int ci = (i & 3) + 8 * (i >> 2);
                    float pv = __builtin_amdgcn_exp2f(fmaf(slope2, (float)ci, sc[J][i] + c2));
                    if (J == 0) pv = (ci + cb >= l31v) ? pv : 0.f;
                    if (J == 4) pv = (ci + cb <= l31v) ? pv : 0.f;
                    sc[J][i] = pv; den += pv;
                }
            } else {
#pragma unroll
                for (int i = 0; i < 16; ++i) sc[J][i] = 0.f;
            }
        }
        den = xsum32(den);
        f32x16 o[2];
#pragma unroll
        for (int c = 0; c < 2; ++c)
#pragma unroll
            for (int i = 0; i < 16; ++i) o[c][i] = 0.f;
#pragma unroll
        for (int J = 0; J < 5; ++J) {
#pragma unroll
            for (int s = 0; s < 2; ++s) {
                const bf16x8 pf = pack8(sc[J], s);
#pragma unroll
                for (int c = 0; c < 2; ++c) {
                    const LAS unsigned char* vb = Vl + (32 * (w + J) + 16 * s + 4 * hh + q4) * VPITCH + (32 * c + 16 * blk + 4 * p4) * 2;
                    const bf16x8 vf = cat8(vtr(vb), vtr(vb + 8 * VPITCH));
                    o[c] = MFMA32(vf, pf, o[c]);
                }
            }
            __builtin_amdgcn_sched_barrier(0);
        }
        const float inv = __builtin_amdgcn_rcpf(den);
        LAS unsigned char* ob = F.lds + (w < 4 ? ATT_O + w * (32 * VPITCH) : ATT_O2 + (w - 4) * (32 * VPITCH));
#pragma unroll
        for (int c = 0; c < 2; ++c)
#pragma unroll
            for (int i4 = 0; i4 < 4; ++i4) {
                const int d0 = 32 * c + 8 * i4 + 4 * hh;
                *(LAS u32x2*)(ob + l31 * VPITCH + d0 * 2) = (u32x2){pk2(o[c][4 * i4] * inv, o[c][4 * i4 + 1] * inv), pk2(o[c][4 * i4 + 2] * inv, o[c][4 * i4 + 3] * inv)};
            }
        asm volatile("s_waitcnt lgkmcnt(0)" ::: "memory");
#pragma unroll
        for (int k = 0; k < 4; ++k) { const int q2 = (lane >> 3) + 8 * k;
            const u32x4 v = *(const LAS u32x4*)(ob + q2 * VPITCH + (lane & 7) * 16);
            const size_t tq2 = (size_t)u.b * SEQ + (size_t)(n0 + 32 * w + q2) * r + u.rho;
            *(u32x4*)(opart + ((size_t)u.g * T + tq2) * 512 + hd * 64 + (lane & 7) * 8) = v; }
        if (hh == 0) lse[((size_t)u.g * T + tq) * 8 + hd] = mx + __builtin_amdgcn_logf(den);
    }
}
DI void attn_mix_phase(const Frame& F, const bf16* opart, const float* lse, unsigned char* yatt) {
    const int gw = F.bid * 8 + F.wave, NGW = F.G * 8;
    for (int it = gw; it < T / 2; it += 2 * NGW) {
        const int c16 = F.lane & 31, hd = c16 >> 2;
        int tk[2]; float l[2][3]; u32x4 sv[2][3][2];
#pragma unroll
        for (int q = 0; q < 2; ++q) { tk[q] = 2 * (it + q * NGW) + (F.lane >> 5);
#pragma unroll
            for (int g = 0; g < 3; ++g) { l[q][g] = lse[((size_t)g * T + tk[q]) * 8 + hd]; const u32x4* src = (const u32x4*)(opart + ((size_t)g * T + tk[q]) * 512 + c16 * 16); sv[q][g][0] = src[0]; sv[q][g][1] = src[1]; } }
#pragma unroll
        for (int q = 0; q < 2; ++q) {
            const float m = fmaxf(fmaxf(l[q][0], l[q][1]), l[q][2]);
            float wsum = 0.f, wg[3];
#pragma unroll
            for (int g = 0; g < 3; ++g) { wg[g] = __builtin_amdgcn_exp2f(l[q][g] - m); wsum += wg[g]; }
            const float inv = __builtin_amdgcn_rcpf(wsum);
            f32x4 a0 = {0, 0, 0, 0}, a1 = a0, a2 = a0, a3 = a0;
#pragma unroll
            for (int g = 0; g < 3; ++g) { f32x4 v0, v1, v2, v3; unpack_bf8(sv[q][g][0], v0, v1); unpack_bf8(sv[q][g][1], v2, v3);
                const float ww = wg[g] * inv; a0 += v0 * ww; a1 += v1 * ww; a2 += v2 * ww; a3 += v3 * ww; }
            *(u32x4*)(yatt + (size_t)tk[q] * 512 + c16 * 16) = (u32x4){pk4_fp8(a0[0], a0[1], a0[2], a0[3]), pk4_fp8(a1[0], a1[1], a1[2], a1[3]), pk4_fp8(a2[0], a2[1], a2[2], a2[3]), pk4_fp8(a3[0], a3[1], a3[2], a3[3])};
        }
    }
}

constexpr int HP = 272;
constexpr int HG_QD = 0, HG_KI = 32 * HP, HG_KE = 2 * 32 * HP, HG_VV = 3 * 32 * HP, HG_DD = 4 * 32 * HP, HG_SSQ = HG_DD + 512, HG_TOT = HG_SSQ + 512, HG_Y = HG_TOT + 2048, HGY_P = 136, HG_HALF = HG_Y + 32 * HGY_P;
struct HgRaw { unsigned lfp[8], qp[8]; u32x4 v0, v1; };
DI void hgrn_load(const bf16* R2, size_t tok0, int hd, int cp, int sg, int tidh, HgRaw& w) {
    const bf16* src = R2 + (tok0 + 8 * sg) * NHG + hd * 128 + 2 * cp;
#pragma unroll
    for (int tt = 0; tt < 8; ++tt) { w.lfp[tt] = *(const unsigned*)(src + (size_t)tt * NHG + 1024); w.qp[tt] = *(const unsigned*)(src + (size_t)tt * NHG); }
    const int row = tidh >> 3, ch = tidh & 7; const bf16* vs = R2 + (tok0 + row) * NHG + 2048 + hd * 128;
    w.v0 = *(const u32x4*)(vs + ch * 8); w.v1 = *(const u32x4*)(vs + (ch + 8) * 8);
}
template <bool OUT>
DI void hgrn_phase(const Frame& F, const bf16* R2, float* Lst, float* Dtot, const float* gain, unsigned char* yhg) {
    const int hf = F.wave >> 2, wv = F.wave & 3, tidh = F.tid & 255, lane = F.lane, l31 = lane & 31, hh = lane >> 5;
    const int q4 = (lane & 15) >> 2, p4 = lane & 3, blk = (lane >> 4) & 1;
    LAS unsigned char* base = F.lds + hf * HG_HALF;
    const int cp = tidh & 63, sg = tidh >> 6;
    for (int it0 = F.bid * 2; it0 < 512; it0 += F.G * 2) {
        const int pr_ = it0 >> 1, bhd = pr_ >> 2, j = hf ? 7 - (pr_ & 3) : (pr_ & 3), item = bhd * 8 + j, hd = bhd & 7, b = bhd >> 3;
        const bool active = OUT || (j < 7);
        f32x16 S[4];
#pragma unroll
        for (int kb = 0; kb < 4; ++kb)
#pragma unroll
            for (int i = 0; i < 16; ++i) S[kb][i] = 0.f;
        if (OUT) {
            for (int i0 = 0; i0 < j; ++i0) {
                const float* Lp = Lst + (size_t)(bhd * 8 + i0) * 16384; const float* Dp = Dtot + (bhd * 8 + i0) * 128;
#pragma unroll
                for (int kb = 0; kb < 4; ++kb)
#pragma unroll
                    for (int i4 = 0; i4 < 4; ++i4) { const f32x4 dd = *(const f32x4*)(Dp + 32 * kb + 8 * i4 + 4 * hh);
#pragma unroll
                        for (int e = 0; e < 4; ++e) S[kb][4 * i4 + e] = S[kb][4 * i4 + e] * dd[e] + Lp[(32 * kb + 8 * i4 + 4 * hh + e) * 128 + 32 * wv + l31]; }
            }
        }
        float dsum0 = 0.f, dsum1 = 0.f;
        const size_t tokI = (size_t)b * SEQ + j * 512;
        HgRaw raw; hgrn_load(R2, tokI, hd, cp, sg, tidh, raw);
        for (int c = 0; c < 16; ++c) {
            const size_t tok0 = tokI + c * 32;
            float lf0[8], lf1[8], cs0[8], cs1[8];
            { float r0 = 0.f, r1 = 0.f;
#pragma unroll
              for (int tt = 0; tt < 8; ++tt) { lf0[tt] = bf2f(raw.lfp[tt] & 0xffffu); lf1[tt] = bf2f(raw.lfp[tt] >> 16); r0 += lf0[tt]; r1 += lf1[tt]; cs0[tt] = r0; cs1[tt] = r1; } }
            LAS float* tot = (LAS float*)(base + HG_TOT);
            *(LAS f32x2*)(tot + sg * 128 + 2 * cp) = (f32x2){cs0[7], cs1[7]};
            __syncthreads();
            if (OUT && c > 0) {
                const int row = tidh >> 3, ch = tidh & 7; const LAS unsigned char* yp = base + HG_Y + row * HGY_P + ch * 16;
                const u32x2 ya = *(const LAS u32x2*)yp, yb = *(const LAS u32x2*)(yp + 8);
                *(u32x4*)(yhg + (tok0 - 32 + row) * D + hd * 128 + ch * 16) = (u32x4){ya.x, ya.y, yb.x, yb.y}; }
            float off0 = 0.f, off1 = 0.f, bl0 = 0.f, bl1 = 0.f;
#pragma unroll
            for (int g2 = 0; g2 < 4; ++g2) { const f32x2 tv = *(const LAS f32x2*)(tot + g2 * 128 + 2 * cp); bl0 += tv.x; bl1 += tv.y; if (g2 < sg) { off0 += tv.x; off1 += tv.y; } }
#pragma unroll
            for (int tt = 0; tt < 8; ++tt) {
                const float bt0 = off0 + cs0[tt], bt1 = off1 + cs1[tt], e0 = __expf(bt0), e1 = __expf(bt1);
                const float key0 = 1.0f - __expf(lf0[tt]), key1 = 1.0f - __expf(lf1[tt]);
                const int t = 8 * sg + tt;
                *(LAS unsigned*)(base + HG_QD + t * HP + cp * 4) = pk2(bf2f(raw.qp[tt] & 0xffffu) * e0, bf2f(raw.qp[tt] >> 16) * e1);
                *(LAS unsigned*)(base + HG_KI + t * HP + cp * 4) = pk2(key0 * __expf(-bt0), key1 * __expf(-bt1));
                *(LAS unsigned*)(base + HG_KE + t * HP + cp * 4) = pk2(key0 * __expf(bl0 - bt0), key1 * __expf(bl1 - bt1));
            }
            { const int row = tidh >> 3, ch = tidh & 7;
              *(LAS u32x4*)(base + HG_VV + row * HP + ch * 16) = raw.v0; *(LAS u32x4*)(base + HG_VV + row * HP + (ch + 8) * 16) = raw.v1; }
            if (sg == 0) { *(LAS f32x2*)(base + HG_DD + cp * 8) = (f32x2){__expf(bl0), __expf(bl1)}; dsum0 += bl0; dsum1 += bl1; }
            __syncthreads();
            if (c < 15) hgrn_load(R2, tok0 + 32, hd, cp, sg, tidh, raw);
            u32x2 sgv[4];
            if (OUT) {
#pragma unroll
                for (int i4 = 0; i4 < 4; ++i4) sgv[i4] = *(const u32x2*)(R2 + (tok0 + l31) * NHG + 3072 + hd * 128 + 32 * wv + 8 * i4 + 4 * hh);
            }
            __builtin_amdgcn_sched_barrier(0);
            f32x16 o;
            if (OUT) {
                f32x16 X;
#pragma unroll
                for (int i = 0; i < 16; ++i) X[i] = 0.f;
#pragma unroll
                for (int s2 = 0; s2 < 8; ++s2) {
                    const bf16x8 af = *(const LAS bf16x8*)(base + HG_KI + l31 * HP + (16 * s2 + 8 * hh) * 2);
                    const bf16x8 bfr = *(const LAS bf16x8*)(base + HG_QD + l31 * HP + (16 * s2 + 8 * hh) * 2);
                    X = MFMA32(af, bfr, X);
                }
                int l31v = l31; asm volatile("" : "+v"(l31v));
#pragma unroll
                for (int i = 0; i < 16; ++i) X[i] = (crow(i, hh) <= l31v) ? X[i] : 0.f;
#pragma unroll
                for (int i = 0; i < 16; ++i) o[i] = 0.f;
#pragma unroll
                for (int s2 = 0; s2 < 2; ++s2) {
                    const LAS unsigned char* vb = base + HG_VV + (16 * s2 + 4 * hh + q4) * HP + (32 * wv + 16 * blk + 4 * p4) * 2;
                    const bf16x8 vf = cat8(vtr(vb), vtr(vb + 8 * HP));
                    o = MFMA32(vf, pack8(X, s2), o);
                }
#pragma unroll
                for (int kb = 0; kb < 4; ++kb)
#pragma unroll
                    for (int s2 = 0; s2 < 2; ++s2) {
                        const LAS unsigned char* qb = base + HG_QD + l31 * HP + (32 * kb + 16 * s2 + 4 * hh) * 2;
                        const bf16x8 qf = cat8(*(const LAS s16x4*)qb, *(const LAS s16x4*)(qb + 16));
                        o = MFMA32(pack8(S[kb], s2), qf, o);
                    }
            }
            if (active) {
#pragma unroll
                for (int kb = 0; kb < 4; ++kb) {
#pragma unroll
                    for (int i4 = 0; i4 < 4; ++i4) { const f32x4 dv = *(const LAS f32x4*)(base + HG_DD + (32 * kb + 8 * i4 + 4 * hh) * 4);
#pragma unroll
                        for (int e = 0; e < 4; ++e) S[kb][4 * i4 + e] *= dv[e]; }
#pragma unroll
                    for (int s2 = 0; s2 < 2; ++s2) {
                        const LAS unsigned char* kb_ = base + HG_KE + (16 * s2 + 8 * hh + q4) * HP + (32 * kb + 16 * blk + 4 * p4) * 2;
                        const LAS unsigned char* vb = base + HG_VV + (16 * s2 + 8 * hh + q4) * HP + (32 * wv + 16 * blk + 4 * p4) * 2;
                        const bf16x8 kf = cat8(vtr(kb_), vtr(kb_ + 4 * HP));
                        const bf16x8 vf = cat8(vtr(vb), vtr(vb + 4 * HP));
                        S[kb] = MFMA32(kf, vf, S[kb]);
                    }
                }
            }
            if (OUT) {
                float ss = 0.f;
#pragma unroll
                for (int i = 0; i < 16; ++i) ss += o[i] * o[i];
                ss = xsum32(ss);
                LAS float* ssq = (LAS float*)(base + HG_SSQ);
                if (hh == 0) ssq[wv * 32 + l31] = ss;
                __syncthreads();
                const float tot2 = ssq[l31] + ssq[32 + l31] + ssq[64 + l31] + ssq[96 + l31];
                const float rinv = rsqrtf(tot2 * (1.0f / 128.0f) + RMS_EPS);
                const size_t tk = tok0 + l31;
#pragma unroll
                for (int i4 = 0; i4 < 4; ++i4) {
                    const int dv0 = 32 * wv + 8 * i4 + 4 * hh;
                    const f32x4 gn = *(const f32x4*)(gain + hd * 128 + dv0);
                    const u32x2 sgg = sgv[i4];
                    const float y0 = o[4 * i4] * rinv * gn[0] * bf2f(sgg.x & 0xffffu), y1 = o[4 * i4 + 1] * rinv * gn[1] * bf2f(sgg.x >> 16);
                    const float y2 = o[4 * i4 + 2] * rinv * gn[2] * bf2f(sgg.y & 0xffffu), y3 = o[4 * i4 + 3] * rinv * gn[3] * bf2f(sgg.y >> 16);
                    *(LAS unsigned*)(base + HG_Y + l31 * HGY_P + dv0) = pk4_fp8(y0, y1, y2, y3);
                }
            }
        }
        if (!OUT && active) {
            float* Lp = Lst + (size_t)item * 16384;
#pragma unroll
            for (int kb = 0; kb < 4; ++kb)
#pragma unroll
                for (int i = 0; i < 16; ++i) Lp[(32 * kb + crow(i, hh)) * 128 + 32 * wv + l31] = S[kb][i];
            if (sg == 0) *(f32x2*)(Dtot + item * 128 + 2 * cp) = (f32x2){__expf(dsum0), __expf(dsum1)};
        }
        __syncthreads();
        if (OUT) { const int row = tidh >> 3, ch = tidh & 7; const LAS unsigned char* yp = base + HG_Y + row * HGY_P + ch * 16;
            const u32x2 ya = *(const LAS u32x2*)yp, yb = *(const LAS u32x2*)(yp + 8);
            *(u32x4*)(yhg + ((size_t)b * SEQ + j * 512 + 15 * 32 + row) * D + hd * 128 + ch * 16) = (u32x4){ya.x, ya.y, yb.x, yb.y}; }
    }
}

constexpr int H1_KE = 0, H1_VV = 64 * HP, H1_DD = 2 * 64 * HP, H1_TOT = H1_DD + 512, H1_HALF = H1_TOT + 2048;
struct Hg1Raw { unsigned lfp[16]; u32x4 v[4]; };
DI void hgrn1_load(const bf16* R2, size_t tok0, int hd, int cp, int sg, int tidh, Hg1Raw& w) {
    const bf16* src = R2 + (tok0 + 16 * sg) * NHG + hd * 128 + 1024 + 2 * cp;
#pragma unroll
    for (int tt = 0; tt < 16; ++tt) w.lfp[tt] = *(const unsigned*)(src + (size_t)tt * NHG);
#pragma unroll
    for (int i = 0; i < 4; ++i) { const int id = tidh + 256 * i, row = id >> 4, ch = id & 15; w.v[i] = *(const u32x4*)(R2 + (tok0 + row) * NHG + 2048 + hd * 128 + ch * 8); }
}
DI void hgrn_l1_phase(const Frame& F, const bf16* R2, float* Lst, float* Dtot) {
    const int hf = F.wave >> 2, wv = F.wave & 3, tidh = F.tid & 255, lane = F.lane, l31 = lane & 31, hh = lane >> 5;
    const int q4 = (lane & 15) >> 2, p4 = lane & 3, blk = (lane >> 4) & 1;
    LAS unsigned char* base = F.lds + hf * H1_HALF;
    const int cp = tidh & 63, sg = tidh >> 6;
    for (int it0 = F.bid * 2; it0 < 512; it0 += F.G * 2) {
        const int item = it0 + hf, j = item & 7, bhd = item >> 3, hd = bhd & 7, b = bhd >> 3;
        const bool active = j < 7;
        f32x16 S[4];
#pragma unroll
        for (int kb = 0; kb < 4; ++kb)
#pragma unroll
            for (int i = 0; i < 16; ++i) S[kb][i] = 0.f;
        float dsum0 = 0.f, dsum1 = 0.f;
        const size_t tokI = (size_t)b * SEQ + j * 512;
        Hg1Raw raw; hgrn1_load(R2, tokI, hd, cp, sg, tidh, raw);
        for (int c = 0; c < 8; ++c) {
            float lf0[16], lf1[16], cs0[16], cs1[16];
            { float r0 = 0.f, r1 = 0.f;
#pragma unroll
              for (int tt = 0; tt < 16; ++tt) { lf0[tt] = bf2f(raw.lfp[tt] & 0xffffu); lf1[tt] = bf2f(raw.lfp[tt] >> 16); r0 += lf0[tt]; r1 += lf1[tt]; cs0[tt] = r0; cs1[tt] = r1; } }
            LAS float* tot = (LAS float*)(base + H1_TOT);
            *(LAS f32x2*)(tot + sg * 128 + 2 * cp) = (f32x2){cs0[15], cs1[15]};
            __syncthreads();
            float off0 = 0.f, off1 = 0.f, bl0 = 0.f, bl1 = 0.f;
#pragma unroll
            for (int g2 = 0; g2 < 4; ++g2) { const f32x2 tv = *(const LAS f32x2*)(tot + g2 * 128 + 2 * cp); bl0 += tv.x; bl1 += tv.y; if (g2 < sg) { off0 += tv.x; off1 += tv.y; } }
#pragma unroll
            for (int tt = 0; tt < 16; ++tt) {
                const float key0 = 1.0f - __expf(lf0[tt]), key1 = 1.0f - __expf(lf1[tt]);
                *(LAS unsigned*)(base + H1_KE + (16 * sg + tt) * HP + cp * 4) = pk2(key0 * __expf(bl0 - off0 - cs0[tt]), key1 * __expf(bl1 - off1 - cs1[tt]));
            }
#pragma unroll
            for (int i = 0; i < 4; ++i) { const int id = tidh + 256 * i, row = id >> 4, ch = id & 15; *(LAS u32x4*)(base + H1_VV + row * HP + ch * 16) = raw.v[i]; }
            if (sg == 0) { *(LAS f32x2*)(base + H1_DD + cp * 8) = (f32x2){__expf(bl0), __expf(bl1)}; dsum0 += bl0; dsum1 += bl1; }
            __syncthreads();
            if (c < 7) hgrn1_load(R2, tokI + 64 * (c + 1), hd, cp, sg, tidh, raw);
            __builtin_amdgcn_sched_barrier(0);
            if (active) {
#pragma unroll
                for (int kb = 0; kb < 4; ++kb) {
#pragma unroll
                    for (int i4 = 0; i4 < 4; ++i4) { const f32x4 dv = *(const LAS f32x4*)(base + H1_DD + (32 * kb + 8 * i4 + 4 * hh) * 4);
#pragma unroll
                        for (int e = 0; e < 4; ++e) S[kb][4 * i4 + e] *= dv[e]; }
#pragma unroll
                    for (int s2 = 0; s2 < 4; ++s2) {
                        const LAS unsigned char* kb_ = base + H1_KE + (16 * s2 + 8 * hh + q4) * HP + (32 * kb + 16 * blk + 4 * p4) * 2;
                        const LAS unsigned char* vb = base + H1_VV + (16 * s2 + 8 * hh + q4) * HP + (32 * wv + 16 * blk + 4 * p4) * 2;
                        S[kb] = MFMA32(cat8(vtr(kb_), vtr(kb_ + 4 * HP)), cat8(vtr(vb), vtr(vb + 4 * HP)), S[kb]);
                    }
                }
            }
        }
        if (active) {
            float* Lp = Lst + (size_t)item * 16384;
#pragma unroll
            for (int kb = 0; kb < 4; ++kb)
#pragma unroll
                for (int i = 0; i < 16; ++i) Lp[(32 * kb + crow(i, hh)) * 128 + 32 * wv + l31] = S[kb][i];
            if (sg == 0) *(f32x2*)(Dtot + item * 128 + 2 * cp) = (f32x2){__expf(dsum0), __expf(dsum1)};
        }
        __syncthreads();
    }
}

DI void ln_router_phase(const Frame& F, const Args& a, const bf16* pre1, bf16* x1b, unsigned char* x18, const bf16* wrt, int* tok_e, float* tok_g, unsigned* cnt_tbl) {
    constexpr int XP = 2048 + 16;
    LAS unsigned char* XS = F.lds; LAS float* LG = (LAS float*)(F.lds + 32 * XP);
    LAS unsigned* hist = (LAS unsigned*)(F.lds + TABL_OFF);
    const int lane = F.lane, w = F.wave, mt = w >> 2, nt = w & 3, l15 = lane & 15, lq = lane >> 4;
    if (F.tid < 64) hist[F.tid] = 0u;
    bf16x8 Bf[32];
    { const bf16* wp = wrt + (size_t)(16 * nt + l15) * 1024 + 8 * lq;
#pragma unroll
      for (int s2 = 0; s2 < 32; ++s2) Bf[s2] = *(const bf16x8*)(wp + 32 * s2); }
    const float rbias = a.router_b[lane];
    u32x2 pfr[4][4];
#pragma unroll
    for (int r = 0; r < 4; ++r)
#pragma unroll
        for (int j = 0; j < 4; ++j) pfr[r][j] = *((const u32x2*)(pre1 + (size_t)(F.bid * 128 + w * 4 + r) * D) + lane + 64 * j);
    for (int bt = 0; bt < 4; ++bt) {
        const int rowb = F.bid * 128 + bt * 32;
        __syncthreads();
#pragma unroll
        for (int r = 0; r < 4; ++r) {
            const int lr = w * 4 + r;
            f32x4 v[4]; float sm = 0.f;
#pragma unroll
            for (int j = 0; j < 4; ++j) { const u32x2 pv = pfr[r][j]; v[j] = (f32x4){bf2f(pv.x & 0xffffu), bf2f(pv.x >> 16), bf2f(pv.y & 0xffffu), bf2f(pv.y >> 16)}; sm += (v[j].x + v[j].y) + (v[j].z + v[j].w); }
            const float mean = wave_sum_sw(sm) * (1.f / D); float s2 = 0.f;
#pragma unroll
            for (int j = 0; j < 4; ++j) { v[j] = v[j] - mean; s2 += (v[j].x * v[j].x + v[j].y * v[j].y) + (v[j].z * v[j].z + v[j].w * v[j].w); }
            const float rstd = rsqrtf(wave_sum_sw(s2) * (1.f / D) + LN_EPS);
            u32x2* o8 = (u32x2*)(x1b + (size_t)(rowb + lr) * D) + lane; unsigned* o4 = (unsigned*)(x18 + (size_t)(rowb + lr) * D) + lane;
#pragma unroll
            for (int j = 0; j < 4; ++j) {
                const f32x4 w4 = *((const f32x4*)a.ln1_w + lane + 64 * j), b4 = *((const f32x4*)a.ln1_b + lane + 64 * j);
                const f32x4 y = v[j] * rstd * w4 + b4;
                const u32x2 yb = (u32x2){pk2(y.x, y.y), pk2(y.z, y.w)};
                o8[64 * j] = yb; o4[64 * j] = pk4_fp8(y.x, y.y, y.z, y.w);
                *(LAS u32x2*)(XS + lr * XP + (lane + 64 * j) * 8) = yb;
            }
        }
        __syncthreads();
        if (bt < 3) {
#pragma unroll
            for (int r = 0; r < 4; ++r)
#pragma unroll
                for (int j = 0; j < 4; ++j) pfr[r][j] = *((const u32x2*)(pre1 + (size_t)(rowb + 32 + w * 4 + r) * D) + lane + 64 * j);
        }
        f32x4 acc = {0.f, 0.f, 0.f, 0.f};
        { const LAS unsigned char* ap = XS + (16 * mt + l15) * XP + 16 * lq;
#pragma unroll
          for (int s2 = 0; s2 < 32; ++s2) acc = __builtin_amdgcn_mfma_f32_16x16x32_bf16(*(const LAS bf16x8*)(ap + 64 * s2), Bf[s2], acc, 0, 0, 0); }
#pragma unroll
        for (int i = 0; i < 4; ++i) LG[(16 * mt + 4 * lq + i) * 64 + 16 * nt + l15] = acc[i];
        __syncthreads();
#pragma unroll
        for (int r = 0; r < 4; ++r) {
            const int lr = w * 4 + r; const float lgt = LG[lr * 64 + lane];
            const float sgm = sigmoidf_(lgt), sel = sgm + rbias;
            float m1 = sel;
            m1 = grp8_max(m1);
            const unsigned long long eqm = __ballot(sel == m1);
            const unsigned grpbits = (unsigned)((eqm >> (lane & 56)) & 0xffull);
            const int first = __builtin_ctz(grpbits) + (lane & 56);
            float m2 = (lane == first) ? -3.0e38f : sel;
            m2 = grp8_max(m2);
            const float gs = m1 + m2;
            int grank = 0;
#pragma unroll
            for (int g2 = 0; g2 < 8; ++g2) { const float og = __builtin_bit_cast(float, __builtin_amdgcn_readlane(__builtin_bit_cast(int, gs), 8 * g2));
                grank += (og > gs || (og == gs && g2 < (lane >> 3))) ? 1 : 0; }
            const bool gsel = grank < 4;
            const unsigned ub = __builtin_bit_cast(unsigned, sel);
            const unsigned key = gsel ? (ub ^ ((ub >> 31) ? 0xFFFFFFFFu : 0x80000000u)) : 0u;
            unsigned thr = 0u;
#pragma unroll
            for (int bit = 31; bit >= 0; --bit) { const unsigned trial = thr | (1u << bit); thr = (__builtin_popcountll(__ballot(key >= trial)) >= 8) ? trial : thr; }
            const unsigned long long gtm = __ballot(key > thr), eqm2 = __ballot(key == thr), below = (1ull << lane) - 1ull;
            const int need = 8 - __builtin_popcountll(gtm);
            const bool chosen = (key > thr) || (key == thr && __builtin_popcountll(eqm2 & below) < need);
            const int rank = __builtin_popcountll(__ballot(chosen) & below);
            const float ssum = wave_sum(chosen ? sgm : 0.f);
            if (chosen) {
                const size_t o = (size_t)(rowb + lr) * 8 + rank;
                tok_e[o] = lane; tok_g[o] = sgm * __builtin_amdgcn_rcpf(ssum) * 2.5f;
                __hip_atomic_fetch_add(hist + lane, 1u, __ATOMIC_RELAXED, __HIP_MEMORY_SCOPE_WORKGROUP);
            }
        }
    }
    __syncthreads();
    if (F.tid < 64) cnt_tbl[F.bid * 64 + F.tid] = hist[F.tid];
}
DI void p8_convert(const Frame& F, const Args& a, unsigned char* wed, bf16* pb) {
    tr_run(F, 64 * 128, [&](int it) LAMBDA_INL { return p8_item(a, wed, it); });
    const int gw = F.bid * 8 + F.wave, NGW = F.G * 8;
    for (int m0 = gw * 8; m0 < T; m0 += NGW * 8) { f32x4 v[8];
#pragma unroll
        for (int q = 0; q < 8; ++q) v[q] = *((const f32x4*)(a.p + (size_t)(m0 + q) * 256) + F.lane);
#pragma unroll
        for (int q = 0; q < 8; ++q) *((u32x2*)(pb + (size_t)(m0 + q) * 256) + F.lane) = (u32x2){pk2(v[q].x, v[q].y), pk2(v[q].z, v[q].w)}; }
}
DI void scatter_phase(const Frame& F, const unsigned* cnt_tbl, const int* tok_e, const float* tok_g, int* pos_of, int* tok_list, float* gate_list, unsigned* tabw) {
    LAS unsigned* part = (LAS unsigned*)(F.lds);
    LAS unsigned* cur = (LAS unsigned*)(F.lds + 8192);
    LAS unsigned* segs = (LAS unsigned*)(F.lds + 8192 + 256);
    constexpr int WPB = 256 / NBLK, WPP = WPB / 8;
    const int w = F.bid, blk = w / WPB, wl = w % WPB, e = F.tid & 63, part_i = F.tid >> 6;
    __syncthreads();
    { unsigned tot = 0, below = 0;
      for (int q = 0; q < WPP; ++q) { const int w2 = part_i * WPP + q; const unsigned c = cnt_tbl[(blk * WPB + w2) * 64 + e]; tot += c; below += (w2 < wl) ? c : 0u; }
      part[part_i * 64 + e] = tot; part[512 + part_i * 64 + e] = below; }
    __syncthreads();
    if (F.tid < 64) { unsigned tot = 0, below = 0;
        for (int q = 0; q < 8; ++q) { tot += part[q * 64 + e]; below += part[512 + q * 64 + e]; }
        const int nt_ = (int)((tot + 255u) >> 8); int inc_ = nt_;
        inc_ += __builtin_amdgcn_update_dpp(0, inc_, 0x111, 0xf, 0xf, true); inc_ += __builtin_amdgcn_update_dpp(0, inc_, 0x112, 0xf, 0xf, true);
        inc_ += __builtin_amdgcn_update_dpp(0, inc_, 0x114, 0xf, 0xf, true); inc_ += __builtin_amdgcn_update_dpp(0, inc_, 0x118, 0xf, 0xf, true);
        inc_ += __builtin_amdgcn_update_dpp(0, inc_, 0x142, 0xa, 0xf, false); inc_ += __builtin_amdgcn_update_dpp(0, inc_, 0x143, 0xc, 0xf, false);
        const unsigned st_ = (unsigned)(inc_ - nt_) * 256u;
        segs[e] = st_; segs[64 + e] = tot; segs[128 + e] = (unsigned)nt_; cur[e] = below + st_; if (e == 63) segs[192] = (unsigned)inc_; }
    __syncthreads();
    int* tl = tok_list + (size_t)blk * MAXROWS; float* gl = gate_list + (size_t)blk * MAXROWS;
    for (int i = F.tid; i < 128 * 8; i += 512) {
        const int tk = w * 128 + (i >> 3); const int ex = tok_e[(size_t)tk * 8 + (i & 7)];
        const unsigned pos = __hip_atomic_fetch_add(cur + ex, 1u, __ATOMIC_RELAXED, __HIP_MEMORY_SCOPE_WORKGROUP);
        tl[pos] = tk; gl[pos] = tok_g[(size_t)tk * 8 + (i & 7)]; pos_of[(size_t)tk * 8 + (i & 7)] = (int)pos;
    }
    if (wl < 64) { const unsigned st = segs[wl] + segs[64 + wl], en = segs[wl] + segs[128 + wl] * 256u;
      for (unsigned pz = st + F.tid; pz < en; pz += 512) { tl[pz] = blk * TB; gl[pz] = 0.f; } }
    if (wl == 0) {
        if (F.tid == 0) tabw[TB_NT + blk * 64] = segs[192];
        if (F.tid < 64) { const unsigned t0 = segs[e] >> 8, nt_ = segs[128 + e]; for (unsigned q = 0; q < nt_; ++q) tabw[TB_TEXP + blk * MAXTILES + t0 + q] = (unsigned)e; }
    }
}
struct CombHdr { int pos[8]; u32x2 xv[4], dv[4]; };
DI void comb_load_hdr(CombHdr& h, size_t tk, const bf16* x1b, const bf16* dense, const int* pos_of, int lane) {
#pragma unroll
    for (int k = 0; k < 8; ++k) h.pos[k] = pos_of[tk * 8 + k];
#pragma unroll
    for (int j = 0; j < 4; ++j) { h.xv[j] = *((const u32x2*)(x1b + tk * D) + lane + 64 * j); h.dv[j] = *((const u32x2*)(dense + tk * D) + lane + 64 * j); }
}
DI void combine_phase(const Frame& F, const Args& a, int blk, const bf16* x1b, const bf16* dense, const unsigned char* ye, const unsigned char* ye2, const int* pos_of) {
    const int gw = F.bid * 8 + F.wave, NGW = F.G * 8, lane = F.lane;
    CombHdr h[2];
    if (gw < TB) { comb_load_hdr(h[0], (size_t)blk * TB + gw, x1b, dense, pos_of, lane); comb_load_hdr(h[1], (size_t)blk * TB + gw + NGW, x1b, dense, pos_of, lane); }
    for (int it = gw; it < TB; it += 2 * NGW) {
        unsigned yv[2][8][4];
#pragma unroll
        for (int q = 0; q < 2; ++q)
#pragma unroll
            for (int k = 0; k < 8; ++k) { const int p = h[q].pos[k]; const unsigned char* yr = p < YE_SPLIT ? ye + (size_t)p * D : ye2 + (size_t)(p - YE_SPLIT) * D;
#pragma unroll
                for (int j = 0; j < 4; ++j) yv[q][k][j] = *((const unsigned*)yr + lane + 64 * j); }
        f32x4 v[2][4];
#pragma unroll
        for (int q = 0; q < 2; ++q)
#pragma unroll
            for (int j = 0; j < 4; ++j) { const u32x2 xv = h[q].xv[j], dv = h[q].dv[j];
                v[q][j] = (f32x4){bf2f(xv.x & 0xffffu), bf2f(xv.x >> 16), bf2f(xv.y & 0xffffu), bf2f(xv.y >> 16)} * ALPHA
                        + (f32x4){bf2f(dv.x & 0xffffu), bf2f(dv.x >> 16), bf2f(dv.y & 0xffffu), bf2f(dv.y >> 16)}; }
        const int itn = it + 2 * NGW;
        if (itn < TB) { comb_load_hdr(h[0], (size_t)blk * TB + itn, x1b, dense, pos_of, lane); comb_load_hdr(h[1], (size_t)blk * TB + itn + NGW, x1b, dense, pos_of, lane); }
#pragma unroll
        for (int q = 0; q < 2; ++q) {
            const size_t tk = (size_t)blk * TB + it + q * NGW;
#pragma unroll
            for (int k = 0; k < 8; ++k)
#pragma unroll
                for (int j = 0; j < 4; ++j) v[q][j] += unpk4_fp8(yv[q][k][j]) * YEI;
            float sm = 0.f;
#pragma unroll
            for (int j = 0; j < 4; ++j) sm += (v[q][j].x + v[q][j].y) + (v[q][j].z + v[q][j].w);
            const float mean = wave_sum(sm) * (1.f / D); float s2 = 0.f;
#pragma unroll
            for (int j = 0; j < 4; ++j) { v[q][j] = v[q][j] - mean; s2 += (v[q][j].x * v[q][j].x + v[q][j].y * v[q][j].y) + (v[q][j].z * v[q][j].z + v[q][j].w * v[q][j].w); }
            const float rstd = rsqrtf(wave_sum(s2) * (1.f / D) + LN_EPS);
#pragma unroll
            for (int j = 0; j < 4; ++j) {
                const f32x4 w4 = *((const f32x4*)a.ln2_w + lane + 64 * j), b4 = *((const f32x4*)a.ln2_b + lane + 64 * j);
                *((f32x4*)(a.out + tk * D) + lane + 64 * j) = v[q][j] * rstd * w4 + b4;
            }
        }
    }
}

#ifndef PHASE_MASK
#define PHASE_MASK 0xffffffffu
#endif
#define PH(k) ((PHASE_MASK >> (k)) & 1u)
#ifndef REPEAT_MASK
#define REPEAT_MASK 0u
#endif
#define RP(k) (1 + (int)((REPEAT_MASK >> (k)) & 1u))
typedef const __attribute__((address_space(4))) Args* KArgsPtr;
DI KArgsPtr kargs_ptr() { KArgsPtr p = (KArgsPtr)__builtin_amdgcn_kernarg_segment_ptr(); asm volatile("" : "+s"(p)); return p; }
__global__ void __launch_bounds__(512, 2) fwd_kernel(Args a_by_value) {
    extern __shared__ __attribute__((aligned(16))) unsigned char lds_raw[];
    (void)a_by_value;
#if defined(__HIP_DEVICE_COMPILE__)
    const int wave0 = __builtin_amdgcn_readfirstlane((int)threadIdx.x >> 6) & 7;
#define LEADER() (wave0 == 0 && lane_id_asm() == 0)
#define FRAME() Frame F; { const int l_ = lane_id_asm(); F.tid = wave0 * 64 + l_; F.lane = l_; F.wave = wave0; F.G = gridDim.x; F.bid = blockIdx.x; F.lds = (LAS unsigned char*)lds_raw; } \
                const Args a = *kargs_ptr(); unsigned char* const ws = a.ws; unsigned char* const dob = (unsigned char*)a.out; unsigned* const tabw = (unsigned*)(ws + WS_TAB); (void)dob; (void)tabw;
#define STAMP() do {} while (0)
#define GRIDBAR() do { GRIDBAR_(); STAMP(); } while (0)
#define GRIDBAR_() do { XcdBarrier bar_; bar_.bar = (unsigned*)(kargs_ptr()->ws + WS_CTL) + 4096; bar_.x = xb_xcc_id(); bar_.st = (volatile LAS unsigned*)((LAS unsigned char*)lds_raw + MISC_OFF) + 8; xcd_barrier(bar_, LEADER()); } while (0)
    {
        for (int u = threadIdx.x; u < (LDS_BYTES - LDSCTL_OFF) / 4; u += 512) ((LAS unsigned*)((LAS unsigned char*)lds_raw + LDSCTL_OFF))[u] = 0u;
        __syncthreads();
        (void)xcd_barrier_post((unsigned*)(kargs_ptr()->ws + WS_CTL) + 4096, (volatile LAS unsigned*)((LAS unsigned char*)lds_raw + MISC_OFF) + 8, LEADER());
        STAMP();
    }
    _Pragma("unroll 1") for (int rep_ = 0; rep_ < RP(0); ++rep_) if (PH(0)) { FRAME(); p0_prologue(F, a); }
    GRIDBAR();
    if (PH(1)) { FRAME(); const bool conv_first = ((F.bid >> 3) & 1) == 0;
        if (conv_first) { tr_run(F, I_EGU, [&](int it) LAMBDA_INL { return egu_item(a, it); }); __syncthreads(); }
        { ProbQKV P; P.init(ws + WS_X8, ws + WS_WIN8, T, NATT, 512, F.G, F.bid); P.O = (bf16*)(ws + WS_R); P.xl = F.lds; pg8::gemm_phase(F.lds, P, wave0); }
        if (!conv_first) { __syncthreads(); tr_run(F, I_EGU, [&](int it) LAMBDA_INL { return egu_item(a, it); }); } }
    GRIDBAR();
    _Pragma("unroll 1") for (int rep_ = 0; rep_ < RP(2); ++rep_) if (PH(2)) { FRAME(); attn_phase(F, (const bf16*)(ws + WS_R), (bf16*)(ws + WS_OPART), (float*)(ws + WS_LSE)); }
    GRIDBAR();
    _Pragma("unroll 1") for (int rep_ = 0; rep_ < RP(3); ++rep_) if (PH(3)) { FRAME(); attn_mix_phase(F, (const bf16*)(ws + WS_OPART), (const float*)(ws + WS_LSE), ws + WS_YATT); }
    __syncthreads();
    _Pragma("unroll 1") for (int rep_ = 0; rep_ < RP(4); ++rep_) if (PH(4)) { FRAME(); ProbHG P; P.init(ws + WS_X8, ws + WS_WIN8 + (size_t)NATT * 1024, T, NHG + NGATE, 512, F.G, F.bid); P.R2 = (bf16*)(ws + WS_R); P.gates = (bf16*)dob; P.lbl = a.lb_logits; pg8::gemm_phase(F.lds, P, wave0); }
    GRIDBAR();
    _Pragma("unroll 1") for (int rep_ = 0; rep_ < RP(5); ++rep_) if (PH(5)) { FRAME(); hgrn_l1_phase(F, (const bf16*)(ws + WS_R), (float*)(ws + WS_L), (float*)(ws + WS_TAB + 128 * 1024)); }
    GRIDBAR();
    _Pragma("unroll 1") for (int rep_ = 0; rep_ < RP(7); ++rep_) if (PH(7)) { FRAME(); hgrn_phase<true>(F, (const bf16*)(ws + WS_R), (float*)(ws + WS_L), (float*)(ws + WS_TAB + 128 * 1024), a.hg_norm_w, ws + WS_XB); }
    GRIDBAR();
    _Pragma("unroll 1") for (int rep_ = 0; rep_ < RP(8); ++rep_) if (PH(8)) { FRAME(); ProbBrA P; P.init(ws + WS_YATT, ws + WS_WA, T, 1024, 256, F.G, F.bid); P.gates = (const bf16*)dob; P.O = (bf16*)(ws + WS_MERGED); pg8::gemm_phase(F.lds, P, wave0); }
    __syncthreads();
    _Pragma("unroll 1") for (int rep_ = 0; rep_ < RP(9); ++rep_) if (PH(9)) { FRAME(); ProbBrH P; P.init(ws + WS_XB, ws + WS_WH, T, 1024, 512, F.G, F.bid); P.gates = (const bf16*)dob; P.M1 = (const bf16*)(ws + WS_MERGED); P.O = ws + 320 * MiB; pg8::gemm_phase(F.lds, P, wave0); }
    GRIDBAR();
    if (PH(10)) { FRAME(); const bool conv_first = ((F.bid >> 3) & 1) == 0;
        if (conv_first) { p8_convert(F, a, dob + DO_WED, (bf16*)(ws + WS_PB)); __syncthreads(); }
        { ProbWo P; P.init(ws + 320 * MiB, ws + WS_WO, T, 1024, 512, F.G, F.bid); P.x = a.x; P.O = (bf16*)(ws + WS_PRE1); pg8::gemm_phase(F.lds, P, wave0); }
        if (!conv_first) { __syncthreads(); p8_convert(F, a, dob + DO_WED, (bf16*)(ws + WS_PB)); } }
    GRIDBAR();
    _Pragma("unroll 1") for (int rep_ = 0; rep_ < RP(11); ++rep_) if (PH(11)) { FRAME(); ln_router_phase(F, a, (const bf16*)(ws + WS_PRE1), (bf16*)(ws + WS_X1B), ws + WS_X8, (const bf16*)(ws + WS_WRT), (int*)(ws + WS_LISTS + LS_TOKE), (float*)(ws + WS_LISTS + LS_TOKG), tabw + TB_CNT); }
    GRIDBAR();
    _Pragma("unroll 1") for (int rep_ = 0; rep_ < RP(13); ++rep_) if (PH(13)) { FRAME(); scatter_phase(F, tabw + TB_CNT, (const int*)(ws + WS_LISTS + LS_TOKE), (const float*)(ws + WS_LISTS + LS_TOKG), (int*)(ws + WS_LISTS + LS_POS),
                  (int*)(ws + WS_LISTS + LS_TOKLIST), (float*)(ws + WS_LISTS + LS_GATELIST), tabw); }
    __syncthreads();
    _Pragma("unroll 1") for (int rep_ = 0; rep_ < RP(14); ++rep_) if (PH(14)) { FRAME(); ProbPP P; P.init(ws + WS_PB, ws + WS_WPP, T, 1024, 256, F.G, F.bid); P.O = (bf16*)(ws + WS_XB); pg8::gemm_phase(F.lds, P, wave0); }
    __syncthreads();
    _Pragma("unroll 1") for (int rep_ = 0; rep_ < RP(15); ++rep_) if (PH(15)) { FRAME(); ProbPG P; P.init(ws + WS_X8, ws + WS_WPG, T, 1024, 512, F.G, F.bid); P.O = (bf16*)(ws + WS_XB); pg8::gemm_phase(F.lds, P, wave0); }
    __syncthreads();
    _Pragma("unroll 1") for (int rep_ = 0; rep_ < RP(16); ++rep_) if (PH(16)) { FRAME(); ProbSGU P; P.init(ws + WS_X8, ws + WS_WSGU, T, 512, 512, F.G, F.bid); P.O = (bf16*)(ws + WS_HS); pg8::gemm_phase(F.lds, P, wave0); }
    GRIDBAR();
#pragma unroll 1
    for (int blk = 0; blk < NBLK; ++blk) {
        {
            FRAME(); LAS int* texp = (LAS int*)(F.lds + TABL_OFF);
            const int ntl = (int)tabw[TB_NT + blk * 64];
            __syncthreads();
            for (int i = F.tid; i < ntl; i += 512) texp[i] = (int)tabw[TB_TEXP + blk * MAXTILES + i];
            __syncthreads();
            LAS unsigned short* ltok = (LAS unsigned short*)(F.lds + XL_TOK); LAS float* lgate = (LAS float*)(F.lds + XL_GATE);
            { const int* tl_ = (const int*)(ws + WS_LISTS + LS_TOKLIST) + (size_t)blk * MAXROWS; const float* gl_ = (const float*)(ws + WS_LISTS + LS_GATELIST) + (size_t)blk * MAXROWS;
              const int pm0_ = ((F.bid >> 3) >> 1) * 8 + (F.bid & 7);
#pragma unroll 1
              for (int i = 0; i < XL_UNITS; ++i) { const int pm_ = i * 128 + pm0_; if (pm_ >= ntl) break;
                  if (F.tid < 256) ltok[i * 256 + F.tid] = (unsigned short)tl_[pm_ * 256 + F.tid]; else lgate[i * 256 + F.tid - 256] = gl_[pm_ * 256 + F.tid - 256]; } }
            __syncthreads();
            _Pragma("unroll 1") for (int rep_ = 0; rep_ < RP(18); ++rep_) if (PH(18)) { ProbMoeUp P; P.A = (const char*)(ws + WS_X8); P.Bt = (const char*)(ws + WS_WEGU8); P.K = 512; P.ntiles = ntl; P.G = F.G; P.c = F.bid; P.texp = texp;
              P.ltok = ltok; P.lgate = lgate; P.H = dob; pg8::gemm_phase(F.lds, P, wave0); }
            __syncthreads();
            _Pragma("unroll 1") for (int rep_ = 0; rep_ < RP(17); ++rep_) if (PH(17)) { ProbSD P; P.init(ws + WS_HS, ws + WS_WSD, T, 1024, 256, F.G, F.bid); P.O = (bf16*)(ws + WS_XB);
              const int x_ = F.bid & 7, sl_ = F.bid >> 3, q_ = (sl_ >> 1) * 8 + x_, full_ = ntl - 8 * 128;
              const int fl_ = full_ < 0 ? 0 : (full_ > 128 ? 128 : full_);
              P.nlight = 2 * (128 - fl_); P.rank = (q_ >= fl_ && P.nlight > 0) ? 2 * (q_ - fl_) + (sl_ & 1) : -1;
              if (P.nlight == 0) { P.nlight = 256; P.rank = F.bid; }
              pg8::gemm_phase(F.lds, P, wave0); }
        }
        GRIDBAR();
        {
            FRAME(); LAS int* texp = (LAS int*)(F.lds + TABL_OFF);
            const int ntl = (int)tabw[TB_NT + blk * 64];
            _Pragma("unroll 1") for (int rep_ = 0; rep_ < RP(19); ++rep_) if (PH(19)) { ProbMoeDown P; P.A = (const char*)dob; P.Bt = (const char*)(dob + DO_WED); P.ntiles = ntl; P.G = F.G; P.c = F.bid; P.texp = texp;
              P.Y = ws + WS_YE; P.Y2 = ws + WS_YE2; P.xb = F.lds + (TABL_OFF + 6144); pg8::gemm_phase(F.lds, P, wave0); }
        }
        GRIDBAR();
        _Pragma("unroll 1") for (int rep_ = 0; rep_ < RP(20); ++rep_) if (PH(20)) { FRAME(); combine_phase(F, a, blk, (const bf16*)(ws + WS_X1B), (const bf16*)(ws + WS_XB), ws + WS_YE, ws + WS_YE2, (const int*)(ws + WS_LISTS + LS_POS)); }
    }
#endif
}

extern "C" void kernel_launch(void* const* d_in, const int* in_sizes, int n_in, void* d_out, int out_size, void* d_ws, size_t ws_size, hipStream_t stream) {
    static int grid = 0;
    if (grid == 0) {
        if (n_in != 22 || in_sizes[0] != T * D || out_size != T * D || ws_size < WS_END) { fprintf(stderr, "kernel_launch: unexpected shapes (n_in %d, in0 %d, out %d, ws %zu)\n", n_in, n_in > 0 ? in_sizes[0] : -1, out_size, ws_size); grid = -1; return; }
        int dev = 0, cus = 0, per_cu = 0;
        if (hipGetDevice(&dev) != hipSuccess || hipDeviceGetAttribute(&cus, hipDeviceAttributeMultiprocessorCount, dev) != hipSuccess) { grid = -1; return; }
        if (hipFuncSetAttribute((const void*)fwd_kernel, hipFuncAttributeMaxDynamicSharedMemorySize, LDS_BYTES) != hipSuccess) { fprintf(stderr, "kernel_launch: hipFuncSetAttribute failed\n"); grid = -1; return; }
        if (hipOccupancyMaxActiveBlocksPerMultiprocessor(&per_cu, (const void*)fwd_kernel, 512, LDS_BYTES) != hipSuccess || per_cu < 1) fprintf(stderr, "kernel_launch: occupancy query says %d\n", per_cu);
        (void)hipGetLastError();
        grid = cus;
        if (grid != 256) { fprintf(stderr, "kernel_launch: built for 256 CUs, device has %d\n", cus); grid = -1; return; }
    }
    if (grid < 0) return;
    if (hipMemsetAsync((char*)d_ws + WS_CTL, 0, CTL_ZERO_BYTES, stream) != hipSuccess) return;
    Args a{};
    const float** pp = (const float**)&a;
    for (int i = 0; i < 22; ++i) pp[i] = (const float*)d_in[i];
    a.out = (float*)d_out; a.ws = (unsigned char*)d_ws;
    hipLaunchKernelGGL(fwd_kernel, dim3(grid), dim3(512), LDS_BYTES, stream, a);
}
```
